# Optimizing an MI355X kernel written in HIP

```python
import jax, jax.numpy as jnp
from jax import lax
import numpy as np

D_MODEL = 2048
BATCH = 4
SEQ = 2048
DEPTH = 1

HEAD_DIM = 64
SWA_Q_HEADS = 16
SWA_KV_HEADS = 4
SWA_GROUP = SWA_Q_HEADS // SWA_KV_HEADS
WINDOW = 128
FOX_HEADS = 16
BLOCK_Q = 128
ROPE_THETA = 10000.0
FGATE_BIAS_INIT = 3.0

N_EXPERTS = 32
TOP_K = 4
D_EXPERT = D_MODEL
SWIGLU_LIMIT = 7.0
SWIGLU_ALPHA = 1.702
MOE_BLOCK = 128

RMS_EPS = 1e-5
NEG_INF = -1e30

SWA_Q_W = SWA_Q_HEADS * HEAD_DIM
SWA_KV_W = SWA_KV_HEADS * HEAD_DIM
FOX_W = FOX_HEADS * HEAD_DIM
IN_WIDTHS = [SWA_Q_W, SWA_KV_W, SWA_KV_W, FOX_W, FOX_W, FOX_W, FOX_HEADS, D_MODEL, D_MODEL]
IN_W = sum(IN_WIDTHS)
IN_SPLITS = [int(v) for v in np.cumsum(IN_WIDTHS)[:-1]]
FGATE_OFFSET = SWA_Q_W + 2 * SWA_KV_W + 3 * FOX_W

kernel_name = "hybrid_swa_sink_fox_gated_moe_adaln"


def rms_norm(x, g):
    xf = x.astype(jnp.float32)
    y = xf * lax.rsqrt(jnp.mean(xf * xf, axis=-1, keepdims=True) + RMS_EPS)
    return (y * g.astype(jnp.float32)).astype(x.dtype)


def rope(x, positions):
    hd = x.shape[-1]
    inv_freq = 1.0 / (ROPE_THETA ** (jnp.arange(0, hd, 2, dtype=jnp.float32) / hd))
    ang = positions.astype(jnp.float32)[..., None] * inv_freq
    cos = jnp.cos(ang)[:, :, None, :]
    sin = jnp.sin(ang)[:, :, None, :]
    xf = x.astype(jnp.float32)
    x1, x2 = jnp.split(xf, 2, axis=-1)
    out = jnp.concatenate([x1 * cos - x2 * sin, x2 * cos + x1 * sin], axis=-1)
    return out.astype(x.dtype)


def swa_sink_attention(q, k, v, sinks):
    B, S, _, hd = q.shape
    W = WINDOW
    nb = S // W
    scale = hd ** -0.5
    qb = q.reshape(B, nb, W, SWA_KV_HEADS, SWA_GROUP, hd)
    kb = k.reshape(B, nb, W, SWA_KV_HEADS, hd)
    vb = v.reshape(B, nb, W, SWA_KV_HEADS, hd)
    pad = ((0, 0), (1, 0), (0, 0), (0, 0), (0, 0))
    kk = jnp.concatenate([jnp.pad(kb, pad)[:, :-1], kb], axis=2)
    vv = jnp.concatenate([jnp.pad(vb, pad)[:, :-1], vb], axis=2)
    scores = jnp.einsum('bnqhgd,bnkhd->bnhgqk', qb, kk).astype(jnp.float32) * scale
    qi = jnp.arange(W)[:, None]
    kj = jnp.arange(2 * W)[None, :]
    delta = qi + W - kj
    band = (delta >= 0) & (delta < WINDOW)
    key_pos = jnp.arange(nb)[:, None, None] * W - W + kj[None]
    valid = band[None] & (key_pos >= 0)
    scores = jnp.where(valid[None, :, None, None], scores, NEG_INF)
    sink_col = jnp.broadcast_to(
        sinks.astype(jnp.float32).reshape(1, 1, SWA_KV_HEADS, SWA_GROUP, 1, 1),
        scores.shape[:-1] + (1,))
    probs = jax.nn.softmax(jnp.concatenate([scores, sink_col], axis=-1), axis=-1)[..., :-1]
    out = jnp.einsum('bnhgqk,bnkhd->bnqhgd', probs.astype(v.dtype), vv)
    return out.reshape(B, S, SWA_Q_HEADS * hd)


def forgetting_attention(q, k, v, log_f):
    B, S, H, hd = q.shape
    nb = S // BLOCK_Q
    scale = hd ** -0.5
    cum = jnp.transpose(jnp.cumsum(log_f, axis=1), (0, 2, 1))
    q_blocks = jnp.transpose(q.reshape(B, nb, BLOCK_Q, H, hd), (1, 0, 2, 3, 4))
    cum_q = jnp.transpose(cum.reshape(B, H, nb, BLOCK_Q), (2, 0, 1, 3))
    starts = jnp.arange(nb, dtype=jnp.int32) * BLOCK_Q
    key_pos = jnp.arange(S, dtype=jnp.int32)

    def one_block(args):
        qb, cq, start = args
        s = jnp.einsum('bqhd,bkhd->bhqk', qb, k).astype(jnp.float32) * scale
        s = s + cq[..., :, None] - cum[:, :, None, :]
        q_pos = start + jnp.arange(BLOCK_Q, dtype=jnp.int32)
        causal = key_pos[None, :] <= q_pos[:, None]
        p = jax.nn.softmax(jnp.where(causal, s, NEG_INF), axis=-1)
        return jnp.einsum('bhqk,bkhd->bqhd', p.astype(v.dtype), v)

    out = lax.map(one_block, (q_blocks, cum_q, starts))
    return jnp.transpose(out, (1, 0, 2, 3, 4)).reshape(B, S, H * hd)


def hybrid_mixer(xn, positions, w_in, b_in, sinks, w_branch_a, w_branch_b, w_out):
    B, S, _ = xn.shape
    proj = xn @ w_in + b_in
    qa, ka, va, qb, kb, vb, fb, ga, gb = jnp.split(proj, IN_SPLITS, axis=-1)
    qa = rope(qa.reshape(B, S, SWA_Q_HEADS, HEAD_DIM), positions)
    ka = rope(ka.reshape(B, S, SWA_KV_HEADS, HEAD_DIM), positions)
    va = va.reshape(B, S, SWA_KV_HEADS, HEAD_DIM)
    ya = swa_sink_attention(qa, ka, va, sinks)
    log_f = jax.nn.log_sigmoid(fb.astype(jnp.float32))
    yb = forgetting_attention(qb.reshape(B, S, FOX_HEADS, HEAD_DIM),
                              kb.reshape(B, S, FOX_HEADS, HEAD_DIM),
                              vb.reshape(B, S, FOX_HEADS, HEAD_DIM), log_f)
    merged = jax.nn.sigmoid(ga) * (ya @ w_branch_a) + jax.nn.sigmoid(gb) * (yb @ w_branch_b)
    return merged @ w_out


def moe_ffn(xn, w_router, b_router, w_gu, b_gu, w_down, b_down):
    B, S, D = xn.shape
    N = B * S
    A = N * TOP_K
    xf = xn.reshape(N, D)
    logits = (xf @ w_router + b_router).astype(jnp.float32)
    top_val, top_idx = lax.top_k(logits, TOP_K)
    gates = jax.nn.softmax(top_val, axis=-1)
    eid = top_idx.reshape(A).astype(jnp.int32)
    tok = jnp.arange(A, dtype=jnp.int32) // TOP_K
    gw = gates.reshape(A)
    order = jnp.argsort(eid)
    s_eid, s_tok, s_w = eid[order], tok[order], gw[order]
    counts = jnp.bincount(eid, length=N_EXPERTS).astype(jnp.int32)
    starts = jnp.cumsum(counts) - counts
    pad_counts = ((counts + MOE_BLOCK - 1) // MOE_BLOCK) * MOE_BLOCK
    pad_ends = jnp.cumsum(pad_counts)
    pad_starts = pad_ends - pad_counts
    dest = pad_starts[s_eid] + (jnp.arange(A, dtype=jnp.int32) - starts[s_eid])
    P = A + N_EXPERTS * MOE_BLOCK
    n_blocks = P // MOE_BLOCK
    row_tok = jnp.zeros((P,), jnp.int32).at[dest].set(s_tok)
    row_w = jnp.zeros((P,), jnp.float32).at[dest].set(s_w)
    block_starts = jnp.arange(n_blocks, dtype=jnp.int32) * MOE_BLOCK
    block_e = jnp.minimum(jnp.searchsorted(pad_ends, block_starts, side='right'),
                          N_EXPERTS - 1).astype(jnp.int32)
    x_rows = xf[row_tok].reshape(n_blocks, MOE_BLOCK, D)

    def expert_block(args):
        xb, e = args
        hcat = xb @ w_gu[e] + b_gu[e]
        glu, lin = jnp.split(hcat, 2, axis=-1)
        glu = jnp.minimum(glu, SWIGLU_LIMIT)
        lin = jnp.clip(lin, -SWIGLU_LIMIT, SWIGLU_LIMIT)
        act = glu * jax.nn.sigmoid(SWIGLU_ALPHA * glu) * (lin + 1.0)
        return act @ w_down[e] + b_down[e]

    y_rows = lax.map(expert_block, (x_rows, block_e)).reshape(P, D)
    y = jax.ops.segment_sum(y_rows * row_w[:, None].astype(y_rows.dtype), row_tok,
                            num_segments=N)
    return y.reshape(B, S, D)


def setup_inputs(seed: int = 0) -> dict:
    key = jax.random.key(seed)
    ks = jax.random.split(key, 20)
    f32 = jnp.float32
    D, F, E, L = D_MODEL, D_EXPERT, N_EXPERTS, DEPTH
    x = jax.random.normal(ks[0], (BATCH, SEQ, D), f32)
    c = jax.random.normal(ks[1], (BATCH, D), f32)
    positions = jnp.broadcast_to(jnp.arange(SEQ, dtype=jnp.int32)[None, :], (BATCH, SEQ))
    w_ada = 0.5 * jax.random.normal(ks[2], (L, D, 6 * D), f32) * D ** -0.5
    b_ada = 0.02 * jax.random.normal(ks[3], (L, 6 * D), f32)
    g_mix = 1.0 + 0.02 * jax.random.normal(ks[4], (L, D), f32)
    w_in = jax.random.normal(ks[5], (L, D, IN_W), f32) * D ** -0.5
    b_in = 0.01 * jax.random.normal(ks[6], (L, IN_W), f32)
    b_in = b_in.at[:, FGATE_OFFSET:FGATE_OFFSET + FOX_HEADS].add(FGATE_BIAS_INIT)
    sinks = 0.5 * jax.random.normal(ks[7], (L, SWA_Q_HEADS), f32)
    w_branch_a = jax.random.normal(ks[8], (L, SWA_Q_W, D), f32) * SWA_Q_W ** -0.5
    w_branch_b = jax.random.normal(ks[9], (L, FOX_W, D), f32) * FOX_W ** -0.5
    w_out = jax.random.normal(ks[10], (L, D, D), f32) * D ** -0.5
    g_ffn = 1.0 + 0.02 * jax.random.normal(ks[11], (L, D), f32)
    w_router = jax.random.normal(ks[12], (L, D, E), f32) * D ** -0.5
    b_router = 0.01 * jax.random.normal(ks[13], (L, E), f32)
    w_gu = jax.random.normal(ks[14], (L, E, D, 2 * F), f32) * D ** -0.5
    b_gu = 0.01 * jax.random.normal(ks[15], (L, E, 2 * F), f32)
    w_down = jax.random.normal(ks[16], (L, E, F, D), f32) * F ** -0.5
    b_down = 0.01 * jax.random.normal(ks[17], (L, E, D), f32)
    g_final = 1.0 + 0.02 * jax.random.normal(ks[18], (D,), f32)
    return {"x": x, "c": c, "positions": positions, "w_ada": w_ada, "b_ada": b_ada,
            "g_mix": g_mix, "w_in": w_in, "b_in": b_in, "sinks": sinks,
            "w_branch_a": w_branch_a, "w_branch_b": w_branch_b, "w_out": w_out,
            "g_ffn": g_ffn, "w_router": w_router, "b_router": b_router,
            "w_gu": w_gu, "b_gu": b_gu, "w_down": w_down, "b_down": b_down,
            "g_final": g_final}


def reference(x, c, positions, w_ada, b_ada, g_mix, w_in, b_in, sinks, w_branch_a,
              w_branch_b, w_out, g_ffn, w_router, b_router, w_gu, b_gu, w_down, b_down,
              g_final):
    h = x
    c_act = jax.nn.silu(c)
    for l in range(DEPTH):
        mod = c_act @ w_ada[l] + b_ada[l]
        sh1, sc1, gt1, sh2, sc2, gt2 = [m[:, None, :] for m in jnp.split(mod, 6, axis=-1)]
        xn = rms_norm(h, g_mix[l]) * (1.0 + sc1) + sh1
        h = h + gt1 * hybrid_mixer(xn, positions, w_in[l], b_in[l], sinks[l],
                                   w_branch_a[l], w_branch_b[l], w_out[l])
        xn = rms_norm(h, g_ffn[l]) * (1.0 + sc2) + sh2
        h = h + gt2 * moe_ffn(xn, w_router[l], b_router[l], w_gu[l], b_gu[l],
                              w_down[l], b_down[l])
    return rms_norm(h, g_final)
```

```cpp
#include <hip/hip_runtime.h>
#include <stdint.h>
#include <math.h>
namespace mk {
#define LAS __attribute__((address_space(3)))
#define GAS __attribute__((address_space(1)))
typedef unsigned short bf16_t;
typedef short bf16x8 __attribute__((ext_vector_type(8)));
typedef float f32x4 __attribute__((ext_vector_type(4)));
typedef float f32x2 __attribute__((ext_vector_type(2)));
typedef float f32x16 __attribute__((ext_vector_type(16)));
typedef unsigned u32x4 __attribute__((ext_vector_type(4)));
typedef unsigned u32x2 __attribute__((ext_vector_type(2)));
typedef __bf16 bf16x2_t __attribute__((ext_vector_type(2)));
typedef int i32x4 __attribute__((ext_vector_type(4)));
typedef int i32x8 __attribute__((ext_vector_type(8)));

constexpr int NTOK = 8192, DM = 2048, SEQ = 2048, INW = 8720, NEXP = 32, MODW = 12288;
constexpr float LOG2E = 1.4426950408889634f;
constexpr float QSCALE = 0.125f * LOG2E;

__device__ __forceinline__ unsigned pk2(float lo, float hi) { f32x2 v = {lo, hi}; bf16x2_t b = __builtin_convertvector(v, bf16x2_t); return __builtin_bit_cast(unsigned, b); }
__device__ __forceinline__ float bflo(unsigned u) { return __builtin_bit_cast(float, u << 16); }
__device__ __forceinline__ float bfhi(unsigned u) { return __builtin_bit_cast(float, u & 0xffff0000u); }
__device__ __forceinline__ unsigned pk4_fp8_raw(float a, float b, float c, float d) { int w = 0; w = __builtin_amdgcn_cvt_pk_fp8_f32(a, b, w, false); w = __builtin_amdgcn_cvt_pk_fp8_f32(c, d, w, true); return (unsigned)w; }
__device__ __forceinline__ float sat448(float x) { return __builtin_amdgcn_fmed3f(x, -448.0f, 448.0f); }
__device__ __forceinline__ unsigned pk4_fp8(float a, float b, float c, float d) { return pk4_fp8_raw(a, b, c, d); }
__device__ __forceinline__ i32x8 cat8(bf16x8 lo, bf16x8 hi) { return __builtin_shufflevector(__builtin_bit_cast(i32x4, lo), __builtin_bit_cast(i32x4, hi), 0, 1, 2, 3, 4, 5, 6, 7); }
__device__ __forceinline__ int lane_id() { int l = (int)__builtin_amdgcn_mbcnt_hi(~0u, __builtin_amdgcn_mbcnt_lo(~0u, 0u)); asm volatile("" : "+v"(l)); return l; }
template <int CTRL> __device__ __forceinline__ float dpp_mov(float x) { return __builtin_bit_cast(float, __builtin_amdgcn_update_dpp(0, __builtin_bit_cast(int, x), CTRL, 0xF, 0xF, true)); }
__device__ __forceinline__ float lx1(float x) { return dpp_mov<0xB1>(x); }
__device__ __forceinline__ float lx2(float x) { return dpp_mov<0x4E>(x); }
__device__ __forceinline__ float lx4(float x) { return dpp_mov<0x1B>(dpp_mov<0x141>(x)); }
__device__ __forceinline__ float lx8(float x) { return dpp_mov<0x128>(x); }
__device__ __forceinline__ float lx16(float x, int lane) { const unsigned u = __builtin_bit_cast(unsigned, x); auto rr = __builtin_amdgcn_permlane16_swap(u, u, false, false); return __builtin_bit_cast(float, (lane & 16) ? rr[0] : rr[1]); }
__device__ __forceinline__ float lx32(float x, int lane) { const unsigned u = __builtin_bit_cast(unsigned, x); auto rr = __builtin_amdgcn_permlane32_swap(u, u, false, false); return __builtin_bit_cast(float, (lane & 32) ? rr[0] : rr[1]); }
__device__ __forceinline__ float wave_sum_v(float v) {
    v += lx1(v); v += lx2(v); v += lx4(v); v += lx8(v);
    { const unsigned u = __builtin_bit_cast(unsigned, v); auto rr = __builtin_amdgcn_permlane16_swap(u, u, false, false); v = __builtin_bit_cast(float, rr[0]) + __builtin_bit_cast(float, rr[1]); }
    { const unsigned u = __builtin_bit_cast(unsigned, v); auto rr = __builtin_amdgcn_permlane32_swap(u, u, false, false); v = __builtin_bit_cast(float, rr[0]) + __builtin_bit_cast(float, rr[1]); }
    return v;
}
__device__ __forceinline__ float fast_sigmoid(float x) { return __builtin_amdgcn_rcpf(1.0f + __builtin_amdgcn_exp2f(-x * LOG2E)); }

constexpr int BM = 256, BK = 64, HALF = 128, HTB = HALF * BK * 2, STAGE_BYTES = 8 * HTB, NXCD = 8, WGM = 8;
__host__ __device__ __forceinline__ int lds_byte(int r, int c) { const int st = (r >> 4) * 2 + (c >> 5), rr = r & 15, cc = c & 31, ob = rr * 64 + cc * 2; return st * 1024 + (ob ^ (((ob >> 9) & 1) << 5)); }
__host__ __device__ __forceinline__ void stage_rc(int b, int& R, int& C) { const int st = b / 1024, sb = b % 1024, swz = sb ^ (((sb >> 9) & 1) << 5); R = (st >> 1) * 16 + swz / 64; C = (st & 1) * 32 + (swz % 64) / 2; }
__host__ __device__ __forceinline__ int perm32(int rho) { const int n = rho >> 4, i = rho & 15; return 8 * (i >> 2) + 4 * n + (i & 3); }

struct Unit { int pm, pn, aux; };

template <class Epi, class Sched, bool ALIGN_EPI, bool FP8 = false>
__device__ __forceinline__ void gemm_phase(LAS unsigned char* lds, const Sched& S, const Epi& E, int wid  ) {
    const int lane = lane_id(), tid = wid * 64 + lane, wr = wid >> 2, wc = wid & 3, fr = lane & 15, fq = lane >> 4;
    const int K = S.K, nt = FP8 ? K / (2 * BK) : K / BK;
    int sR[2], sC[2]; unsigned voffB[2];
#pragma unroll
    for (int i = 0; i < 2; ++i) { stage_rc(tid * 16 + i * 8192, sR[i], sC[i]); const int Rb = Epi::PERM ? ((sR[i] & ~31) + perm32(sR[i] & 31)) : sR[i]; voffB[i] = (unsigned)Rb * S.ldb2 + (unsigned)sC[i] * 2u; }
    const size_t kstep = (size_t)(BK * 2);
    const size_t hstepB = (size_t)HALF * S.ldb2;
    const unsigned ldsw = (unsigned)wid * 1024u;
    const int aoff = lds_byte(wr * 64 + fr, fq * 8), boff = lds_byte(wc * 32 + fr, fq * 8);
#define PG8_SA(b, h) (((b) * 2 + (h)) * HTB)
#define PG8_SB(b, h) ((4 + (b) * 2 + (h)) * HTB)
#define PG8_STAGE(bufoff, gbase, voff) do { _Pragma("unroll") for (int _i = 0; _i < 2; ++_i) \
        __builtin_amdgcn_global_load_lds((const unsigned*)((const char*)(gbase) + (voff)[_i]), (LAS unsigned*)(lds + (bufoff) + ldsw + _i * 8192), 16, 0, 0); } while (0)
#define PG8_LDA(dst, b, h) do { _Pragma("unroll") for (int m = 0; m < 4; ++m) { if constexpr (FP8) dst##8[m] = cat8(*(const LAS bf16x8*)(lds + PG8_SA(b, h) + aoff + m * 2048), *(const LAS bf16x8*)(lds + PG8_SA(b, h) + aoff + m * 2048 + 1024)); \
        else { _Pragma("unroll") for (int k = 0; k < 2; ++k) dst[m][k] = *(const LAS bf16x8*)(lds + PG8_SA(b, h) + aoff + m * 2048 + k * 1024); } } } while (0)
#define PG8_LDB(dst, b, h) do { _Pragma("unroll") for (int n = 0; n < 2; ++n) { if constexpr (FP8) dst##8[n] = cat8(*(const LAS bf16x8*)(lds + PG8_SB(b, h) + boff + n * 2048), *(const LAS bf16x8*)(lds + PG8_SB(b, h) + boff + n * 2048 + 1024)); \
        else { _Pragma("unroll") for (int k = 0; k < 2; ++k) dst[n][k] = *(const LAS bf16x8*)(lds + PG8_SB(b, h) + boff + n * 2048 + k * 1024); } } } while (0)
#define PG8_MMA(ai, bj, At, Bt) do { __builtin_amdgcn_s_setprio(1); _Pragma("unroll") for (int m = 0; m < 4; ++m) _Pragma("unroll") for (int n = 0; n < 2; ++n) { \
        if constexpr (FP8) asm volatile("v_mfma_scale_f32_16x16x128_f8f6f4 %0, %1, %2, %0, %3, %3 op_sel_hi:[0,0,0]" : "+v"(acc[ai][bj][m][n]) : "v"(Bt##8[n]), "v"(At##8[m]), "v"(fp8_unit_scale)); \
        else { _Pragma("unroll") for (int k = 0; k < 2; ++k) acc[ai][bj][m][n] = __builtin_amdgcn_mfma_f32_16x16x32_bf16(Bt[n][k], At[m][k], acc[ai][bj][m][n], 0, 0, 0); } } __builtin_amdgcn_s_setprio(0); } while (0)
#define PG8_WAIT_V(n) asm volatile("s_waitcnt vmcnt(" #n ")" ::: "memory")
#define PG8_WAIT_L(n) asm volatile("s_waitcnt lgkmcnt(" #n ")" ::: "memory")
#define PG8_BAR __builtin_amdgcn_s_barrier()
#define PG8_SCHED __builtin_amdgcn_sched_barrier(0)
#define PG8_AOFFS(dst, u, ui) do { _Pragma("unroll") for (int _h = 0; _h < 2; ++_h) _Pragma("unroll") for (int _i = 0; _i < 2; ++_i) dst[_h][_i] = S.a_rowoff(u, ui, sR[_i] + _h * HALF) + (unsigned)sC[_i] * 2u; } while (0)
    Unit cur, nxt; int ui = 0;
    if (!S.next(0, cur)) return;
    int vrows = 256; if constexpr (Sched::RAGGED) vrows = S.rows(cur);
#define PG8_DO0 (!Sched::RAGGED || vrows > 64 || wr == 0)
#define PG8_DO1 (!Sched::RAGGED || vrows > 128)
    f32x4 acc[2][2][4][2];
#pragma unroll
    for (int a = 0; a < 2; ++a)
#pragma unroll
        for (int b = 0; b < 2; ++b)
#pragma unroll
            for (int m = 0; m < 4; ++m)
#pragma unroll
                for (int n = 0; n < 2; ++n) acc[a][b][m][n] = (f32x4){0.f, 0.f, 0.f, 0.f};
    bf16x8 At[4][2], B0[2][2], B1[2][2]; i32x8 At8[4], B08[2], B18[2];
    constexpr bool GA = Sched::GATHER;
    const unsigned fp8_unit_scale = 0x7f7f7f7fu;
    unsigned vAc[2][2], vAn[2][2];
    PG8_AOFFS(vAc, cur, 0);
    const size_t hstepA = GA ? 0 : (size_t)(vAc[1][0] - vAc[0][0]);
#define PG8_H1(v) (GA ? (v)[1] : (v)[0])
    const char* cA = S.a_base(cur); const char* cB = S.b_base(cur);
    PG8_STAGE(PG8_SB(0, 0), cB, voffB); PG8_STAGE(PG8_SB(0, 1), cB + hstepB, voffB); PG8_STAGE(PG8_SA(0, 0), cA, vAc[0]); PG8_STAGE(PG8_SA(0, 1), cA + hstepA, PG8_H1(vAc));
    if (wr == 1) PG8_BAR;
    PG8_WAIT_V(2); PG8_BAR;
    PG8_STAGE(PG8_SB(1, 0), cB + kstep, voffB); PG8_STAGE(PG8_SA(1, 0), cA + kstep, vAc[0]); PG8_STAGE(PG8_SB(1, 1), cB + hstepB + kstep, voffB);
    PG8_WAIT_V(6); PG8_BAR;
    for (;;) {
        const bool has_next = S.next(ui + 1, nxt);
        const char* nA = cA; const char* nB = cB;
        if (has_next) { nA = S.a_base(nxt); nB = S.b_base(nxt); if constexpr (GA) PG8_AOFFS(vAn, nxt, ui + 1); }
        else if constexpr (GA) {
#pragma unroll
            for (int _h = 0; _h < 2; ++_h)
#pragma unroll
                for (int _i = 0; _i < 2; ++_i) vAn[_h][_i] = vAc[_h][_i]; }
        for (int t = 0; t < nt; t += 2) {
            const bool last = (t == nt - 2);
            const char* a1 = cA + (size_t)(t + 1) * kstep;
            const char* a2 = last ? nA : cA + (size_t)(t + 2) * kstep; const char* b2 = last ? nB : cB + (size_t)(t + 2) * kstep;
            const char* a3 = a2 + kstep; const char* b3 = b2 + kstep;
            unsigned vS[2][2];
#pragma unroll
            for (int _h = 0; _h < 2; ++_h)
#pragma unroll
                for (int _i = 0; _i < 2; ++_i) vS[_h][_i] = (GA && last) ? vAn[_h][_i] : vAc[_h][_i];
            PG8_LDB(B0, 0, 0); PG8_LDB(B1, 0, 1); PG8_SCHED; PG8_LDA(At, 0, 0); PG8_STAGE(PG8_SA(1, 1), a1 + hstepA, PG8_H1(vAc));
            PG8_WAIT_V(8); PG8_WAIT_L(0); PG8_BAR; if (PG8_DO0) { PG8_MMA(0, 0, At, B0); PG8_MMA(0, 1, At, B1); } PG8_BAR; PG8_SCHED;
            PG8_LDA(At, 0, 1); PG8_STAGE(PG8_SB(0, 0), b2, voffB); PG8_STAGE(PG8_SB(0, 1), b2 + hstepB, voffB); PG8_STAGE(PG8_SA(0, 0), a2, vS[0]);
            PG8_WAIT_V(8); PG8_WAIT_L(0); PG8_BAR; if (PG8_DO1) { PG8_MMA(1, 0, At, B0); PG8_MMA(1, 1, At, B1); } PG8_BAR; PG8_SCHED;
            PG8_LDB(B0, 1, 0); PG8_LDB(B1, 1, 1); PG8_SCHED; PG8_LDA(At, 1, 0); PG8_STAGE(PG8_SA(0, 1), a2 + hstepA, PG8_H1(vS));
            PG8_WAIT_V(8); PG8_WAIT_L(0); PG8_BAR; if (PG8_DO0) { PG8_MMA(0, 0, At, B0); PG8_MMA(0, 1, At, B1); } PG8_BAR; PG8_SCHED;
            PG8_LDA(At, 1, 1); PG8_STAGE(PG8_SB(1, 0), b3, voffB); PG8_STAGE(PG8_SB(1, 1), b3 + hstepB, voffB); PG8_STAGE(PG8_SA(1, 0), a3, vS[0]);
            PG8_WAIT_V(8); PG8_WAIT_L(0); PG8_BAR; if (PG8_DO1) { PG8_MMA(1, 0, At, B0); PG8_MMA(1, 1, At, B1); } PG8_BAR; PG8_SCHED;
        }
        if constexpr (ALIGN_EPI) { if (wr == 0) PG8_BAR; }
        if constexpr (FP8) asm volatile("s_nop 15\n\ts_nop 15\n\ts_nop 15\n\ts_nop 15" ::: "memory");
        E(acc, cur, wr, wc, fr, fq);
        if (!has_next) break;
#pragma unroll
        for (int a = 0; a < 2; ++a)
#pragma unroll
            for (int b = 0; b < 2; ++b)
#pragma unroll
                for (int m = 0; m < 4; ++m)
#pragma unroll
                    for (int n = 0; n < 2; ++n) acc[a][b][m][n] = (f32x4){0.f, 0.f, 0.f, 0.f};
        cur = nxt; cA = nA; cB = nB; ++ui;
        if constexpr (Sched::RAGGED) vrows = S.rows(cur);
        if constexpr (GA) {
#pragma unroll
        for (int _h = 0; _h < 2; ++_h)
#pragma unroll
            for (int _i = 0; _i < 2; ++_i) vAc[_h][_i] = vAn[_h][_i]; }
        if constexpr (ALIGN_EPI) { if (wr == 1) PG8_BAR; }
    }
    PG8_WAIT_V(0);
    if constexpr (!ALIGN_EPI) { if (wr == 0) PG8_BAR; }
    PG8_BAR;
#undef PG8_SA
#undef PG8_SB
#undef PG8_STAGE
#undef PG8_LDA
#undef PG8_LDB
#undef PG8_MMA
#undef PG8_WAIT_V
#undef PG8_WAIT_L
#undef PG8_BAR
#undef PG8_SCHED
#undef PG8_AOFFS
#undef PG8_DO0
#undef PG8_DO1
#undef PG8_H1
}

#define XB_TMO      128
#define XB_XCNT(j)  (256  + 64 * (j))
#define XB_XSUB(j)  (1280 + 64 * (j))
#define XB_XGEN(j)  (2304 + 64 * (j))
#define XB_TOP      3328
#define XB_TOPGEN   3392
#define XCD_BAR_WORDS 3456
#define XB_SPIN_CAP (1u << 18)
__device__ __forceinline__ unsigned xb_ld(unsigned* p)              { return __hip_atomic_load(p, __ATOMIC_RELAXED, __HIP_MEMORY_SCOPE_AGENT); }
__device__ __forceinline__ unsigned xb_add(unsigned* p, unsigned v) { return __hip_atomic_fetch_add(p, v, __ATOMIC_RELAXED, __HIP_MEMORY_SCOPE_AGENT); }
__device__ __forceinline__ unsigned xb_xcc_id() { return (unsigned)__builtin_amdgcn_s_getreg((3 << 11) | 20) & 0xFu; }
#define XB_SPIN(cond, bar) do { unsigned _sp = 0; while (cond) { __builtin_amdgcn_s_sleep(1); \
    if ((++_sp & 255u) == 0u) { if (xb_ld(&(bar)[XB_TMO])) break; if (_sp > XB_SPIN_CAP) { atomicAdd(&(bar)[XB_TMO], 1u); break; } } } } while (0)
struct XcdBarrier { unsigned* bar; unsigned x; volatile LAS unsigned* st; unsigned total; };
__device__ __forceinline__ XcdBarrier xcd_barrier_post(unsigned* bar, volatile LAS unsigned* st, unsigned total) {
    XcdBarrier b; b.bar = bar; b.x = xb_xcc_id(); b.st = st; b.total = total;
    if (threadIdx.x == 0) (void)xb_add(&bar[XB_XCNT(b.x)], 1u);
    return b;
}
__device__ __forceinline__ void xcd_barrier_complete(unsigned* bar, unsigned x, unsigned G, unsigned& nloc, unsigned& nx) {
    unsigned sum, cnt, mine, sp = 0u;
    for (;;) {
        sum = 0u; cnt = 0u; mine = 0u;
#pragma unroll
        for (unsigned j = 0; j < 16; ++j) { const unsigned c = xb_ld(&bar[XB_XCNT(j)]); sum += c; cnt += (c > 0u) ? 1u : 0u; mine = (j == x) ? c : mine; }
        if (sum == G) break;
        __builtin_amdgcn_s_sleep(1);
        if ((++sp & 255u) == 0u) { if (xb_ld(&bar[XB_TMO])) break; if (sp > XB_SPIN_CAP) { atomicAdd(&bar[XB_TMO], 1u); break; } }
    }
    nloc = mine > 0u ? mine : 1u; nx = cnt > 0u ? cnt : 1u;
}
__device__ __forceinline__ void xcd_barrier(const XcdBarrier& b) {
    asm volatile("s_waitcnt vmcnt(0)" ::: "memory");
    __syncthreads();
    if (threadIdx.x == 0) {
        unsigned* bar = b.bar;
        __builtin_amdgcn_s_waitcnt(0);
        unsigned nloc = b.st[0], nx = b.st[1];
        if (nloc == 0u) { xcd_barrier_complete(bar, b.x, b.total, nloc, nx); b.st[0] = nloc; b.st[1] = nx; }
        const unsigned old = xb_add(&bar[XB_XSUB(b.x)], 1u);
        const unsigned gen = old / nloc;
        if (old + 1u == (gen + 1u) * nloc) {
            __builtin_amdgcn_fence(__ATOMIC_RELEASE, "agent");
            asm volatile("s_waitcnt vmcnt(0)" ::: "memory");
            const unsigned og = xb_add(&bar[XB_TOP], 1u);
            const unsigned tg = og / nx;
            if (og + 1u == (tg + 1u) * nx) xb_add(&bar[XB_TOPGEN], 1u);
            else XB_SPIN(xb_ld(&bar[XB_TOPGEN]) == tg, bar);
            __builtin_amdgcn_fence(__ATOMIC_ACQUIRE, "agent");
            xb_add(&bar[XB_XGEN(b.x)], 1u);
            asm volatile("s_waitcnt vmcnt(0)" ::: "memory");
        } else {
            XB_SPIN(xb_ld(&bar[XB_XGEN(b.x)]) == gen, bar);
            __builtin_amdgcn_fence(__ATOMIC_ACQUIRE, "agent");
            asm volatile("s_waitcnt vmcnt(0)" ::: "memory");
        }
    }
    __syncthreads();
}
}
namespace mk {
constexpr size_t MiB = 1ull << 20;
constexpr size_t WS_CTL = 0, CTL_ZERO_BYTES = 1 * MiB;
constexpr size_t WS_MOD = 1 * MiB, WS_COS = 2 * MiB, WS_SIN = 3 * MiB, WS_LOGF = 4 * MiB, WS_CUM = 5 * MiB, WS_TEID = 6 * MiB, WS_TPOS = 6 * MiB + 512 * 1024, WS_TGATE = 7 * MiB, WS_BINP = 7 * MiB + 512 * 1024,
                 WS_TOKOF = 8 * MiB  , WS_XN = 16 * MiB  , WS_WIN = 48 * MiB  , WS_WAB = 84 * MiB  , WS_WOUT = 92 * MiB  , WS_QA = 100 * MiB  , WS_KA = 116 * MiB  ,
                 WS_VA = 120 * MiB  , WS_QB = 124 * MiB  , WS_KB = 140 * MiB, WS_VB = 156 * MiB, WS_SGA = 172 * MiB  , WS_SGB = 204 * MiB  , WS_YAB = 236 * MiB  ,
                 WS_T1 = 268 * MiB  , WS_MERGED = 332 * MiB  , WS_H1 = 364 * MiB  , WS_XN2 = 428 * MiB  , WS_ACT = 460 * MiB  , WS_YS = 620 * MiB  ,
                 WS_WGU = 780 * MiB  , WS_WD = 1292 * MiB  , WS_JUNK = 1548 * MiB  , WS_END = 1580 * MiB;
constexpr int CW_CNT = 1024;
constexpr int CW_BAR = 4096;
constexpr int CW_BAR2 = 8192;
constexpr int CW_CQ = 2048;
constexpr int CW_AQ = 2112;
#ifndef CONV_MODE
#define CONV_MODE 0
#endif
#ifndef NCOMP_DEF
#define NCOMP_DEF 184
#endif
constexpr int NCOMP = NCOMP_DEF;
constexpr int RING_OFF = 0, RING_BYTES = 131072;
constexpr int TBL_OFF = RING_BYTES;
constexpr int MISC_OFF = TBL_OFF + 10240;
constexpr int LDS_BYTES = 147456;
static_assert(MISC_OFF + 1024 <= LDS_BYTES, "LDS map");
constexpr int NWAVES = 8;
constexpr bool MOE_FP8 = true;
constexpr float WSCALE = 32.0f, WSCALE_INV = 1.0f / 32.0f;
constexpr bool MIX_FP8 = true;
constexpr int MIX_EB = MIX_FP8 ? 1 : 2;
#ifndef P5_FP8_DEF
#define P5_FP8_DEF 1
#endif
constexpr bool P5_FP8 = MIX_FP8 && P5_FP8_DEF;
constexpr int P5_EB = P5_FP8 ? 1 : 2;
constexpr int MOE_EB = MOE_FP8 ? 1 : 2;

struct Frame {
    LAS unsigned char* lds; volatile LAS unsigned* MISC; unsigned* ctl;
    int tid, lane, wave, vcu, G;
    const float *x, *c, *w_ada, *b_ada, *g_mix, *w_in, *b_in, *sinks, *w_a, *w_b, *w_out, *g_ffn, *w_r, *b_r, *w_gu, *b_gu, *w_dn, *b_dn, *g_fin; const int* pos;
    float* out; unsigned char* ws;
};
__device__ __forceinline__ void refresh(Frame& F) { F.lane = lane_id(); F.tid = F.wave * 64 + F.lane; }
template <class T> __device__ __forceinline__ T* wsp(const Frame& F, size_t off) { return (T*)(F.ws + off); }

__device__ __forceinline__ float wave_sum(float v) {
#pragma unroll
    for (int o = 1; o < 64; o <<= 1) v += __shfl_xor(v, o);
    return v;
}

struct DenseSched {
    static constexpr bool GATHER = false, RAGGED = false;
    const char* A; const char* Bt; unsigned lda2, ldb2; int K; int nM, nN, nwg, G, c;
    __device__ __forceinline__ void init(const void* A_, unsigned lda2_, const void* Bt_, unsigned ldb2_, int K_, int M, int N, int G_, int c_) {
        A = (const char*)A_; Bt = (const char*)Bt_; lda2 = lda2_; ldb2 = ldb2_; K = K_; nM = M / BM; nN = N / BM; nwg = nM * nN; G = G_; c = c_; }
    __device__ __forceinline__ bool tile(long L, Unit& u) const {
        if (L >= nwg) return false;
        int wgid = (int)L; { const int q = nwg / NXCD, r = nwg % NXCD, xcd = wgid % NXCD, off = wgid / NXCD; wgid = (xcd < r ? xcd * (q + 1) : r * (q + 1) + (xcd - r) * q) + off; }
        const int nig = WGM * nN, gid = wgid / nig, fm = gid * WGM, gsz = (nM - fm) < WGM ? (nM - fm) : WGM;
        u.pm = fm + ((wgid % nig) % gsz); u.pn = (wgid % nig) / gsz; u.aux = 0; return true; }
    __device__ __forceinline__ bool next(int i, Unit& u) const { return tile((long)i * G + c, u); }
    __device__ __forceinline__ const char* a_base(const Unit& u) const { return A + (size_t)u.pm * BM * lda2; }
    __device__ __forceinline__ unsigned a_rowoff(const Unit&, int, int R) const { return (unsigned)R * lda2; }
    __device__ __forceinline__ const char* b_base(const Unit& u) const { return Bt + (size_t)u.pn * BM * ldb2; }
};
struct BranchSched {
    static constexpr bool GATHER = false, RAGGED = false;
    DenseSched d; unsigned ldb2; int K;
    __device__ __forceinline__ bool next(int i, Unit& u) const { if (!d.tile((long)(i >> 1) * d.G + d.c, u)) return false; u.aux = i & 1; return true; }
    __device__ __forceinline__ const char* a_base(const Unit& u) const { return d.A + (size_t)u.pm * BM * (2048 * MIX_EB) + (size_t)u.aux * (1024 * MIX_EB); }
    __device__ __forceinline__ unsigned a_rowoff(const Unit&, int, int R) const { return (unsigned)R * (2048u * MIX_EB); }
    __device__ __forceinline__ const char* b_base(const Unit& u) const { return d.Bt + ((size_t)u.aux * 2048 + (size_t)u.pn * BM) * (1024 * MIX_EB); }
};
template <bool GATHER_>
struct MoeSched {
    static constexpr bool GATHER = GATHER_, gather = GATHER_, RAGGED = true;
    const volatile LAS unsigned* cnt;
    __device__ __forceinline__ int rows(const Unit& u) const { const int r = (int)cnt[u.aux] - (u.pm - (int)tpre[u.aux]) * 256; return r < 256 ? r : 256; }
    const volatile LAS unsigned* tpre; const LAS unsigned* tbl; const char* A; const char* Bt; int NN; unsigned ldb2; int K; int G, vcu;
    size_t b_estride;
    const volatile LAS unsigned* hpre; const volatile LAS unsigned* lexp; int nlight;
    __device__ __forceinline__ bool next(int i, Unit& u) const {
        const int L = i * G + vcu; const int NH = NN * (int)hpre[32];
        if (L < NH) {
            int e = 0;
            for (int j = 1; j < 32; ++j) if (NN * (int)hpre[j] <= L) e = j;
            const int l = L - NN * (int)hpre[e], T = (int)hpre[e + 1] - (int)hpre[e];
            u.pn = l / T; u.pm = (int)tpre[e] + (l - u.pn * T); u.aux = e; return true; }
        const int l2 = L - NH, j = l2 / NN; if (j >= nlight) return false;
        const int e = (int)lexp[j]; u.pn = l2 - j * NN; u.pm = (int)tpre[e + 1] - 1; u.aux = e; return true; }
    __device__ __forceinline__ const char* a_base(const Unit& u) const { return gather ? A : A + (size_t)u.pm * BM * (2048 * MOE_EB); }
    __device__ __forceinline__ unsigned a_rowoff(const Unit&, int ui, int R) const { return gather ? tbl[ui * 256 + R] : (unsigned)R * (2048u * MOE_EB); }
    __device__ __forceinline__ const char* b_base(const Unit& u) const { return Bt + (size_t)u.aux * b_estride + (size_t)u.pn * BM * ldb2; }
};

__device__ __forceinline__ void st8bf(bf16_t* p, f32x4 a, f32x4 b) { u32x4 w; w.x = pk2(a[0], a[1]); w.y = pk2(a[2], a[3]); w.z = pk2(b[0], b[1]); w.w = pk2(b[2], b[3]); *(u32x4*)p = w; }
struct EpiInProj {
    static constexpr bool PERM = true;
    bf16_t *QA, *KA, *VA, *QB, *KB, *VB, *SGA, *SGB; const float* bias; const float* cosT; const float* sinT;
    __device__ __forceinline__ void operator()(const f32x4 (&acc)[2][2][4][2], const Unit& u, int wr, int wc, int fr, int fq) const {
        const int pn = u.pn, row0 = u.pm * BM + wr * 64 + fr, cw = wc * 32 + 8 * fq;
        const float ws = MIX_FP8 ? WSCALE_INV : 1.0f;
        f32x4 bv[2][2];
#pragma unroll
        for (int bj = 0; bj < 2; ++bj)
#pragma unroll
            for (int n = 0; n < 2; ++n) bv[bj][n] = *(const f32x4*)(bias + pn * 256 + bj * 128 + cw + 4 * n);
        if (pn < 5) {
            bf16_t* O = pn < 4 ? QA : KA; const int ldo = pn < 4 ? 1024 : 256; const int hcol = (pn < 4 ? pn * 256 : 0) + wc * 64 + 8 * fq; const float qs = pn < 4 ? QSCALE : 1.0f;
#pragma unroll
            for (int ai = 0; ai < 2; ++ai)
#pragma unroll
                for (int m = 0; m < 4; ++m) { const int row = row0 + ai * HALF + m * 16;
                    f32x4 o1[2], o2[2];
#pragma unroll
                    for (int n = 0; n < 2; ++n) { const f32x4 cs = *(const f32x4*)(cosT + (size_t)row * 32 + 8 * fq + 4 * n), sn = *(const f32x4*)(sinT + (size_t)row * 32 + 8 * fq + 4 * n);
                        const f32x4 x1 = acc[ai][0][m][n] * ws + bv[0][n], x2 = acc[ai][1][m][n] * ws + bv[1][n];
                        o1[n] = (x1 * cs - x2 * sn) * qs; o2[n] = (x2 * cs + x1 * sn) * qs; }
                    bf16_t* rp = O + (size_t)row * ldo + hcol; st8bf(rp, o1[0], o1[1]); st8bf(rp + 32, o2[0], o2[1]); }
        } else if (pn < 18) {
            bf16_t* O; int ldo, col0; float sc = 1.0f;
            if (pn == 5) { O = VA; ldo = 256; col0 = 0; } else if (pn < 10) { O = QB; ldo = 1024; col0 = (pn - 6) * 256; sc = QSCALE; } else if (pn < 14) { O = KB; ldo = 1024; col0 = (pn - 10) * 256; } else { O = VB; ldo = 1024; col0 = (pn - 14) * 256; }
#pragma unroll
            for (int ai = 0; ai < 2; ++ai)
#pragma unroll
                for (int m = 0; m < 4; ++m) { bf16_t* rp = O + (size_t)(row0 + ai * HALF + m * 16) * ldo + col0 + cw;
#pragma unroll
                    for (int bj = 0; bj < 2; ++bj) st8bf(rp + bj * HALF, (acc[ai][bj][m][0] * ws + bv[bj][0]) * sc, (acc[ai][bj][m][1] * ws + bv[bj][1]) * sc); }
        } else {
            bf16_t* O = pn < 26 ? SGA : SGB; const int col0 = ((pn - 18) & 7) * 256;
#pragma unroll
            for (int ai = 0; ai < 2; ++ai)
#pragma unroll
                for (int m = 0; m < 4; ++m) { bf16_t* rp = O + (size_t)(row0 + ai * HALF + m * 16) * 2048 + col0 + cw;
#pragma unroll
                    for (int bj = 0; bj < 2; ++bj) { f32x4 a = acc[ai][bj][m][0] * ws + bv[bj][0], b = acc[ai][bj][m][1] * ws + bv[bj][1];
#pragma unroll
                        for (int j = 0; j < 4; ++j) { a[j] = fast_sigmoid(a[j]); b[j] = fast_sigmoid(b[j]); }
                        st8bf(rp + bj * HALF, a, b); } }
        }
    }
};
struct EpiBranch {
    static constexpr bool PERM = true;
    const bf16_t *SGA, *SGB; float* T1; unsigned char* MERGED;
    __device__ __forceinline__ void operator()(const f32x4 (&acc)[2][2][4][2], const Unit& u, int wr, int wc, int fr, int fq) const {
        const int row0 = u.pm * BM + wr * 64 + fr, col0 = u.pn * BM + wc * 32 + 8 * fq;
        const bf16_t* SG = u.aux ? SGB : SGA;
#pragma unroll
        for (int ai = 0; ai < 2; ++ai)
#pragma unroll
            for (int m = 0; m < 4; ++m) { const size_t off = (size_t)(row0 + ai * HALF + m * 16) * 2048 + col0;
#pragma unroll
                for (int bj = 0; bj < 2; ++bj) { const u32x4 g = *(const u32x4*)(SG + off + bj * HALF);
                    const f32x4 g0 = {bflo(g.x), bfhi(g.x), bflo(g.y), bfhi(g.y)}, g1 = {bflo(g.z), bfhi(g.z), bflo(g.w), bfhi(g.w)};
                    const float ws = MIX_FP8 ? WSCALE_INV : 1.0f;
                    f32x4 a = acc[ai][bj][m][0] * g0 * ws, b = acc[ai][bj][m][1] * g1 * ws;
                    float* tp = T1 + off + bj * HALF;
                    if (u.aux == 0) { *(f32x4*)tp = a; *(f32x4*)(tp + 4) = b; }
                    else { a += *(const f32x4*)tp; b += *(const f32x4*)(tp + 4);
                        if constexpr (P5_FP8) { u32x2 w; w.x = pk4_fp8(a[0], a[1], a[2], a[3]); w.y = pk4_fp8(b[0], b[1], b[2], b[3]); *(u32x2*)(MERGED + off + bj * HALF) = w; }
                        else st8bf((bf16_t*)MERGED + off + bj * HALF, a, b); } } }
    }
};
struct EpiOut {
    static constexpr bool PERM = false;
    const float* x; const float* mod; float* H1;
    __device__ __forceinline__ void operator()(const f32x4 (&acc)[2][2][4][2], const Unit& u, int wr, int wc, int fr, int fq) const {
        const int row0 = u.pm * BM + wr * 64 + fr, col0 = u.pn * BM + wc * 32 + 4 * fq; const float* gt = mod + (size_t)(u.pm >> 3) * MODW + 4096;
#pragma unroll
        for (int bj = 0; bj < 2; ++bj)
#pragma unroll
            for (int n = 0; n < 2; ++n) { const int col = col0 + bj * HALF + n * 16; const f32x4 g = *(const f32x4*)(gt + col);
#pragma unroll
                for (int ai = 0; ai < 2; ++ai)
#pragma unroll
                    for (int m = 0; m < 4; ++m) { const size_t off = (size_t)(row0 + ai * HALF + m * 16) * 2048 + col; *(f32x4*)(H1 + off) = *(const f32x4*)(x + off) + g * (acc[ai][bj][m][n] * (P5_FP8 ? WSCALE_INV : 1.0f)); } }
    }
};
struct EpiGU {
    static constexpr bool PERM = true;
    const float* b_gu; unsigned char* ACT;
    __device__ __forceinline__ void operator()(const f32x4 (&acc)[2][2][4][2], const Unit& u, int wr, int wc, int fr, int fq) const {
        const int row0 = u.pm * BM + wr * 64 + fr, cw = wc * 32 + 8 * fq; const float* bg = b_gu + (size_t)u.aux * 4096 + u.pn * 128 + cw;
        const float ws = MOE_FP8 ? WSCALE_INV : 1.0f;
        f32x4 bv[2][2];
#pragma unroll
        for (int bj = 0; bj < 2; ++bj)
#pragma unroll
            for (int n = 0; n < 2; ++n) bv[bj][n] = *(const f32x4*)(bg + bj * 2048 + 4 * n);
#pragma unroll
        for (int ai = 0; ai < 2; ++ai)
#pragma unroll
            for (int m = 0; m < 4; ++m) { f32x4 o[2];
#pragma unroll
                for (int n = 0; n < 2; ++n) { const f32x4 g = acc[ai][0][m][n] * ws + bv[0][n], l = acc[ai][1][m][n] * ws + bv[1][n];
#pragma unroll
                    for (int j = 0; j < 4; ++j) { const float gg = fminf(g[j], 7.0f), ll = fminf(fmaxf(l[j], -7.0f), 7.0f);
                        o[n][j] = gg * (ll + 1.0f) * __builtin_amdgcn_rcpf(1.0f + __builtin_amdgcn_exp2f(-1.702f * LOG2E * gg)); } }
                const size_t eo = (size_t)(row0 + ai * HALF + m * 16) * 2048 + u.pn * 128 + cw;
                if constexpr (MOE_FP8) { u32x2 w; w.x = pk4_fp8(o[0][0], o[0][1], o[0][2], o[0][3]); w.y = pk4_fp8(o[1][0], o[1][1], o[1][2], o[1][3]); *(u32x2*)(ACT + eo) = w; }
                else st8bf((bf16_t*)ACT + eo, o[0], o[1]); }
    }
};
struct EpiDown {
    static constexpr bool PERM = true;
    const float* b_dn; bf16_t* YS;
    __device__ __forceinline__ void operator()(const f32x4 (&acc)[2][2][4][2], const Unit& u, int wr, int wc, int fr, int fq) const {
        const int row0 = u.pm * BM + wr * 64 + fr, col0 = u.pn * BM + wc * 32 + 8 * fq; const float* bd = b_dn + (size_t)u.aux * 2048 + col0;
        const float ws = MOE_FP8 ? WSCALE_INV : 1.0f;
        f32x4 bv[2][2];
#pragma unroll
        for (int bj = 0; bj < 2; ++bj)
#pragma unroll
            for (int n = 0; n < 2; ++n) bv[bj][n] = *(const f32x4*)(bd + bj * HALF + 4 * n);
#pragma unroll
        for (int ai = 0; ai < 2; ++ai)
#pragma unroll
            for (int m = 0; m < 4; ++m) { bf16_t* rp = YS + (size_t)(row0 + ai * HALF + m * 16) * 2048 + col0;
#pragma unroll
                for (int bj = 0; bj < 2; ++bj) st8bf(rp + bj * HALF, acc[ai][bj][m][0] * ws + bv[bj][0], acc[ai][bj][m][1] * ws + bv[bj][1]); }
    }
};

__device__ __forceinline__ int in_src(int r) { const int pn = r >> 8, c = r & 255; if (pn < 5) return pn * 256 + ((c & 127) >> 5) * 64 + (c >> 7) * 32 + (c & 31); return pn < 18 ? r : r + 16; }
__device__ __forceinline__ void transpose_item(const float* __restrict__ W, size_t ldw, int k0, int src0, int src1, bf16_t* __restrict__ WT, size_t ldk, int dst0, LAS unsigned* scr, int lane) {
    const int lg = lane >> 4, lc = lane & 15;
    const int scol = (lc < 8 ? src0 : src1 - 32) + 4 * lc;
    f32x4 v[8][2];
#pragma unroll
    for (int i = 0; i < 8; ++i)
#pragma unroll
        for (int p = 0; p < 2; ++p) v[i][p] = *(const f32x4*)(W + (size_t)(k0 + 8 * i + 2 * lg + p) * ldw + scol);
#pragma unroll
    for (int i = 0; i < 8; ++i)
#pragma unroll
        for (int c = 0; c < 4; ++c) scr[(4 * lc + c) * 33 + 4 * i + lg] = pk2(v[i][0][c], v[i][1][c]);
    asm volatile("s_waitcnt lgkmcnt(0)" ::: "memory");
    const int rn = lane >> 3, ch = lane & 7;
#pragma unroll
    for (int j = 0; j < 8; ++j) { const int n = rn + 8 * j; const LAS unsigned* s = scr + n * 33 + 4 * ch; u32x4 o; o.x = s[0]; o.y = s[1]; o.z = s[2]; o.w = s[3];
        *(u32x4*)(WT + (size_t)(dst0 + n) * ldk + k0 + 8 * ch) = o; }
    asm volatile("s_waitcnt lgkmcnt(0)" ::: "memory");
}
__device__ __forceinline__ void transpose_item_f8(const float* __restrict__ W, size_t ldw, int k0, int src0, int src1, unsigned char* __restrict__ WT, size_t ldk, int dst0, LAS unsigned* scr, int lane, float scale) {
    const int lg = lane >> 4, lc = lane & 15;
    const float* wp = W + (size_t)(k0 + 4 * lg) * ldw + (lc < 8 ? src0 : src1 - 32) + 4 * lc;
#pragma unroll
    for (int hf = 0; hf < 2; ++hf) {
        f32x4 v[4][4];
#pragma unroll
        for (int i = 0; i < 4; ++i)
#pragma unroll
            for (int p = 0; p < 4; ++p) v[i][p] = *(const f32x4*)(wp + (size_t)(64 * hf + 16 * i + p) * ldw);
#pragma unroll
        for (int i = 0; i < 4; ++i)
#pragma unroll
            for (int c = 0; c < 4; ++c) scr[(4 * lc + c) * 33 + 16 * hf + 4 * i + lg] = pk4_fp8_raw(v[i][0][c] * scale, v[i][1][c] * scale, v[i][2][c] * scale, v[i][3][c] * scale);
    }
    asm volatile("s_waitcnt lgkmcnt(0)" ::: "memory");
    const int rn = lane >> 3, ch = lane & 7;
#pragma unroll
    for (int j = 0; j < 8; ++j) { const int n = rn + 8 * j; const LAS unsigned* s = scr + n * 33 + 4 * ch; u32x4 o; o.x = s[0]; o.y = s[1]; o.z = s[2]; o.w = s[3];
        *(u32x4*)(WT + (size_t)(dst0 + n) * ldk + k0 + 16 * ch) = o; }
    asm volatile("s_waitcnt lgkmcnt(0)" ::: "memory");
}
__device__ __forceinline__ void p0_prologue(Frame& F) {
    refresh(F);
    LAS unsigned* scr = (LAS unsigned*)(F.lds + RING_OFF + F.wave * 8448);
    LAS f32x4* ca = (LAS f32x4*)(F.lds + RING_OFF + 69632);
    for (int k = F.tid; k < 2048; k += NWAVES * 64) { f32x4 v;
#pragma unroll
        for (int b = 0; b < 4; ++b) { const float cv = F.c[b * 2048 + k]; v[b] = cv / (1.0f + expf(-cv)); }
        ca[k] = v; }
    __syncthreads();
    const int gw = F.vcu * NWAVES + F.wave, NGW = F.G * NWAVES, lane = F.lane;
    constexpr int KD = MIX_FP8 ? 128 : 64;
    constexpr int T_ADA = 768, T_ROPE = 256, T_BIAS = 1, T_WIN = (2048 / KD) * 136, T_WA = (1024 / KD) * 32, T_WB = (1024 / KD) * 32, T_WOUT = (2048 / KD) * 32;
    constexpr int NT = T_ADA + T_ROPE + T_BIAS + T_WIN + T_WA + T_WB + T_WOUT;
    float* mod = wsp<float>(F, WS_MOD); float* cosT = wsp<float>(F, WS_COS); float* sinT = wsp<float>(F, WS_SIN); float* binp = wsp<float>(F, WS_BINP);
    for (int it = gw; it < NT; it += NGW) {
        int r = it;
        if (r < T_ADA) {
            const int j0 = 16 * r, cl = lane & 3, kr = lane >> 2;
            f32x4 a[4];
#pragma unroll
            for (int b = 0; b < 4; ++b) a[b] = (f32x4){0.f, 0.f, 0.f, 0.f};
            const float* wp = F.w_ada + (size_t)kr * MODW + j0 + 4 * cl;
#pragma unroll 8
            for (int s = 0; s < 128; ++s) { const f32x4 w4 = *(const f32x4*)(wp + (size_t)s * 16 * MODW); const f32x4 c4 = ca[16 * s + kr];
#pragma unroll
                for (int b = 0; b < 4; ++b) a[b] += w4 * c4[b]; }
#pragma unroll
            for (int b = 0; b < 4; ++b)
#pragma unroll
                for (int c = 0; c < 4; ++c) { float v = a[b][c]; v += __shfl_xor(v, 4); v += __shfl_xor(v, 8); v += __shfl_xor(v, 16); v += __shfl_xor(v, 32); a[b][c] = v; }
            if (kr == 0) { const f32x4 bb = *(const f32x4*)(F.b_ada + j0 + 4 * cl);
#pragma unroll
                for (int b = 0; b < 4; ++b) *(f32x4*)(mod + b * MODW + j0 + 4 * cl) = a[b] + bb; }
            continue; } r -= T_ADA;
        if (r < T_ROPE) {
            const int i = lane & 31, ts = lane >> 5; const float inv = 1.0f / powf(10000.0f, (float)(2 * i) / 64.0f);
            for (int j = 0; j < 16; ++j) { const int t = 32 * r + 2 * j + ts; const float ang = (float)F.pos[t] * inv; cosT[t * 32 + i] = cosf(ang); sinT[t * 32 + i] = sinf(ang); }
            continue; } r -= T_ROPE;
        if (r < T_BIAS) { for (int q = lane; q < 8704; q += 64) binp[q] = F.b_in[in_src(q)]; continue; } r -= T_BIAS;
        const float* W; size_t ldw; int kb, nb, s0, s1; unsigned char* WT; size_t ldk;
        if (r < T_WIN) { kb = r / 136; nb = r % 136; W = F.w_in; ldw = INW; s0 = in_src(64 * nb); s1 = in_src(64 * nb + 32); WT = wsp<unsigned char>(F, WS_WIN); ldk = 2048; }
        else if ((r -= T_WIN) < T_WA) { kb = r / 32; nb = r % 32; W = F.w_a; ldw = 2048; s0 = 64 * nb; s1 = s0 + 32; WT = wsp<unsigned char>(F, WS_WAB); ldk = 1024; }
        else if ((r -= T_WA) < T_WB) { kb = r / 32; nb = r % 32; W = F.w_b; ldw = 2048; s0 = 64 * nb; s1 = s0 + 32; WT = wsp<unsigned char>(F, WS_WAB) + (size_t)2048 * 1024 * MIX_EB; ldk = 1024; }
        else { r -= T_WB; W = F.w_out; ldw = 2048; WT = wsp<unsigned char>(F, WS_WOUT); ldk = 2048;
            if constexpr (MIX_FP8 && !P5_FP8) { kb = r / 32; nb = r % 32; s0 = 64 * nb; s1 = s0 + 32;
                transpose_item(W, ldw, 128 * kb, s0, s1, (bf16_t*)WT, ldk, 64 * nb, scr, lane); transpose_item(W, ldw, 128 * kb + 64, s0, s1, (bf16_t*)WT, ldk, 64 * nb, scr, lane); continue; }
            kb = r / 32; nb = r % 32; s0 = 64 * nb; s1 = s0 + 32; }
        if constexpr (MIX_FP8) transpose_item_f8(W, ldw, 128 * kb, s0, s1, WT, ldk, 64 * nb, scr, lane, WSCALE);
        else transpose_item(W, ldw, 64 * kb, s0, s1, (bf16_t*)WT, ldk, 64 * nb, scr, lane);
    }
}
constexpr int T_WGU = MOE_FP8 ? 32 * 16 * 64 : 32 * 32 * 64, T_WD = MOE_FP8 ? 32 * 16 * 32 : 32 * 32 * 32;
__device__ __forceinline__ void convert_item(Frame& F, int r, LAS unsigned* scr, int lane) {
    if (r < T_WGU) {
        if constexpr (MOE_FP8) { const int e = r >> 10, q = r & 1023, kb = q >> 6, nb = q & 63; const int r0 = 64 * nb, src = ((r0 & 255) >> 7) * 2048 + (r0 >> 8) * 128 + (r0 & 127);
            transpose_item_f8(F.w_gu + (size_t)e * 2048 * 4096, 4096, 128 * kb, src, src + 32, wsp<unsigned char>(F, WS_WGU) + (size_t)e * 4096 * 2048, 2048, r0, scr, lane, WSCALE); }
        else { const int e = r >> 11, q = r & 2047, kb = q >> 6, nb = q & 63; const int r0 = 64 * nb, src = ((r0 & 255) >> 7) * 2048 + (r0 >> 8) * 128 + (r0 & 127);
            transpose_item(F.w_gu + (size_t)e * 2048 * 4096, 4096, 64 * kb, src, src + 32, wsp<bf16_t>(F, WS_WGU) + (size_t)e * 4096 * 2048, 2048, r0, scr, lane); }
        return; }
    r -= T_WGU;
    if constexpr (MOE_FP8) { const int e = r >> 9, q = r & 511, kb = q >> 5, nb = q & 31;
        transpose_item_f8(F.w_dn + (size_t)e * 2048 * 2048, 2048, 128 * kb, 64 * nb, 64 * nb + 32, wsp<unsigned char>(F, WS_WD) + (size_t)e * 2048 * 2048, 2048, 64 * nb, scr, lane, WSCALE); }
    else { const int e = r >> 10, q = r & 1023, kb = q >> 5, nb = q & 31;
        transpose_item(F.w_dn + (size_t)e * 2048 * 2048, 2048, 64 * kb, 64 * nb, 64 * nb + 32, wsp<bf16_t>(F, WS_WD) + (size_t)e * 2048 * 2048, 2048, 64 * nb, scr, lane); }
}
struct CvItem { const char* src; unsigned char* dst; };
template <bool GU> __device__ __forceinline__ CvItem cv_decode(Frame& F, int r) {
    constexpr int N = GU ? T_WGU : T_WD; constexpr size_t ldw = GU ? 4096 : 2048;
    r = r < N ? r : 0;
    const int e = r >> (GU ? 10 : 9), q = r & (GU ? 1023 : 511), kb = q >> (GU ? 6 : 5), nb = q & (GU ? 63 : 31), r0 = 64 * nb;
    const int srcc = GU ? ((r0 & 255) >> 7) * 2048 + (r0 >> 8) * 128 + (r0 & 127) : r0;
    CvItem P;
    P.src = (const char*)((GU ? F.w_gu : F.w_dn) + (size_t)e * 2048 * ldw + (size_t)(128 * kb) * ldw + srcc);
    P.dst = (GU ? wsp<unsigned char>(F, WS_WGU) : wsp<unsigned char>(F, WS_WD)) + (size_t)e * ldw * 2048 + (size_t)r0 * 2048 + 128 * kb;
    return P;
}
template <bool GU> __device__ __forceinline__ void convert_loop(Frame& F, unsigned* head) {
    constexpr int N = GU ? T_WGU : T_WD, NP = (N + 2) / 3 * 3; constexpr unsigned ldwb = (GU ? 4096u : 2048u) * 4u;
    LAS unsigned* scr = (LAS unsigned*)(F.lds + RING_OFF + F.wave * 8448);
    const int lane = F.lane, lg = lane >> 4, lc = lane & 15, rn = lane >> 3, ch = lane & 7;
    const unsigned lo = (unsigned)(4 * lg) * ldwb + 16u * (unsigned)lc;
    f32x4 A[4][4], B[4][4], C[4][4];
#define CV_LOAD(buf, P, h) do { _Pragma("unroll") for (int i = 0; i < 4; ++i) _Pragma("unroll") for (int p = 0; p < 4; ++p) { const char* rb_ = (P).src + (size_t)(64 * (h) + 16 * i + p) * ldwb; \
        asm volatile("global_load_dwordx4 %0, %1, %2 nt" : "=v"(buf[i][p]) : "v"(lo), "s"(rb_) : "memory"); } } while (0)
#define CV_WAIT(N, buf) do { asm volatile("s_waitcnt vmcnt(" #N ")" ::: "memory"); _Pragma("unroll") for (int i = 0; i < 4; ++i) asm volatile("" : "+v"(buf[i][0]), "+v"(buf[i][1]), "+v"(buf[i][2]), "+v"(buf[i][3])); } while (0)
#define CV_PROC(buf, h) do { _Pragma("unroll") for (int i = 0; i < 4; ++i) _Pragma("unroll") for (int c = 0; c < 4; ++c) \
        scr[(4 * lc + c) * 33 + 16 * (h) + 4 * i + lg] = pk4_fp8_raw(buf[i][0][c] * WSCALE, buf[i][1][c] * WSCALE, buf[i][2][c] * WSCALE, buf[i][3][c] * WSCALE); } while (0)
#define CV_STORE(P) do { _Pragma("unroll") for (int j = 0; j < 8; ++j) { const LAS unsigned* s_ = scr + (rn + 8 * j) * 33 + 4 * ch; u32x4 o_; o_.x = s_[0]; o_.y = s_[1]; o_.z = s_[2]; o_.w = s_[3]; \
        const unsigned so_ = (unsigned)(rn + 8 * j) * 2048u + 16u * (unsigned)ch; asm volatile("global_store_dwordx4 %0, %1, %2 nt" :: "v"(so_), "v"(o_), "s"((P).dst) : "memory"); } } while (0)
    const unsigned claim_add = 3u, claim_off = 0u; unsigned long long ex_save;
#define CV_CLAIM() asm volatile("s_mov_b64 %1, exec\n\ts_mov_b64 exec, 1\n\tglobal_atomic_add %0, %2, %3, %4 sc0\n\ts_mov_b64 exec, %1" : "+v"(raw), "=&s"(ex_save) : "v"(claim_off), "v"(claim_add), "s"(head) : "memory")
    unsigned raw = 0u;
    CV_CLAIM();
    asm volatile("s_waitcnt vmcnt(0)" : "+v"(raw) :: "memory");
    int base = (int)__builtin_amdgcn_readfirstlane(raw);
    CV_CLAIM();
    CvItem P0 = cv_decode<GU>(F, base), P1, P2;
    CV_LOAD(A, P0, 0); CV_LOAD(B, P0, 1);
    {
      unsigned char* junk = wsp<unsigned char>(F, WS_JUNK) + (size_t)(blockIdx.x * NWAVES + F.wave) * 16384; const u32x4 zz_ = {0u, 0u, 0u, 0u};
#pragma unroll
      for (int j = 0; j < 8; ++j) { const unsigned so_ = (unsigned)(rn + 8 * j) * 128u + 16u * (unsigned)ch; asm volatile("global_store_dwordx4 %0, %1, %2 nt" :: "v"(so_), "v"(zz_), "s"(junk) : "memory"); } }
    while (base < NP) {
        P1 = cv_decode<GU>(F, base + 1); P2 = cv_decode<GU>(F, base + 2);
        CV_LOAD(C, P1, 0); CV_WAIT(40, A); CV_PROC(A, 0);
        CV_LOAD(A, P1, 1); CV_WAIT(40, B); CV_PROC(B, 1); CV_STORE(P0);
        CV_LOAD(B, P2, 0); CV_WAIT(40, C); CV_PROC(C, 0);
        CV_LOAD(C, P2, 1); CV_WAIT(40, A); CV_PROC(A, 1); CV_STORE(P1);
        asm volatile("s_waitcnt vmcnt(48)" : "+v"(raw) :: "memory");
        base = (int)__builtin_amdgcn_readfirstlane(raw);
        CV_CLAIM();
        P0 = cv_decode<GU>(F, base);
        CV_LOAD(A, P0, 0); CV_WAIT(41, B); CV_PROC(B, 0);
        CV_LOAD(B, P0, 1); CV_WAIT(41, C); CV_PROC(C, 1); CV_STORE(P2);
    }
#undef CV_WAIT
    asm volatile("s_waitcnt vmcnt(0)" ::: "memory");
#undef CV_CLAIM
#undef CV_LOAD
#undef CV_PROC
#undef CV_STORE
}
__device__ __forceinline__ void convert_queue(Frame& F) {
    refresh(F);
    __syncthreads();
    if constexpr (!MOE_FP8) {
        LAS unsigned* scr0 = (LAS unsigned*)(F.lds + RING_OFF + F.wave * 8448); unsigned* head0 = F.ctl + CW_CQ; constexpr int NQ0 = T_WGU + T_WD;
        for (;;) { unsigned raw0 = 0u; if (F.lane == 0) raw0 = __hip_atomic_fetch_add(head0, 1u, __ATOMIC_RELAXED, __HIP_MEMORY_SCOPE_AGENT); const int it = (int)__builtin_amdgcn_readfirstlane(raw0); if (it >= NQ0) break; convert_item(F, it, scr0, F.lane); }
        __syncthreads(); return; }
    convert_loop<true>(F, F.ctl + CW_CQ);
    convert_loop<false>(F, F.ctl + CW_CQ + 128);
    __syncthreads();
}


constexpr int CS_GU = 32 * 8 * 16, CS_DN = 32 * 8 * 8, CS_N = CS_GU + CS_DN, CS_PITCH = 65;
__device__ __forceinline__ void convert_coop(Frame& F) {
    refresh(F);
    __syncthreads();
    LAS unsigned* tile0 = (LAS unsigned*)(F.lds + RING_OFF);
    unsigned* head = F.ctl + CW_CQ + 256;
    const int lane = F.lane, w = F.wave;
    if (F.tid == 0) F.MISC[104] = __hip_atomic_fetch_add(head, 1u, __ATOMIC_RELAXED, __HIP_MEMORY_SCOPE_AGENT);
    __syncthreads();
    int slot = 0, p = 0;
    for (;;) {
        const int it = (int)F.MISC[104 + slot];
        if (it >= CS_N) break;
        if (F.tid == 0) F.MISC[104 + (slot ^ 1)] = __hip_atomic_fetch_add(head, 1u, __ATOMIC_RELAXED, __HIP_MEMORY_SCOPE_AGENT);
        const bool gu = it < CS_GU; const int r = gu ? it : it - CS_GU;
        const int e = gu ? (r >> 7) : (r >> 6), q = gu ? (r & 127) : (r & 63), kb = gu ? (q >> 4) : (q >> 3), nb = gu ? (q & 15) : (q & 7);
        const size_t ldw = gu ? 4096 : 2048;
        const float* W = (gu ? F.w_gu : F.w_dn) + (size_t)e * 2048 * ldw + (size_t)(256 * kb + 32 * w) * ldw;
        const int scol = gu ? ((lane >> 5) * 2048 + nb * 128 + 4 * (lane & 31)) : (nb * 256 + 4 * lane);
        unsigned char* O = (gu ? wsp<unsigned char>(F, WS_WGU) : wsp<unsigned char>(F, WS_WD)) + (size_t)e * ldw * 2048 + (size_t)(256 * nb) * 2048 + 256 * kb;
        LAS unsigned* T = tile0 + p * (256 * CS_PITCH);
        f32x4 v[32];
#pragma unroll
        for (int i = 0; i < 32; ++i) v[i] = __builtin_nontemporal_load((const f32x4*)(W + (size_t)i * ldw + scol));
#pragma unroll
        for (int kk = 0; kk < 8; ++kk)
#pragma unroll
            for (int c = 0; c < 4; ++c) T[(4 * lane + c) * CS_PITCH + 8 * w + kk] = pk4_fp8_raw(v[4 * kk][c] * WSCALE, v[4 * kk + 1][c] * WSCALE, v[4 * kk + 2][c] * WSCALE, v[4 * kk + 3][c] * WSCALE);
        __syncthreads();
#pragma unroll
        for (int i = 0; i < 8; ++i) { const int n = 32 * w + 4 * i + (lane >> 4), ch = lane & 15; const LAS unsigned* s_ = T + n * CS_PITCH + 4 * ch; u32x4 o; o.x = s_[0]; o.y = s_[1]; o.z = s_[2]; o.w = s_[3];
            __builtin_nontemporal_store(o, (u32x4*)(O + (size_t)n * 2048 + 16 * ch)); }
        slot ^= 1; p ^= 1;
    }
    __syncthreads();
}

__device__ __forceinline__ void p1_norm_fb(Frame& F) {
    refresh(F);
#pragma unroll 1
    for (int i0 = F.tid; i0 < 2048 * 4; i0 += 8 * NWAVES * 64) {
        f32x4 v[8];
#pragma unroll
        for (int u = 0; u < 8; ++u) { const int i = i0 + u * NWAVES * 64, k = i >> 2, q = i & 3; v[u] = *(const f32x4*)(F.w_in + (size_t)k * INW + 4608 + 4 * q); }
#pragma unroll
        for (int u = 0; u < 8; ++u) { const int i = i0 + u * NWAVES * 64, k = i >> 2, q = i & 3; const int j = k >> 8, l = (k & 255) >> 2, c = k & 3; *(LAS f32x4*)(F.lds + RING_OFF + ((((j * 4 + c) * 4 + q) * 64 + l) << 4)) = v[u]; } }
    __syncthreads();
    const int gw = F.vcu * NWAVES + F.wave, NGW = F.G * NWAVES, lane = F.lane;
    const float* mod = wsp<float>(F, WS_MOD); unsigned char* XN = wsp<unsigned char>(F, WS_XN); float* LOGF = wsp<float>(F, WS_LOGF);
    for (int row = gw; row < NTOK; row += NGW) {
        const int b = row >> 11; const float* xr = F.x + (size_t)row * DM; const float* sh = mod + b * MODW, *sc = mod + b * MODW + 2048;
        f32x4 v[8]; float ss = 0.f;
#pragma unroll
        for (int j = 0; j < 8; ++j) { v[j] = *(const f32x4*)(xr + 256 * j + 4 * lane); ss += v[j][0] * v[j][0] + v[j][1] * v[j][1] + v[j][2] * v[j][2] + v[j][3] * v[j][3]; }
        ss = wave_sum(ss); const float rstd = 1.0f / sqrtf(ss * (1.0f / DM) + 1e-5f);
        float fa[16];
#pragma unroll
        for (int h = 0; h < 16; ++h) fa[h] = 0.f;
#pragma unroll
        for (int j = 0; j < 8; ++j) { const int col = 256 * j + 4 * lane; const f32x4 g = *(const f32x4*)(F.g_mix + col), s1 = *(const f32x4*)(sc + col), h1 = *(const f32x4*)(sh + col);
            const f32x4 y = v[j] * rstd * g * (s1 + 1.0f) + h1;
            if constexpr (MIX_FP8) *(unsigned*)(XN + (size_t)row * DM + col) = pk4_fp8(y[0], y[1], y[2], y[3]);
            else { u32x2 w; w.x = pk2(y[0], y[1]); w.y = pk2(y[2], y[3]); *(u32x2*)((bf16_t*)XN + (size_t)row * DM + col) = w; }
#pragma unroll
            for (int c = 0; c < 4; ++c) {
#pragma unroll
                for (int q = 0; q < 4; ++q) { const f32x4 wv = *(const LAS f32x4*)(F.lds + RING_OFF + ((((j * 4 + c) * 4 + q) * 64 + lane) << 4));
#pragma unroll
                    for (int e = 0; e < 4; ++e) fa[4 * q + e] += y[c] * wv[e]; }
                if (c & 1) asm volatile("" ::: "memory"); } }
#pragma unroll
        for (int h = 0; h < 16; ++h) fa[h] = wave_sum(fa[h]);
        float mine = 0.f;
#pragma unroll
        for (int h = 0; h < 16; ++h) mine = (lane == h) ? fa[h] : mine;
        if (lane < 16) { const float f = mine + F.b_in[4608 + lane]; LOGF[row * 16 + lane] = fminf(f, 0.f) - log1pf(expf(-fabsf(f))); }
    }
}
__device__ __forceinline__ void p2_cumsum(Frame& F) {
    refresh(F);
    volatile LAS float* wsum_s = (volatile LAS float*)(F.MISC + 96);
    const float* LOGF = wsp<float>(F, WS_LOGF); float* CUM = wsp<float>(F, WS_CUM);
    for (int bh = F.vcu; bh < 64; bh += F.G) {
        const int b = bh >> 4, h = bh & 15, t0 = 4 * F.tid;
        float a[4];
#pragma unroll
        for (int i = 0; i < 4; ++i) a[i] = LOGF[(size_t)(b * SEQ + t0 + i) * 16 + h];
        a[1] += a[0]; a[2] += a[1]; a[3] += a[2];
        float s = a[3];
#pragma unroll
        for (int o = 1; o < 64; o <<= 1) { const float t = __shfl_up(s, o); if (F.lane >= o) s += t; }
        if (F.lane == 63) wsum_s[F.wave] = s;
        __syncthreads();
        float base = 0.f;
        for (int w = 0; w < F.wave; ++w) base += wsum_s[w];
        const float excl = base + s - a[3];
#pragma unroll
        for (int i = 0; i < 4; ++i) CUM[(size_t)bh * SEQ + t0 + i] = excl + a[i];
        __syncthreads();
    }
}

constexpr int AT_KOFF = 0, AT_VOFF = 9216, AT_COFF = 17920, AT_BUF = 18432;
template <int MODE>
__device__ __forceinline__ void attn_unit(LAS unsigned char* lds, const bf16_t* __restrict__ Q, const bf16_t* __restrict__ Kt, const bf16_t* __restrict__ Vt, const float* __restrict__ cum, unsigned char* __restrict__ O,
                                          int b, int h, int qb, float sink2, int wid) {
    const int lane = lane_id(), tid = wid * 64 + lane, r32 = lane & 31, hi = lane >> 5;
    constexpr int KP = MODE ? 1024 : 256;
    const int kvh = MODE ? h : (h >> 2);
    const int q0 = qb * 256, w0 = q0 + 32 * wid;
    const size_t rowbase = (size_t)b * SEQ;
    bf16x8 qf[4];
    { const bf16_t* qp = Q + (rowbase + w0 + r32) * 1024 + h * 64 + hi * 8;
#pragma unroll
      for (int d0 = 0; d0 < 4; ++d0) qf[d0] = *(const bf16x8*)(qp + d0 * 16); }
    const int kt_lo = MODE ? 0 : (q0 >= 128 ? ((q0 - 128) >> 6) : 0), kt_hi = (q0 + 255) >> 6;
    const int skey = tid >> 3, sch = tid & 7, vp = (tid & 255) >> 3;
    const bf16_t* kg = Kt + (rowbase + skey) * KP + kvh * 64 + sch * 8;
    const bf16_t* vg = Vt + (rowbase + 2 * vp) * KP + kvh * 64 + sch * 8;
    u32x4 kreg, vr0, vr1; float ckreg = 0.f;
#define AT_LOAD(kt) do { kreg = *(const u32x4*)(kg + (size_t)(kt) * 64 * KP); if (tid >= 256) { vr0 = *(const u32x4*)(vg + (size_t)(kt) * 64 * KP); vr1 = *(const u32x4*)(vg + (size_t)(kt) * 64 * KP + KP); } \
        if (MODE && tid < 64) ckreg = cum[(kt) * 64 + tid] * LOG2E; } while (0)
    AT_LOAD(kt_lo);
    float m = MODE ? -1e30f : sink2, l = (MODE == 0 && hi == 0) ? 1.0f : 0.0f;
    const float cq2 = MODE ? cum[w0 + r32] * LOG2E : 0.f;
    f32x16 o0 = {}, o1 = {};
    for (int kt = kt_lo; kt <= kt_hi; ++kt) {
        LAS unsigned char* buf = lds + ((kt - kt_lo) & 1) * AT_BUF;
        *(LAS u32x4*)(buf + AT_KOFF + skey * 144 + sch * 16) = kreg;
        if (tid >= 256) {
#pragma unroll
            for (int i = 0; i < 8; ++i) { const unsigned a = vr0[i >> 1], c = vr1[i >> 1];
                *(LAS unsigned*)(buf + AT_VOFF + (8 * sch + i) * 136 + vp * 4) = __builtin_amdgcn_perm(c, a, (i & 1) ? 0x07060302u : 0x05040100u); } }
        if (MODE && tid < 64) *(LAS float*)(buf + AT_COFF + tid * 4) = ckreg;
        __syncthreads();
        if (kt < kt_hi) AT_LOAD(kt + 1);
        const int k0 = kt * 64;
        const bool active = (k0 <= w0 + 31) && (MODE || (k0 + 63 >= w0 - 127));
        if (active) {
            f32x16 p0 = {}, p1 = {};
            { const LAS unsigned char* kb = buf + AT_KOFF + r32 * 144 + hi * 16;
#pragma unroll
              for (int d0 = 0; d0 < 4; ++d0) { const bf16x8 ka = *(const LAS bf16x8*)(kb + d0 * 32), kc = *(const LAS bf16x8*)(kb + 32 * 144 + d0 * 32);
                  p0 = __builtin_amdgcn_mfma_f32_32x32x16_bf16(ka, qf[d0], p0, 0, 0, 0); p1 = __builtin_amdgcn_mfma_f32_32x32x16_bf16(kc, qf[d0], p1, 0, 0, 0); } }
            if (MODE) {
#pragma unroll
                for (int g = 0; g < 4; ++g) { const f32x4 c0 = *(const LAS f32x4*)(buf + AT_COFF + (8 * g + 4 * hi) * 4), c1 = *(const LAS f32x4*)(buf + AT_COFF + (32 + 8 * g + 4 * hi) * 4);
#pragma unroll
                    for (int j = 0; j < 4; ++j) { p0[4 * g + j] += cq2 - c0[j]; p1[4 * g + j] += cq2 - c1[j]; } } }
            const bool need_mask = MODE ? (k0 + 63 > w0) : true;
            if (need_mask) { const int q = w0 + r32;
#pragma unroll
                for (int r = 0; r < 16; ++r) { const int key = k0 + (r & 3) + 8 * (r >> 2) + 4 * hi;
                    const bool v0 = (key <= q) && (MODE || key + 127 >= q), v1 = (key + 32 <= q) && (MODE || key + 32 + 127 >= q);
                    p0[r] = v0 ? p0[r] : -INFINITY; p1[r] = v1 ? p1[r] : -INFINITY; } }
            float rm = __builtin_fmaxf(p0[0], p1[0]);
#pragma unroll
            for (int r = 1; r < 16; ++r) rm = __builtin_fmaxf(__builtin_fmaxf(rm, p0[r]), p1[r]);
            { const unsigned ru = __builtin_bit_cast(unsigned, rm); auto rr = __builtin_amdgcn_permlane32_swap(ru, ru, false, false);
              rm = __builtin_fmaxf(__builtin_bit_cast(float, rr[0]), __builtin_bit_cast(float, rr[1])); }
            const float mn = fmaxf(m, rm), alpha = __builtin_amdgcn_exp2f(m - mn);
            const bool grew = mn > m; m = mn;
            float ps = 0.f;
#pragma unroll
            for (int r = 0; r < 16; ++r) { p0[r] = __builtin_amdgcn_exp2f(p0[r] - mn); p1[r] = __builtin_amdgcn_exp2f(p1[r] - mn); ps += p0[r] + p1[r]; }
            l = l * alpha + ps;
            if (__any(grew)) {
#pragma unroll
                for (int r = 0; r < 16; ++r) { o0[r] *= alpha; o1[r] *= alpha; } }
            bf16x8 pf[4];
            { u32x4 w;
              w.x = pk2(p0[0], p0[1]); w.y = pk2(p0[2], p0[3]); w.z = pk2(p0[4], p0[5]); w.w = pk2(p0[6], p0[7]); pf[0] = __builtin_bit_cast(bf16x8, w);
              w.x = pk2(p0[8], p0[9]); w.y = pk2(p0[10], p0[11]); w.z = pk2(p0[12], p0[13]); w.w = pk2(p0[14], p0[15]); pf[1] = __builtin_bit_cast(bf16x8, w);
              w.x = pk2(p1[0], p1[1]); w.y = pk2(p1[2], p1[3]); w.z = pk2(p1[4], p1[5]); w.w = pk2(p1[6], p1[7]); pf[2] = __builtin_bit_cast(bf16x8, w);
              w.x = pk2(p1[8], p1[9]); w.y = pk2(p1[10], p1[11]); w.z = pk2(p1[12], p1[13]); w.w = pk2(p1[14], p1[15]); pf[3] = __builtin_bit_cast(bf16x8, w); }
            const LAS unsigned char* vb = buf + AT_VOFF + r32 * 136 + hi * 8;
#pragma unroll
            for (int ks = 0; ks < 4; ++ks) {
                { const u32x2 lo = *(const LAS u32x2*)(vb + ks * 32), hh = *(const LAS u32x2*)(vb + ks * 32 + 16); const u32x4 w = {lo.x, lo.y, hh.x, hh.y};
                  o0 = __builtin_amdgcn_mfma_f32_32x32x16_bf16(__builtin_bit_cast(bf16x8, w), pf[ks], o0, 0, 0, 0); }
                { const u32x2 lo = *(const LAS u32x2*)(vb + 32 * 136 + ks * 32), hh = *(const LAS u32x2*)(vb + 32 * 136 + ks * 32 + 16); const u32x4 w = {lo.x, lo.y, hh.x, hh.y};
                  o1 = __builtin_amdgcn_mfma_f32_32x32x16_bf16(__builtin_bit_cast(bf16x8, w), pf[ks], o1, 0, 0, 0); } }
        }
    }
#undef AT_LOAD
    l += __shfl_xor(l, 32);
    const float inv = 1.0f / l;
    const size_t oe = (rowbase + w0 + r32) * 2048 + MODE * 1024 + h * 64 + 4 * hi;
#pragma unroll
    for (int g = 0; g < 4; ++g) {
        if constexpr (MIX_FP8) { *(unsigned*)(O + oe + 8 * g) = pk4_fp8(o0[4 * g] * inv, o0[4 * g + 1] * inv, o0[4 * g + 2] * inv, o0[4 * g + 3] * inv);
            *(unsigned*)(O + oe + 32 + 8 * g) = pk4_fp8(o1[4 * g] * inv, o1[4 * g + 1] * inv, o1[4 * g + 2] * inv, o1[4 * g + 3] * inv); }
        else { bf16_t* op = (bf16_t*)O + oe; u32x2 w; w.x = pk2(o0[4 * g] * inv, o0[4 * g + 1] * inv); w.y = pk2(o0[4 * g + 2] * inv, o0[4 * g + 3] * inv); *(u32x2*)(op + 8 * g) = w;
            w.x = pk2(o1[4 * g] * inv, o1[4 * g + 1] * inv); w.y = pk2(o1[4 * g + 2] * inv, o1[4 * g + 3] * inv); *(u32x2*)(op + 32 + 8 * g) = w; } }
    __syncthreads();
}
__device__ __forceinline__ void p3_attention(Frame& F) {
    refresh(F);
    const bf16_t *QA = wsp<bf16_t>(F, WS_QA), *KA = wsp<bf16_t>(F, WS_KA), *VA = wsp<bf16_t>(F, WS_VA), *QB = wsp<bf16_t>(F, WS_QB), *KB = wsp<bf16_t>(F, WS_KB), *VB = wsp<bf16_t>(F, WS_VB);
    const float* CUM = wsp<float>(F, WS_CUM); unsigned char* YAB = wsp<unsigned char>(F, WS_YAB);
    LAS unsigned char* lds = F.lds + RING_OFF;
    unsigned* head = F.ctl + CW_AQ;
    for (;;) {
        __syncthreads();
        if (F.tid == 0) F.MISC[100] = __hip_atomic_fetch_add(head, 1u, __ATOMIC_RELAXED, __HIP_MEMORY_SCOPE_AGENT);
        __syncthreads();
        const int u = (int)F.MISC[100];
        if (u >= 1024) break;
        if (u < 512) { const int bh = u & 63, qb = 7 - (u >> 6); attn_unit<1>(lds, QB, KB, VB, CUM + (size_t)bh * SEQ, YAB, bh >> 4, bh & 15, qb, 0.f, F.wave); }
        else { const int v = u - 512, bh = v >> 3, qb = v & 7; attn_unit<0>(lds, QA, KA, VA, nullptr, YAB, bh >> 4, bh & 15, qb, F.sinks[bh & 15] * LOG2E, F.wave); }
    }
}

template <int HH>
__device__ __forceinline__ void p6_half(Frame& F) {
    refresh(F);
    const int gw = F.vcu * NWAVES + F.wave, NGW = F.G * NWAVES, lane = F.lane;
    const float* mod = wsp<float>(F, WS_MOD); const float* H1 = wsp<float>(F, WS_H1); unsigned char* XN2 = wsp<unsigned char>(F, WS_XN2);
    int* TEID = wsp<int>(F, WS_TEID); int* TPOS = wsp<int>(F, WS_TPOS); float* TGATE = wsp<float>(F, WS_TGATE); int* TOKOF = wsp<int>(F, WS_TOKOF);
    LAS float* part = (LAS float*)(F.lds + TBL_OFF) + F.wave * 256 + lane;
    __syncthreads();
#pragma unroll 1
    for (int i0 = F.tid; i0 < 1024 * 8; i0 += 8 * NWAVES * 64) {
        f32x4 v[8];
#pragma unroll
        for (int u = 0; u < 8; ++u) { const int i = i0 + u * NWAVES * 64, kk = i >> 3, q = i & 7; v[u] = *(const f32x4*)(F.w_r + (size_t)(1024 * HH + kk) * 32 + 4 * q); }
#pragma unroll
        for (int u = 0; u < 8; ++u) { const int i = i0 + u * NWAVES * 64, kk = i >> 3, q = i & 7; const int jj = kk >> 8, l = (kk & 255) >> 2, c = kk & 3; *(LAS f32x4*)(F.lds + RING_OFF + ((((jj * 4 + c) * 8 + q) * 64 + l) << 4)) = v[u]; } }
    __syncthreads();
#pragma unroll 1
    for (int ri = 0; ri < 4; ++ri) {
        const int row = gw + ri * NGW; if (row >= NTOK) break;
        int lane4 = 4 * lane; asm volatile("" : "+v"(lane4));
        const int b = row >> 11; const float* xr = H1 + (size_t)row * DM + lane4; const float* sh = mod + b * MODW + 6144 + lane4, *sc = mod + b * MODW + 8192 + lane4; const float* gp = F.g_ffn + lane4;
        f32x4 v[4]; float ss = 0.f;
#pragma unroll
        for (int j = 0; j < 4; ++j) { v[j] = *(const f32x4*)(xr + 256 * (4 * HH + j)); const f32x4 o = *(const f32x4*)(xr + 256 * (4 * (1 - HH) + j));
            ss += v[j][0] * v[j][0] + v[j][1] * v[j][1] + v[j][2] * v[j][2] + v[j][3] * v[j][3] + o[0] * o[0] + o[1] * o[1] + o[2] * o[2] + o[3] * o[3]; }
        ss = wave_sum(ss); const float rstd = 1.0f / sqrtf(ss * (1.0f / DM) + 1e-5f);
        float a[32];
#pragma unroll
        for (int e = 0; e < 32; ++e) a[e] = 0.f;
        const LAS unsigned char* wl = F.lds + RING_OFF + 4 * lane4;
#pragma unroll
        for (int jj = 0; jj < 4; ++jj) { const int col = 256 * (4 * HH + jj); const f32x4 g = *(const f32x4*)(gp + col), s1 = *(const f32x4*)(sc + col), h1 = *(const f32x4*)(sh + col);
            const f32x4 y = v[jj] * rstd * g * (s1 + 1.0f) + h1;
            if constexpr (MOE_FP8) *(unsigned*)(XN2 + (size_t)row * DM + col + lane4) = pk4_fp8(y[0], y[1], y[2], y[3]);
            else { u32x2 w; w.x = pk2(y[0], y[1]); w.y = pk2(y[2], y[3]); *(u32x2*)((bf16_t*)XN2 + (size_t)row * DM + col + lane4) = w; }
#pragma unroll
            for (int c = 0; c < 4; ++c) {
#pragma unroll
                for (int q = 0; q < 8; ++q) { const f32x4 wv = *(const LAS f32x4*)(wl + ((((jj * 4 + c) * 8 + q) * 64) << 4));
#pragma unroll
                    for (int e = 0; e < 4; ++e) a[4 * q + e] += y[c] * wv[e]; }
                asm volatile("" ::: "memory"); } }
#define P6_RSTEP(XF, MASK, HALF) { const bool up = (lane & (MASK)) != 0; _Pragma("unroll") for (int i = 0; i < (HALF); ++i) { const float keep = up ? a[i + (HALF)] : a[i], give = up ? a[i] : a[i + (HALF)]; a[i] = keep + XF; } }
        P6_RSTEP(__shfl_xor(give, 32), 32, 16) P6_RSTEP(__shfl_xor(give, 16), 16, 8) P6_RSTEP(__shfl_xor(give, 8), 8, 4) P6_RSTEP(__shfl_xor(give, 4), 4, 2) P6_RSTEP(__shfl_xor(give, 2), 2, 1)
#undef P6_RSTEP
        float lg = a[0] + __shfl_xor(a[0], 1);
        if (HH == 0) { part[ri * 64] = lg; continue; }
        lg += part[ri * 64] + F.b_r[lane >> 1];
        float val[4]; int idx[4];
        float cur = lg;
#pragma unroll
        for (int k = 0; k < 4; ++k) { float bv = cur; int bi = lane >> 1;
#pragma unroll
            for (int o = 1; o < 64; o <<= 1) { const float ov = __shfl_xor(bv, o); const int oi = __shfl_xor(bi, o); if (ov > bv || (ov == bv && oi < bi)) { bv = ov; bi = oi; } }
            val[k] = bv; idx[k] = bi; if ((lane >> 1) == bi) cur = -INFINITY; }
        float ex[4], sm = 0.f;
#pragma unroll
        for (int k = 0; k < 4; ++k) { ex[k] = expf(val[k] - val[0]); sm += ex[k]; }
        if (lane < 4) { int e = idx[0]; float gt = ex[0];
#pragma unroll
            for (int k = 1; k < 4; ++k) if (lane == k) { e = idx[k]; gt = ex[k]; }
            const int p = (int)atomicAdd(F.ctl + CW_CNT + e, 1u);
            TOKOF[e * NTOK + p] = row; TEID[row * 4 + lane] = e; TPOS[row * 4 + lane] = p; TGATE[row * 4 + lane] = gt / sm; }
    }
}
__device__ __forceinline__ void p6_norm_router(Frame& F) { p6_half<0>(F); p6_half<1>(F); }
__device__ __forceinline__ void moe_tables(Frame& F) {
    refresh(F);
    __syncthreads();
    if (F.tid == 0) { unsigned s = 0, h = 0, nl = 0;
        for (int e = 0; e < 32; ++e) { const unsigned c = __hip_atomic_load(F.ctl + CW_CNT + e, __ATOMIC_RELAXED, __HIP_MEMORY_SCOPE_AGENT); F.MISC[48 + e] = c; F.MISC[8 + e] = s; s += (c + 255u) >> 8;
            const unsigned rem = c & 255u; F.MISC[112 + e] = h; h += (c >> 8) + (rem > 128u ? 1u : 0u); if (rem >= 1u && rem <= 128u) { F.MISC[152 + nl] = (unsigned)e; ++nl; } }
        F.MISC[8 + 32] = s; F.MISC[112 + 32] = h; F.MISC[190] = nl; }
    __syncthreads();
}
__device__ __forceinline__ void p7_gu(Frame& F) {
    moe_tables(F);
    MoeSched<true> S; S.tpre = F.MISC + 8; S.cnt = F.MISC + 48; S.hpre = F.MISC + 112; S.lexp = F.MISC + 152; S.nlight = (int)F.MISC[190]; S.tbl = (const LAS unsigned*)(F.lds + TBL_OFF); S.A = (const char*)wsp<bf16_t>(F, WS_XN2); S.Bt = (const char*)wsp<bf16_t>(F, WS_WGU); S.NN = 16; S.ldb2 = 2048 * MOE_EB; S.K = 2048;
    S.G = F.G; S.vcu = F.vcu; S.b_estride = (size_t)4096 * 2048 * MOE_EB;
    { const int* TOKOF = wsp<int>(F, WS_TOKOF); Unit u; LAS unsigned* tbl = (LAS unsigned*)(F.lds + TBL_OFF);
      for (int i = 0; i < 10 && S.next(i, u); ++i) { if (F.tid < 256) { const int e = u.aux, p = (u.pm - (int)F.MISC[8 + e]) * 256 + F.tid, cnt = (int)F.MISC[48 + e]; const int tok = TOKOF[e * NTOK + (p < cnt ? p : 0)]; tbl[i * 256 + F.tid] = (unsigned)tok * (2048u * MOE_EB); } }
      __syncthreads(); }
    EpiGU E{F.b_gu, wsp<unsigned char>(F, WS_ACT)};
    gemm_phase<EpiGU, MoeSched<true>, true, MOE_FP8>(F.lds + RING_OFF, S, E, F.wave);
}
__device__ __forceinline__ void p8_down(Frame& F) {
    moe_tables(F);
    MoeSched<false> S; S.tpre = F.MISC + 8; S.cnt = F.MISC + 48; S.hpre = F.MISC + 112; S.lexp = F.MISC + 152; S.nlight = (int)F.MISC[190]; S.tbl = nullptr; S.A = (const char*)wsp<bf16_t>(F, WS_ACT); S.Bt = (const char*)wsp<bf16_t>(F, WS_WD); S.NN = 8; S.ldb2 = 2048 * MOE_EB; S.K = 2048;
    S.G = F.G; S.vcu = F.vcu; S.b_estride = (size_t)2048 * 2048 * MOE_EB;
    EpiDown E{F.b_dn, wsp<bf16_t>(F, WS_YS)};
    gemm_phase<EpiDown, MoeSched<false>, true, MOE_FP8>(F.lds + RING_OFF, S, E, F.wave);
}
__device__ __forceinline__ void p9_final(Frame& F) {
    refresh(F);
    moe_tables(F);
    const int gw = F.vcu * NWAVES + F.wave, NGW = F.G * NWAVES, lane = F.lane;
    const float* mod = wsp<float>(F, WS_MOD); const float* H1 = wsp<float>(F, WS_H1); const bf16_t* YS = wsp<bf16_t>(F, WS_YS);
    const int* TEID = wsp<int>(F, WS_TEID); const int* TPOS = wsp<int>(F, WS_TPOS); const float* TGATE = wsp<float>(F, WS_TGATE);
    for (int row = gw; row < NTOK; row += NGW) {
        const int b = row >> 11; const float* gt = mod + b * MODW + 10240;
        const bf16_t* yr[4]; float gw4[4];
#pragma unroll
        for (int k = 0; k < 4; ++k) { const int e = TEID[row * 4 + k]; yr[k] = YS + ((size_t)F.MISC[8 + e] * 256 + TPOS[row * 4 + k]) * 2048; gw4[k] = TGATE[row * 4 + k]; }
        f32x4 v[8]; float ss = 0.f;
#pragma unroll
        for (int j = 0; j < 8; ++j) { const int col = 256 * j + 4 * lane; f32x4 y = {0.f, 0.f, 0.f, 0.f};
#pragma unroll
            for (int k = 0; k < 4; ++k) { const u32x2 w = *(const u32x2*)(yr[k] + col); y += (f32x4){bflo(w.x), bfhi(w.x), bflo(w.y), bfhi(w.y)} * gw4[k]; }
            v[j] = *(const f32x4*)(H1 + (size_t)row * DM + col) + *(const f32x4*)(gt + col) * y;
            ss += v[j][0] * v[j][0] + v[j][1] * v[j][1] + v[j][2] * v[j][2] + v[j][3] * v[j][3]; }
        ss = wave_sum(ss); const float rstd = 1.0f / sqrtf(ss * (1.0f / DM) + 1e-5f);
#pragma unroll
        for (int j = 0; j < 8; ++j) { const int col = 256 * j + 4 * lane; *(f32x4*)(F.out + (size_t)row * DM + col) = v[j] * rstd * *(const f32x4*)(F.g_fin + col); }
    }
}

constexpr int PER_PHASE = 10;
struct Args { const void* in[20]; float* out; unsigned char* ws; int ph_lo, ph_hi; };
__global__ void __launch_bounds__(NWAVES * 64, 2) mega_fwd(Args args) {
    extern __shared__ __attribute__((aligned(16))) unsigned char lds_raw[];
    Frame F;
    F.lds = (LAS unsigned char*)lds_raw; F.MISC = (volatile LAS unsigned*)(F.lds + MISC_OFF);
    F.tid = threadIdx.x; F.lane = F.tid & 63; F.wave = __builtin_amdgcn_readfirstlane(F.tid >> 6);
    F.G = gridDim.x; { const int bx = blockIdx.x; F.vcu = (F.G % 8 == 0) ? (bx % 8) * (F.G / 8) + bx / 8 : bx; }
    F.ws = args.ws; F.ctl = (unsigned*)(args.ws + WS_CTL); F.out = args.out;
    F.x = (const float*)args.in[0]; F.c = (const float*)args.in[1]; F.pos = (const int*)args.in[2]; F.w_ada = (const float*)args.in[3]; F.b_ada = (const float*)args.in[4]; F.g_mix = (const float*)args.in[5];
    F.w_in = (const float*)args.in[6]; F.b_in = (const float*)args.in[7]; F.sinks = (const float*)args.in[8]; F.w_a = (const float*)args.in[9]; F.w_b = (const float*)args.in[10]; F.w_out = (const float*)args.in[11];
    F.g_ffn = (const float*)args.in[12]; F.w_r = (const float*)args.in[13]; F.b_r = (const float*)args.in[14]; F.w_gu = (const float*)args.in[15]; F.b_gu = (const float*)args.in[16]; F.w_dn = (const float*)args.in[17];
    F.b_dn = (const float*)args.in[18]; F.g_fin = (const float*)args.in[19];
    for (int u = F.tid; u < 256; u += NWAVES * 64) F.MISC[u] = 0u;
    __syncthreads();
    refresh(F);
    const int lo = args.ph_lo, hi = args.ph_hi;
    const bool one_launch = true; (void)lo; (void)hi;
    XcdBarrier bar; bar.bar = (unsigned*)(F.ctl + CW_BAR); bar.x = 0; bar.st = nullptr; bar.total = 0;
    XcdBarrier bar2 = bar;
    const bool is_comp = (int)blockIdx.x < NCOMP || F.G <= NCOMP;
    const int ncomp = F.G <= NCOMP ? F.G : NCOMP;
    if (one_launch) { bar = xcd_barrier_post((unsigned*)(F.ctl + CW_BAR), F.MISC + 0, (unsigned)F.G);
        if (is_comp) bar2 = xcd_barrier_post((unsigned*)(F.ctl + CW_BAR2), F.MISC + 2, (unsigned)ncomp); }
#ifndef REPEAT_MASK
#define REPEAT_MASK 0
#endif
#define IN(k) true
#define REP(k, body) do { if ((REPEAT_MASK >> (k)) & 1) { body; xcd_barrier(bar); } } while (0)
#define REP2(k, body) do { if ((REPEAT_MASK >> (k)) & 1) { body; xcd_barrier(bar2); } } while (0)
#define SEAM(k) do { if (IN(k) && IN((k) + 1)) xcd_barrier(bar); } while (0)
    if (one_launch) {
        if (is_comp) {
            const int G0 = F.G, v0 = F.vcu; F.G = ncomp; { const int bx = blockIdx.x; F.vcu = (ncomp % 8 == 0) ? (bx % 8) * (ncomp / 8) + bx / 8 : bx; }
            REP2(0, p0_prologue(F)); p0_prologue(F); xcd_barrier(bar2);
            REP2(1, p1_norm_fb(F)); p1_norm_fb(F); xcd_barrier(bar2);
            { p2_cumsum(F);
              DenseSched S; S.init(wsp<bf16_t>(F, WS_XN), 2048 * MIX_EB, wsp<bf16_t>(F, WS_WIN), 2048 * MIX_EB, 2048, NTOK, 8704, ncomp, (int)blockIdx.x);
              EpiInProj E{wsp<bf16_t>(F, WS_QA), wsp<bf16_t>(F, WS_KA), wsp<bf16_t>(F, WS_VA), wsp<bf16_t>(F, WS_QB), wsp<bf16_t>(F, WS_KB), wsp<bf16_t>(F, WS_VB), wsp<bf16_t>(F, WS_SGA), wsp<bf16_t>(F, WS_SGB),
                          wsp<float>(F, WS_BINP), wsp<float>(F, WS_COS), wsp<float>(F, WS_SIN)};
              REP2(2, (gemm_phase<EpiInProj, DenseSched, true, MIX_FP8>(F.lds + RING_OFF, S, E, F.wave)));
              gemm_phase<EpiInProj, DenseSched, true, MIX_FP8>(F.lds + RING_OFF, S, E, F.wave); }
            xcd_barrier(bar2);
            p3_attention(F);
            xcd_barrier(bar2);
            {
                BranchSched S; S.d.init(wsp<bf16_t>(F, WS_YAB), 2048 * MIX_EB, wsp<bf16_t>(F, WS_WAB), 1024 * MIX_EB, 1024, NTOK, 2048, ncomp, (int)blockIdx.x); S.ldb2 = 1024 * MIX_EB; S.K = 1024;
                EpiBranch E{wsp<bf16_t>(F, WS_SGA), wsp<bf16_t>(F, WS_SGB), wsp<float>(F, WS_T1), wsp<unsigned char>(F, WS_MERGED)};
                gemm_phase<EpiBranch, BranchSched, true, MIX_FP8>(F.lds + RING_OFF, S, E, F.wave); }
            xcd_barrier(bar2);
            {
                DenseSched S; S.init(wsp<bf16_t>(F, WS_MERGED), 2048 * P5_EB, wsp<bf16_t>(F, WS_WOUT), 2048 * P5_EB, 2048, NTOK, 2048, ncomp, (int)blockIdx.x);
                EpiOut E{F.x, wsp<float>(F, WS_MOD), wsp<float>(F, WS_H1)};
                gemm_phase<EpiOut, DenseSched, true, P5_FP8>(F.lds + RING_OFF, S, E, F.wave); }
            F.G = G0; F.vcu = v0;
        }
#ifndef CONV_COOP
#define CONV_COOP 1
#endif
        if (CONV_MODE == 0 || (CONV_MODE == 1 && !is_comp) || (CONV_MODE == 2 && is_comp)) { if (CONV_COOP && MOE_FP8) convert_coop(F); else convert_queue(F); }
        xcd_barrier(bar);
    }
    if (IN(6)) { p6_norm_router(F); } SEAM(6);
    if (IN(7)) { REP(7, p7_gu(F)); p7_gu(F); } SEAM(7);
    if (IN(8)) { REP(8, p8_down(F)); p8_down(F); } SEAM(8);
    if (IN(9)) { REP(9, p9_final(F)); p9_final(F); }
#undef IN
#undef SEAM
}

static void run_opt(void* const* d_in, float* out, unsigned char* ws, hipStream_t stream, int n_launches) {
    static int grid = 0;
    if (grid == 0) {
        int dev = 0, cus = 0;
        if (hipGetDevice(&dev) != hipSuccess || hipDeviceGetAttribute(&cus, hipDeviceAttributeMultiprocessorCount, dev) != hipSuccess) { grid = -1; return; }
        if (hipFuncSetAttribute((const void*)mega_fwd, hipFuncAttributeMaxDynamicSharedMemorySize, LDS_BYTES) != hipSuccess) { grid = -1; return; }
        int per_cu = 0; (void)hipOccupancyMaxActiveBlocksPerMultiprocessor(&per_cu, (const void*)mega_fwd, NWAVES * 64, LDS_BYTES); (void)hipGetLastError();
        grid = cus;
    }
    if (grid < 0) return;
    (void)hipMemsetAsync(ws + WS_CTL, 0, CTL_ZERO_BYTES, stream);
    Args a{};
    for (int i = 0; i < 20; ++i) a.in[i] = d_in[i];
    a.out = out; a.ws = ws;
    (void)n_launches; a.ph_lo = 0; a.ph_hi = PER_PHASE; hipLaunchKernelGGL(mega_fwd, dim3(grid), dim3(NWAVES * 64), LDS_BYTES, stream, a);
}
}

extern "C" void kernel_launch(void* const* d_in, const int* in_sizes, int n_in, void* d_out, int out_size, void* d_ws, size_t ws_size, hipStream_t stream) {
    mk::run_opt(d_in, (float*)d_out, (unsigned char*)d_ws, stream, 1);
}
```

```cpp
#include <hip/hip_runtime.h>
#include <stdint.h>
#include <math.h>
namespace mk {
#define LAS __attribute__((address_space(3)))
#define GAS __attribute__((address_space(1)))
typedef unsigned short bf16_t;
typedef short bf16x8 __attribute__((ext_vector_type(8)));
typedef float f32x4 __attribute__((ext_vector_type(4)));
typedef float f32x2 __attribute__((ext_vector_type(2)));
typedef float f32x16 __attribute__((ext_vector_type(16)));
typedef unsigned u32x4 __attribute__((ext_vector_type(4)));
typedef unsigned u32x2 __attribute__((ext_vector_type(2)));
typedef __bf16 bf16x2_t __attribute__((ext_vector_type(2)));
typedef int i32x4 __attribute__((ext_vector_type(4)));
typedef int i32x8 __attribute__((ext_vector_type(8)));

constexpr int NTOK = 8192, DM = 2048, SEQ = 2048, INW = 8720, NEXP = 32, MODW = 12288;
constexpr float LOG2E = 1.4426950408889634f;
constexpr float QSCALE = 0.125f * LOG2E;

__device__ __forceinline__ unsigned pk2(float lo, float hi) { f32x2 v = {lo, hi}; bf16x2_t b = __builtin_convertvector(v, bf16x2_t); return __builtin_bit_cast(unsigned, b); }
__device__ __forceinline__ float bflo(unsigned u) { return __builtin_bit_cast(float, u << 16); }
__device__ __forceinline__ float bfhi(unsigned u) { return __builtin_bit_cast(float, u & 0xffff0000u); }
__device__ __forceinline__ unsigned pk4_fp8_raw(float a, float b, float c, float d) { int w = 0; w = __builtin_amdgcn_cvt_pk_fp8_f32(a, b, w, false); w = __builtin_amdgcn_cvt_pk_fp8_f32(c, d, w, true); return (unsigned)w; }
__device__ __forceinline__ float sat448(float x) { return __builtin_amdgcn_fmed3f(x, -448.0f, 448.0f); }
__device__ __forceinline__ unsigned pk4_fp8(float a, float b, float c, float d) { return pk4_fp8_raw(a, b, c, d); }
__device__ __forceinline__ i32x8 cat8(bf16x8 lo, bf16x8 hi) { return __builtin_shufflevector(__builtin_bit_cast(i32x4, lo), __builtin_bit_cast(i32x4, hi), 0, 1, 2, 3, 4, 5, 6, 7); }
__device__ __forceinline__ int lane_id() { int l = (int)__builtin_amdgcn_mbcnt_hi(~0u, __builtin_amdgcn_mbcnt_lo(~0u, 0u)); asm volatile("" : "+v"(l)); return l; }
template <int CTRL> __device__ __forceinline__ float dpp_mov(float x) { return __builtin_bit_cast(float, __builtin_amdgcn_update_dpp(0, __builtin_bit_cast(int, x), CTRL, 0xF, 0xF, true)); }
__device__ __forceinline__ float lx1(float x) { return dpp_mov<0xB1>(x); }
__device__ __forceinline__ float lx2(float x) { return dpp_mov<0x4E>(x); }
__device__ __forceinline__ float lx4(float x) { return dpp_mov<0x1B>(dpp_mov<0x141>(x)); }
__device__ __forceinline__ float lx8(float x) { return dpp_mov<0x128>(x); }
__device__ __forceinline__ float lx16(float x, int lane) { const unsigned u = __builtin_bit_cast(unsigned, x); auto rr = __builtin_amdgcn_permlane16_swap(u, u, false, false); return __builtin_bit_cast(float, (lane & 16) ? rr[0] : rr[1]); }
__device__ __forceinline__ float lx32(float x, int lane) { const unsigned u = __builtin_bit_cast(unsigned, x); auto rr = __builtin_amdgcn_permlane32_swap(u, u, false, false); return __builtin_bit_cast(float, (lane & 32) ? rr[0] : rr[1]); }
__device__ __forceinline__ float wave_sum_v(float v) {
    v += lx1(v); v += lx2(v); v += lx4(v); v += lx8(v);
    { const unsigned u = __builtin_bit_cast(unsigned, v); auto rr = __builtin_amdgcn_permlane16_swap(u, u, false, false); v = __builtin_bit_cast(float, rr[0]) + __builtin_bit_cast(float, rr[1]); }
    { const unsigned u = __builtin_bit_cast(unsigned, v); auto rr = __builtin_amdgcn_permlane32_swap(u, u, false, false); v = __builtin_bit_cast(float, rr[0]) + __builtin_bit_cast(float, rr[1]); }
    return v;
}
__device__ __forceinline__ float fast_sigmoid(float x) { return __builtin_amdgcn_rcpf(1.0f + __builtin_amdgcn_exp2f(-x * LOG2E)); }

constexpr int BM = 256, BK = 64, HALF = 128, HTB = HALF * BK * 2, STAGE_BYTES = 8 * HTB, NXCD = 8, WGM = 8;
__host__ __device__ __forceinline__ int lds_byte(int r, int c) { const int st = (r >> 4) * 2 + (c >> 5), rr = r & 15, cc = c & 31, ob = rr * 64 + cc * 2; return st * 1024 + (ob ^ (((ob >> 9) & 1) << 5)); }
__host__ __device__ __forceinline__ void stage_rc(int b, int& R, int& C) { const int st = b / 1024, sb = b % 1024, swz = sb ^ (((sb >> 9) & 1) << 5); R = (st >> 1) * 16 + swz / 64; C = (st & 1) * 32 + (swz % 64) / 2; }
__host__ __device__ __forceinline__ int perm32(int rho) { const int n = rho >> 4, i = rho & 15; return 8 * (i >> 2) + 4 * n + (i & 3); }

struct Unit { int pm, pn, aux; };

template <class Epi, class Sched, bool ALIGN_EPI, bool FP8 = false>
__device__ __forceinline__ void gemm_phase(LAS unsigned char* lds, const Sched& S, const Epi& E, int wid  ) {
    const int lane = lane_id(), tid = wid * 64 + lane, wr = wid >> 2, wc = wid & 3, fr = lane & 15, fq = lane >> 4;
    const int K = S.K, nt = FP8 ? K / (2 * BK) : K / BK;
    int sR[2], sC[2]; unsigned voffB[2];
#pragma unroll
    for (int i = 0; i < 2; ++i) { stage_rc(tid * 16 + i * 8192, sR[i], sC[i]); const int Rb = Epi::PERM ? ((sR[i] & ~31) + perm32(sR[i] & 31)) : sR[i]; voffB[i] = (unsigned)Rb * S.ldb2 + (unsigned)sC[i] * 2u; }
    const size_t kstep = (size_t)(BK * 2);
    const size_t hstepB = (size_t)HALF * S.ldb2;
    const unsigned ldsw = (unsigned)wid * 1024u;
    const int aoff = lds_byte(wr * 64 + fr, fq * 8), boff = lds_byte(wc * 32 + fr, fq * 8);
#define PG8_SA(b, h) (((b) * 2 + (h)) * HTB)
#define PG8_SB(b, h) ((4 + (b) * 2 + (h)) * HTB)
#define PG8_STAGE(bufoff, gbase, voff) do { _Pragma("unroll") for (int _i = 0; _i < 2; ++_i) \
        __builtin_amdgcn_global_load_lds((const unsigned*)((const char*)(gbase) + (voff)[_i]), (LAS unsigned*)(lds + (bufoff) + ldsw + _i * 8192), 16, 0, 0); } while (0)
#define PG8_LDA(dst, b, h) do { _Pragma("unroll") for (int m = 0; m < 4; ++m) { if constexpr (FP8) dst##8[m] = cat8(*(const LAS bf16x8*)(lds + PG8_SA(b, h) + aoff + m * 2048), *(const LAS bf16x8*)(lds + PG8_SA(b, h) + aoff + m * 2048 + 1024)); \
        else { _Pragma("unroll") for (int k = 0; k < 2; ++k) dst[m][k] = *(const LAS bf16x8*)(lds + PG8_SA(b, h) + aoff + m * 2048 + k * 1024); } } } while (0)
#define PG8_LDB(dst, b, h) do { _Pragma("unroll") for (int n = 0; n < 2; ++n) { if constexpr (FP8) dst##8[n] = cat8(*(const LAS bf16x8*)(lds + PG8_SB(b, h) + boff + n * 2048), *(const LAS bf16x8*)(lds + PG8_SB(b, h) + boff + n * 2048 + 1024)); \
        else { _Pragma("unroll") for (int k = 0; k < 2; ++k) dst[n][k] = *(const LAS bf16x8*)(lds + PG8_SB(b, h) + boff + n * 2048 + k * 1024); } } } while (0)
#define PG8_MMA(ai, bj, At, Bt) do { __builtin_amdgcn_s_setprio(1); _Pragma("unroll") for (int m = 0; m < 4; ++m) _Pragma("unroll") for (int n = 0; n < 2; ++n) { \
        if constexpr (FP8) asm volatile("v_mfma_scale_f32_16x16x128_f8f6f4 %0, %1, %2, %0, %3, %3 op_sel_hi:[0,0,0]" : "+v"(acc[ai][bj][m][n]) : "v"(Bt##8[n]), "v"(At##8[m]), "v"(fp8_unit_scale)); \
        else { _Pragma("unroll") for (int k = 0; k < 2; ++k) acc[ai][bj][m][n] = __builtin_amdgcn_mfma_f32_16x16x32_bf16(Bt[n][k], At[m][k], acc[ai][bj][m][n], 0, 0, 0); } } __builtin_amdgcn_s_setprio(0); } while (0)
#define PG8_WAIT_V(n) asm volatile("s_waitcnt vmcnt(" #n ")" ::: "memory")
#define PG8_WAIT_L(n) asm volatile("s_waitcnt lgkmcnt(" #n ")" ::: "memory")
#define PG8_BAR __builtin_amdgcn_s_barrier()
#define PG8_SCHED __builtin_amdgcn_sched_barrier(0)
#define PG8_AOFFS(dst, u, ui) do { _Pragma("unroll") for (int _h = 0; _h < 2; ++_h) _Pragma("unroll") for (int _i = 0; _i < 2; ++_i) dst[_h][_i] = S.a_rowoff(u, ui, sR[_i] + _h * HALF) + (unsigned)sC[_i] * 2u; } while (0)
    Unit cur, nxt; int ui = 0;
    if (!S.next(0, cur)) return;
    int vrows = 256; if constexpr (Sched::RAGGED) vrows = S.rows(cur);
#define PG8_DO0 (!Sched::RAGGED || vrows > 64 || wr == 0)
#define PG8_DO1 (!Sched::RAGGED || vrows > 128)
    f32x4 acc[2][2][4][2];
#pragma unroll
    for (int a = 0; a < 2; ++a)
#pragma unroll
        for (int b = 0; b < 2; ++b)
#pragma unroll
            for (int m = 0; m < 4; ++m)
#pragma unroll
                for (int n = 0; n < 2; ++n) acc[a][b][m][n] = (f32x4){0.f, 0.f, 0.f, 0.f};
    bf16x8 At[4][2], B0[2][2], B1[2][2]; i32x8 At8[4], B08[2], B18[2];
    constexpr bool GA = Sched::GATHER;
    const unsigned fp8_unit_scale = 0x7f7f7f7fu;
    unsigned vAc[2][2], vAn[2][2];
    PG8_AOFFS(vAc, cur, 0);
    const size_t hstepA = GA ? 0 : (size_t)(vAc[1][0] - vAc[0][0]);
#define PG8_H1(v) (GA ? (v)[1] : (v)[0])
    const char* cA = S.a_base(cur); const char* cB = S.b_base(cur);
    PG8_STAGE(PG8_SB(0, 0), cB, voffB); PG8_STAGE(PG8_SB(0, 1), cB + hstepB, voffB); PG8_STAGE(PG8_SA(0, 0), cA, vAc[0]); PG8_STAGE(PG8_SA(0, 1), cA + hstepA, PG8_H1(vAc));
    if (wr == 1) PG8_BAR;
    PG8_WAIT_V(2); PG8_BAR;
    PG8_STAGE(PG8_SB(1, 0), cB + kstep, voffB); PG8_STAGE(PG8_SA(1, 0), cA + kstep, vAc[0]); PG8_STAGE(PG8_SB(1, 1), cB + hstepB + kstep, voffB);
    PG8_WAIT_V(6); PG8_BAR;
    for (;;) {
        const bool has_next = S.next(ui + 1, nxt);
        const char* nA = cA; const char* nB = cB;
        if (has_next) { nA = S.a_base(nxt); nB = S.b_base(nxt); if constexpr (GA) PG8_AOFFS(vAn, nxt, ui + 1); }
        else if constexpr (GA) {
#pragma unroll
            for (int _h = 0; _h < 2; ++_h)
#pragma unroll
                for (int _i = 0; _i < 2; ++_i) vAn[_h][_i] = vAc[_h][_i]; }
        for (int t = 0; t < nt; t += 2) {
            const bool last = (t == nt - 2);
            const char* a1 = cA + (size_t)(t + 1) * kstep;
            const char* a2 = last ? nA : cA + (size_t)(t + 2) * kstep; const char* b2 = last ? nB : cB + (size_t)(t + 2) * kstep;
            const char* a3 = a2 + kstep; const char* b3 = b2 + kstep;
            unsigned vS[2][2];
#pragma unroll
            for (int _h = 0; _h < 2; ++_h)
#pragma unroll
                for (int _i = 0; _i < 2; ++_i) vS[_h][_i] = (GA && last) ? vAn[_h][_i] : vAc[_h][_i];
            PG8_LDB(B0, 0, 0); PG8_LDB(B1, 0, 1); PG8_SCHED; PG8_LDA(At, 0, 0); PG8_STAGE(PG8_SA(1, 1), a1 + hstepA, PG8_H1(vAc));
            PG8_WAIT_V(8); PG8_WAIT_L(0); PG8_BAR; if (PG8_DO0) { PG8_MMA(0, 0, At, B0); PG8_MMA(0, 1, At, B1); } PG8_BAR; PG8_SCHED;
            PG8_LDA(At, 0, 1); PG8_STAGE(PG8_SB(0, 0), b2, voffB); PG8_STAGE(PG8_SB(0, 1), b2 + hstepB, voffB); PG8_STAGE(PG8_SA(0, 0), a2, vS[0]);
            PG8_WAIT_V(8); PG8_WAIT_L(0); PG8_BAR; if (PG8_DO1) { PG8_MMA(1, 0, At, B0); PG8_MMA(1, 1, At, B1); } PG8_BAR; PG8_SCHED;
            PG8_LDB(B0, 1, 0); PG8_LDB(B1, 1, 1); PG8_SCHED; PG8_LDA(At, 1, 0); PG8_STAGE(PG8_SA(0, 1), a2 + hstepA, PG8_H1(vS));
            PG8_WAIT_V(8); PG8_WAIT_L(0); PG8_BAR; if (PG8_DO0) { PG8_MMA(0, 0, At, B0); PG8_MMA(0, 1, At, B1); } PG8_BAR; PG8_SCHED;
            PG8_LDA(At, 1, 1); PG8_STAGE(PG8_SB(1, 0), b3, voffB); PG8_STAGE(PG8_SB(1, 1), b3 + hstepB, voffB); PG8_STAGE(PG8_SA(1, 0), a3, vS[0]);
            PG8_WAIT_V(8); PG8_WAIT_L(0); PG8_BAR; if (PG8_DO1) { PG8_MMA(1, 0, At, B0); PG8_MMA(1, 1, At, B1); } PG8_BAR; PG8_SCHED;
        }
        if constexpr (ALIGN_EPI) { if (wr == 0) PG8_BAR; }
        if constexpr (FP8) asm volatile("s_nop 15\n\ts_nop 15\n\ts_nop 15\n\ts_nop 15" ::: "memory");
        E(acc, cur, wr, wc, fr, fq);
        if (!has_next) break;
#pragma unroll
        for (int a = 0; a < 2; ++a)
#pragma unroll
            for (int b = 0; b < 2; ++b)
#pragma unroll
                for (int m = 0; m < 4; ++m)
#pragma unroll
                    for (int n = 0; n < 2; ++n) acc[a][b][m][n] = (f32x4){0.f, 0.f, 0.f, 0.f};
        cur = nxt; cA = nA; cB = nB; ++ui;
        if constexpr (Sched::RAGGED) vrows = S.rows(cur);
        if constexpr (GA) {
#pragma unroll
        for (int _h = 0; _h < 2; ++_h)
#pragma unroll
            for (int _i = 0; _i < 2; ++_i) vAc[_h][_i] = vAn[_h][_i]; }
        if constexpr (ALIGN_EPI) { if (wr == 1) PG8_BAR; }
    }
    PG8_WAIT_V(0);
    if constexpr (!ALIGN_EPI) { if (wr == 0) PG8_BAR; }
    PG8_BAR;
#undef PG8_SA
#undef PG8_SB
#undef PG8_STAGE
#undef PG8_LDA
#undef PG8_LDB
#undef PG8_MMA
#undef PG8_WAIT_V
#undef PG8_WAIT_L
#undef PG8_BAR
#undef PG8_SCHED
#undef PG8_AOFFS
#undef PG8_DO0
#undef PG8_DO1
#undef PG8_H1
}

#define XB_TMO      128
#define XB_XCNT(j)  (256  + 64 * (j))
#define XB_XSUB(j)  (1280 + 64 * (j))
#define XB_XGEN(j)  (2304 + 64 * (j))
#define XB_TOP      3328
#define XB_TOPGEN   3392
#define XCD_BAR_WORDS 3456
#define XB_SPIN_CAP (1u << 18)
__device__ __forceinline__ unsigned xb_ld(unsigned* p)              { return __hip_atomic_load(p, __ATOMIC_RELAXED, __HIP_MEMORY_SCOPE_AGENT); }
__device__ __forceinline__ unsigned xb_add(unsigned* p, unsigned v) { return __hip_atomic_fetch_add(p, v, __ATOMIC_RELAXED, __HIP_MEMORY_SCOPE_AGENT); }
__device__ __forceinline__ unsigned xb_xcc_id() { return (unsigned)__builtin_amdgcn_s_getreg((3 << 11) | 20) & 0xFu; }
#define XB_SPIN(cond, bar) do { unsigned _sp = 0; while (cond) { __builtin_amdgcn_s_sleep(1); \
    if ((++_sp & 255u) == 0u) { if (xb_ld(&(bar)[XB_TMO])) break; if (_sp > XB_SPIN_CAP) { atomicAdd(&(bar)[XB_TMO], 1u); break; } } } } while (0)
struct XcdBarrier { unsigned* bar; unsigned x; volatile LAS unsigned* st; unsigned total; };
__device__ __forceinline__ XcdBarrier xcd_barrier_post(unsigned* bar, volatile LAS unsigned* st, unsigned total) {
    XcdBarrier b; b.bar = bar; b.x = xb_xcc_id(); b.st = st; b.total = total;
    if (threadIdx.x == 0) (void)xb_add(&bar[XB_XCNT(b.x)], 1u);
    return b;
}
__device__ __forceinline__ void xcd_barrier_complete(unsigned* bar, unsigned x, unsigned G, unsigned& nloc, unsigned& nx) {
    unsigned sum, cnt, mine, sp = 0u;
    for (;;) {
        sum = 0u; cnt = 0u; mine = 0u;
#pragma unroll
        for (unsigned j = 0; j < 16; ++j) { const unsigned c = xb_ld(&bar[XB_XCNT(j)]); sum += c; cnt += (c > 0u) ? 1u : 0u; mine = (j == x) ? c : mine; }
        if (sum == G) break;
        __builtin_amdgcn_s_sleep(1);
        if ((++sp & 255u) == 0u) { if (xb_ld(&bar[XB_TMO])) break; if (sp > XB_SPIN_CAP) { atomicAdd(&bar[XB_TMO], 1u); break; } }
    }
    nloc = mine > 0u ? mine : 1u; nx = cnt > 0u ? cnt : 1u;
}
__device__ __forceinline__ void xcd_barrier(const XcdBarrier& b) {
    asm volatile("s_waitcnt vmcnt(0)" ::: "memory");
    __syncthreads();
    if (threadIdx.x == 0) {
        unsigned* bar = b.bar;
        __builtin_amdgcn_s_waitcnt(0);
        unsigned nloc = b.st[0], nx = b.st[1];
        if (nloc == 0u) { xcd_barrier_complete(bar, b.x, b.total, nloc, nx); b.st[0] = nloc; b.st[1] = nx; }
        const unsigned old = xb_add(&bar[XB_XSUB(b.x)], 1u);
        const unsigned gen = old / nloc;
        if (old + 1u == (gen + 1u) * nloc) {
            __builtin_amdgcn_fence(__ATOMIC_RELEASE, "agent");
            asm volatile("s_waitcnt vmcnt(0)" ::: "memory");
            const unsigned og = xb_add(&bar[XB_TOP], 1u);
            const unsigned tg = og / nx;
            if (og + 1u == (tg + 1u) * nx) xb_add(&bar[XB_TOPGEN], 1u);
            else XB_SPIN(xb_ld(&bar[XB_TOPGEN]) == tg, bar);
            __builtin_amdgcn_fence(__ATOMIC_ACQUIRE, "agent");
            xb_add(&bar[XB_XGEN(b.x)], 1u);
            asm volatile("s_waitcnt vmcnt(0)" ::: "memory");
        } else {
            XB_SPIN(xb_ld(&bar[XB_XGEN(b.x)]) == gen, bar);
            __builtin_amdgcn_fence(__ATOMIC_ACQUIRE, "agent");
            asm volatile("s_waitcnt vmcnt(0)" ::: "memory");
        }
    }
    __syncthreads();
}
}
namespace mk {
constexpr size_t MiB = 1ull << 20;
constexpr size_t WS_CTL = 0, CTL_ZERO_BYTES = 1 * MiB;
constexpr size_t WS_MOD = 1 * MiB, WS_COS = 2 * MiB, WS_SIN = 3 * MiB, WS_LOGF = 4 * MiB, WS_CUM = 5 * MiB, WS_TEID = 6 * MiB, WS_TPOS = 6 * MiB + 512 * 1024, WS_TGATE = 7 * MiB, WS_BINP = 7 * MiB + 512 * 1024,
                 WS_TOKOF = 8 * MiB  , WS_XN = 16 * MiB  , WS_WIN = 48 * MiB  , WS_WAB = 84 * MiB  , WS_WOUT = 92 * MiB  , WS_QA = 100 * MiB  , WS_KA = 116 * MiB  ,
                 WS_VA = 120 * MiB  , WS_QB = 124 * MiB  , WS_KB = 140 * MiB, WS_VB = 156 * MiB, WS_SGA = 172 * MiB  , WS_SGB = 204 * MiB  , WS_YAB = 236 * MiB  ,
                 WS_T1 = 268 * MiB  , WS_MERGED = 332 * MiB  , WS_H1 = 364 * MiB  , WS_XN2 = 428 * MiB  , WS_ACT = 460 * MiB  , WS_YS = 620 * MiB  ,
                 WS_WGU = 780 * MiB  , WS_WD = 1292 * MiB  , WS_JUNK = 1548 * MiB  , WS_END = 1580 * MiB;
constexpr int CW_CNT = 1024;
constexpr int CW_BAR = 4096;
constexpr int CW_BAR2 = 8192;
constexpr int CW_CQ = 2048;
constexpr int CW_AQ = 2112;
constexpr int CW_SFLAG = 2560;
#ifndef CONV_MODE
#define CONV_MODE 0
#endif
#ifndef NCOMP_DEF
#define NCOMP_DEF 184
#endif
constexpr int NCOMP = NCOMP_DEF;
constexpr int RING_OFF = 0, RING_BYTES = 131072;
constexpr int TBL_OFF = RING_BYTES;
constexpr int MISC_OFF = TBL_OFF + 10240;
constexpr int LDS_BYTES = 147456;
static_assert(MISC_OFF + 1024 <= LDS_BYTES, "LDS map");
constexpr int NWAVES = 8;
constexpr bool MOE_FP8 = true;
constexpr float WSCALE = 32.0f, WSCALE_INV = 1.0f / 32.0f;
constexpr bool MIX_FP8 = true;
constexpr int MIX_EB = MIX_FP8 ? 1 : 2;
#ifndef P5_FP8_DEF
#define P5_FP8_DEF 1
#endif
constexpr bool P5_FP8 = MIX_FP8 && P5_FP8_DEF;
constexpr int P5_EB = P5_FP8 ? 1 : 2;
constexpr int MOE_EB = MOE_FP8 ? 1 : 2;

struct Frame {
    LAS unsigned char* lds; volatile LAS unsigned* MISC; unsigned* ctl;
    int tid, lane, wave, vcu, G;
    const float *x, *c, *w_ada, *b_ada, *g_mix, *w_in, *b_in, *sinks, *w_a, *w_b, *w_out, *g_ffn, *w_r, *b_r, *w_gu, *b_gu, *w_dn, *b_dn, *g_fin; const int* pos;
    float* out; unsigned char* ws;
};
__device__ __forceinline__ void refresh(Frame& F) { F.lane = lane_id(); F.tid = F.wave * 64 + F.lane; }
template <class T> __device__ __forceinline__ T* wsp(const Frame& F, size_t off) { return (T*)(F.ws + off); }

__device__ __forceinline__ float wave_sum(float v) {
#pragma unroll
    for (int o = 1; o < 64; o <<= 1) v += __shfl_xor(v, o);
    return v;
}

struct DenseSched {
    static constexpr bool GATHER = false, RAGGED = false;
    const char* A; const char* Bt; unsigned lda2, ldb2; int K; int nM, nN, nwg, G, c;
    __device__ __forceinline__ void init(const void* A_, unsigned lda2_, const void* Bt_, unsigned ldb2_, int K_, int M, int N, int G_, int c_) {
        A = (const char*)A_; Bt = (const char*)Bt_; lda2 = lda2_; ldb2 = ldb2_; K = K_; nM = M / BM; nN = N / BM; nwg = nM * nN; G = G_; c = c_; }
    __device__ __forceinline__ bool tile(long L, Unit& u) const {
        if (L >= nwg) return false;
        int wgid = (int)L; { const int q = nwg / NXCD, r = nwg % NXCD, xcd = wgid % NXCD, off = wgid / NXCD; wgid = (xcd < r ? xcd * (q + 1) : r * (q + 1) + (xcd - r) * q) + off; }
        const int nig = WGM * nN, gid = wgid / nig, fm = gid * WGM, gsz = (nM - fm) < WGM ? (nM - fm) : WGM;
        u.pm = fm + ((wgid % nig) % gsz); u.pn = (wgid % nig) / gsz; u.aux = 0; return true; }
    __device__ __forceinline__ bool next(int i, Unit& u) const { return tile((long)i * G + c, u); }
    __device__ __forceinline__ const char* a_base(const Unit& u) const { return A + (size_t)u.pm * BM * lda2; }
    __device__ __forceinline__ unsigned a_rowoff(const Unit&, int, int R) const { return (unsigned)R * lda2; }
    __device__ __forceinline__ const char* b_base(const Unit& u) const { return Bt + (size_t)u.pn * BM * ldb2; }
};
struct BranchSched {
    static constexpr bool GATHER = false, RAGGED = false;
    DenseSched d; unsigned ldb2; int K;
    __device__ __forceinline__ bool next(int i, Unit& u) const { if (!d.tile((long)(i >> 1) * d.G + d.c, u)) return false; u.aux = i & 1; return true; }
    __device__ __forceinline__ const char* a_base(const Unit& u) const { return d.A + (size_t)u.pm * BM * (2048 * MIX_EB) + (size_t)u.aux * (1024 * MIX_EB); }
    __device__ __forceinline__ unsigned a_rowoff(const Unit&, int, int R) const { return (unsigned)R * (2048u * MIX_EB); }
    __device__ __forceinline__ const char* b_base(const Unit& u) const { return d.Bt + ((size_t)u.aux * 2048 + (size_t)u.pn * BM) * (1024 * MIX_EB); }
};
template <bool GATHER_>
struct MoeSched {
    static constexpr bool GATHER = GATHER_, gather = GATHER_, RAGGED = true;
    const volatile LAS unsigned* cnt;
    __device__ __forceinline__ int rows(const Unit& u) const { const int r = (int)cnt[u.aux] - (u.pm - (int)tpre[u.aux]) * 256; return r < 256 ? r : 256; }
    const volatile LAS unsigned* tpre; const LAS unsigned* tbl; const char* A; const char* Bt; int NN; unsigned ldb2; int K; int G, vcu;
    size_t b_estride;
    const volatile LAS unsigned* hpre; const volatile LAS unsigned* lexp; int nlight;
    __device__ __forceinline__ bool next(int i, Unit& u) const {
        const int L = i * G + vcu; const int NH = NN * (int)hpre[32];
        if (L < NH) {
            int e = 0;
            for (int j = 1; j < 32; ++j) if (NN * (int)hpre[j] <= L) e = j;
            const int l = L - NN * (int)hpre[e], T = (int)hpre[e + 1] - (int)hpre[e];
            u.pn = l / T; u.pm = (int)tpre[e] + (l - u.pn * T); u.aux = e; return true; }
        const int l2 = L - NH, j = l2 / NN; if (j >= nlight) return false;
        const int e = (int)lexp[j]; u.pn = l2 - j * NN; u.pm = (int)tpre[e + 1] - 1; u.aux = e; return true; }
    __device__ __forceinline__ const char* a_base(const Unit& u) const { return gather ? A : A + (size_t)u.pm * BM * (2048 * MOE_EB); }
    __device__ __forceinline__ unsigned a_rowoff(const Unit&, int ui, int R) const { return gather ? tbl[ui * 256 + R] : (unsigned)R * (2048u * MOE_EB); }
    __device__ __forceinline__ const char* b_base(const Unit& u) const { return Bt + (size_t)u.aux * b_estride + (size_t)u.pn * BM * ldb2; }
};

__device__ __forceinline__ void st8bf(bf16_t* p, f32x4 a, f32x4 b) { u32x4 w; w.x = pk2(a[0], a[1]); w.y = pk2(a[2], a[3]); w.z = pk2(b[0], b[1]); w.w = pk2(b[2], b[3]); *(u32x4*)p = w; }
struct EpiInProj {
    static constexpr bool PERM = true;
    bf16_t *QA, *KA, *VA, *QB, *KB, *VB, *SGA, *SGB; const float* bias; const float* cosT; const float* sinT;
    __device__ __forceinline__ void operator()(const f32x4 (&acc)[2][2][4][2], const Unit& u, int wr, int wc, int fr, int fq) const {
        const int pn = u.pn, row0 = u.pm * BM + wr * 64 + fr, cw = wc * 32 + 8 * fq;
        const float ws = MIX_FP8 ? WSCALE_INV : 1.0f;
        f32x4 bv[2][2];
#pragma unroll
        for (int bj = 0; bj < 2; ++bj)
#pragma unroll
            for (int n = 0; n < 2; ++n) bv[bj][n] = *(const f32x4*)(bias + pn * 256 + bj * 128 + cw + 4 * n);
        if (pn < 5) {
            bf16_t* O = pn < 4 ? QA : KA; const int ldo = pn < 4 ? 1024 : 256; const int hcol = (pn < 4 ? pn * 256 : 0) + wc * 64 + 8 * fq; const float qs = pn < 4 ? QSCALE : 1.0f;
#pragma unroll
            for (int ai = 0; ai < 2; ++ai)
#pragma unroll
                for (int m = 0; m < 4; ++m) { const int row = row0 + ai * HALF + m * 16;
                    f32x4 o1[2], o2[2];
#pragma unroll
                    for (int n = 0; n < 2; ++n) { const f32x4 cs = *(const f32x4*)(cosT + (size_t)row * 32 + 8 * fq + 4 * n), sn = *(const f32x4*)(sinT + (size_t)row * 32 + 8 * fq + 4 * n);
                        const f32x4 x1 = acc[ai][0][m][n] * ws + bv[0][n], x2 = acc[ai][1][m][n] * ws + bv[1][n];
                        o1[n] = (x1 * cs - x2 * sn) * qs; o2[n] = (x2 * cs + x1 * sn) * qs; }
                    bf16_t* rp = O + (size_t)row * ldo + hcol; st8bf(rp, o1[0], o1[1]); st8bf(rp + 32, o2[0], o2[1]); }
        } else if (pn < 18) {
            bf16_t* O; int ldo, col0; float sc = 1.0f;
            if (pn == 5) { O = VA; ldo = 256; col0 = 0; } else if (pn < 10) { O = QB; ldo = 1024; col0 = (pn - 6) * 256; sc = QSCALE; } else if (pn < 14) { O = KB; ldo = 1024; col0 = (pn - 10) * 256; } else { O = VB; ldo = 1024; col0 = (pn - 14) * 256; }
#pragma unroll
            for (int ai = 0; ai < 2; ++ai)
#pragma unroll
                for (int m = 0; m < 4; ++m) { bf16_t* rp = O + (size_t)(row0 + ai * HALF + m * 16) * ldo + col0 + cw;
#pragma unroll
                    for (int bj = 0; bj < 2; ++bj) st8bf(rp + bj * HALF, (acc[ai][bj][m][0] * ws + bv[bj][0]) * sc, (acc[ai][bj][m][1] * ws + bv[bj][1]) * sc); }
        } else {
            bf16_t* O = pn < 26 ? SGA : SGB; const int col0 = ((pn - 18) & 7) * 256;
#pragma unroll
            for (int ai = 0; ai < 2; ++ai)
#pragma unroll
                for (int m = 0; m < 4; ++m) { bf16_t* rp = O + (size_t)(row0 + ai * HALF + m * 16) * 2048 + col0 + cw;
#pragma unroll
                    for (int bj = 0; bj < 2; ++bj) { f32x4 a = acc[ai][bj][m][0] * ws + bv[bj][0], b = acc[ai][bj][m][1] * ws + bv[bj][1];
#pragma unroll
                        for (int j = 0; j < 4; ++j) { a[j] = fast_sigmoid(a[j]); b[j] = fast_sigmoid(b[j]); }
                        st8bf(rp + bj * HALF, a, b); } }
        }
    }
};
struct EpiBranch {
    static constexpr bool PERM = true;
    const bf16_t *SGA, *SGB; float* T1; unsigned char* MERGED;
    __device__ __forceinline__ void operator()(const f32x4 (&acc)[2][2][4][2], const Unit& u, int wr, int wc, int fr, int fq) const {
        const int row0 = u.pm * BM + wr * 64 + fr, col0 = u.pn * BM + wc * 32 + 8 * fq;
        const bf16_t* SG = u.aux ? SGB : SGA;
#pragma unroll
        for (int ai = 0; ai < 2; ++ai)
#pragma unroll
            for (int m = 0; m < 4; ++m) { const size_t off = (size_t)(row0 + ai * HALF + m * 16) * 2048 + col0;
#pragma unroll
                for (int bj = 0; bj < 2; ++bj) { const u32x4 g = *(const u32x4*)(SG + off + bj * HALF);
                    const f32x4 g0 = {bflo(g.x), bfhi(g.x), bflo(g.y), bfhi(g.y)}, g1 = {bflo(g.z), bfhi(g.z), bflo(g.w), bfhi(g.w)};
                    const float ws = MIX_FP8 ? WSCALE_INV : 1.0f;
                    f32x4 a = acc[ai][bj][m][0] * g0 * ws, b = acc[ai][bj][m][1] * g1 * ws;
                    float* tp = T1 + off + bj * HALF;
                    if (u.aux == 0) { *(f32x4*)tp = a; *(f32x4*)(tp + 4) = b; }
                    else { a += *(const f32x4*)tp; b += *(const f32x4*)(tp + 4);
                        if constexpr (P5_FP8) { u32x2 w; w.x = pk4_fp8(a[0], a[1], a[2], a[3]); w.y = pk4_fp8(b[0], b[1], b[2], b[3]); *(u32x2*)(MERGED + off + bj * HALF) = w; }
                        else st8bf((bf16_t*)MERGED + off + bj * HALF, a, b); } } }
    }
};
struct EpiOut {
    static constexpr bool PERM = false;
    const float* x; const float* mod; float* H1;
    __device__ __forceinline__ void operator()(const f32x4 (&acc)[2][2][4][2], const Unit& u, int wr, int wc, int fr, int fq) const {
        const int row0 = u.pm * BM + wr * 64 + fr, col0 = u.pn * BM + wc * 32 + 4 * fq; const float* gt = mod + (size_t)(u.pm >> 3) * MODW + 4096;
#pragma unroll
        for (int bj = 0; bj < 2; ++bj)
#pragma unroll
            for (int n = 0; n < 2; ++n) { const int col = col0 + bj * HALF + n * 16; const f32x4 g = *(const f32x4*)(gt + col);
#pragma unroll
                for (int ai = 0; ai < 2; ++ai)
#pragma unroll
                    for (int m = 0; m < 4; ++m) { const size_t off = (size_t)(row0 + ai * HALF + m * 16) * 2048 + col; *(f32x4*)(H1 + off) = *(const f32x4*)(x + off) + g * (acc[ai][bj][m][n] * (P5_FP8 ? WSCALE_INV : 1.0f)); } }
    }
};
struct EpiGU {
    static constexpr bool PERM = true;
    const float* b_gu; unsigned char* ACT;
    __device__ __forceinline__ void operator()(const f32x4 (&acc)[2][2][4][2], const Unit& u, int wr, int wc, int fr, int fq) const {
        const int row0 = u.pm * BM + wr * 64 + fr, cw = wc * 32 + 8 * fq; const float* bg = b_gu + (size_t)u.aux * 4096 + u.pn * 128 + cw;
        const float ws = MOE_FP8 ? WSCALE_INV : 1.0f;
        f32x4 bv[2][2];
#pragma unroll
        for (int bj = 0; bj < 2; ++bj)
#pragma unroll
            for (int n = 0; n < 2; ++n) bv[bj][n] = *(const f32x4*)(bg + bj * 2048 + 4 * n);
#pragma unroll
        for (int ai = 0; ai < 2; ++ai)
#pragma unroll
            for (int m = 0; m < 4; ++m) { f32x4 o[2];
#pragma unroll
                for (int n = 0; n < 2; ++n) { const f32x4 g = acc[ai][0][m][n] * ws + bv[0][n], l = acc[ai][1][m][n] * ws + bv[1][n];
#pragma unroll
                    for (int j = 0; j < 4; ++j) { const float gg = fminf(g[j], 7.0f), ll = fminf(fmaxf(l[j], -7.0f), 7.0f);
                        o[n][j] = gg * (ll + 1.0f) * __builtin_amdgcn_rcpf(1.0f + __builtin_amdgcn_exp2f(-1.702f * LOG2E * gg)); } }
                const size_t eo = (size_t)(row0 + ai * HALF + m * 16) * 2048 + u.pn * 128 + cw;
                if constexpr (MOE_FP8) { u32x2 w; w.x = pk4_fp8(o[0][0], o[0][1], o[0][2], o[0][3]); w.y = pk4_fp8(o[1][0], o[1][1], o[1][2], o[1][3]); *(u32x2*)(ACT + eo) = w; }
                else st8bf((bf16_t*)ACT + eo, o[0], o[1]); }
    }
};
struct EpiDown {
    static constexpr bool PERM = true;
    const float* b_dn; bf16_t* YS;
    __device__ __forceinline__ void operator()(const f32x4 (&acc)[2][2][4][2], const Unit& u, int wr, int wc, int fr, int fq) const {
        const int row0 = u.pm * BM + wr * 64 + fr, col0 = u.pn * BM + wc * 32 + 8 * fq; const float* bd = b_dn + (size_t)u.aux * 2048 + col0;
        const float ws = MOE_FP8 ? WSCALE_INV : 1.0f;
        f32x4 bv[2][2];
#pragma unroll
        for (int bj = 0; bj < 2; ++bj)
#pragma unroll
            for (int n = 0; n < 2; ++n) bv[bj][n] = *(const f32x4*)(bd + bj * HALF + 4 * n);
#pragma unroll
        for (int ai = 0; ai < 2; ++ai)
#pragma unroll
            for (int m = 0; m < 4; ++m) { bf16_t* rp = YS + (size_t)(row0 + ai * HALF + m * 16) * 2048 + col0;
#pragma unroll
                for (int bj = 0; bj < 2; ++bj) st8bf(rp + bj * HALF, acc[ai][bj][m][0] * ws + bv[bj][0], acc[ai][bj][m][1] * ws + bv[bj][1]); }
    }
};

__device__ __forceinline__ int in_src(int r) { const int pn = r >> 8, c = r & 255; if (pn < 5) return pn * 256 + ((c & 127) >> 5) * 64 + (c >> 7) * 32 + (c & 31); return pn < 18 ? r : r + 16; }
__device__ __forceinline__ void transpose_item(const float* __restrict__ W, size_t ldw, int k0, int src0, int src1, bf16_t* __restrict__ WT, size_t ldk, int dst0, LAS unsigned* scr, int lane) {
    const int lg = lane >> 4, lc = lane & 15;
    const int scol = (lc < 8 ? src0 : src1 - 32) + 4 * lc;
    f32x4 v[8][2];
#pragma unroll
    for (int i = 0; i < 8; ++i)
#pragma unroll
        for (int p = 0; p < 2; ++p) v[i][p] = *(const f32x4*)(W + (size_t)(k0 + 8 * i + 2 * lg + p) * ldw + scol);
#pragma unroll
    for (int i = 0; i < 8; ++i)
#pragma unroll
        for (int c = 0; c < 4; ++c) scr[(4 * lc + c) * 33 + 4 * i + lg] = pk2(v[i][0][c], v[i][1][c]);
    asm volatile("s_waitcnt lgkmcnt(0)" ::: "memory");
    const int rn = lane >> 3, ch = lane & 7;
#pragma unroll
    for (int j = 0; j < 8; ++j) { const int n = rn + 8 * j; const LAS unsigned* s = scr + n * 33 + 4 * ch; u32x4 o; o.x = s[0]; o.y = s[1]; o.z = s[2]; o.w = s[3];
        *(u32x4*)(WT + (size_t)(dst0 + n) * ldk + k0 + 8 * ch) = o; }
    asm volatile("s_waitcnt lgkmcnt(0)" ::: "memory");
}
__device__ __forceinline__ void transpose_item_f8(const float* __restrict__ W, size_t ldw, int k0, int src0, int src1, unsigned char* __restrict__ WT, size_t ldk, int dst0, LAS unsigned* scr, int lane, float scale) {
    const int lg = lane >> 4, lc = lane & 15;
    const float* wp = W + (size_t)(k0 + 4 * lg) * ldw + (lc < 8 ? src0 : src1 - 32) + 4 * lc;
#pragma unroll
    for (int hf = 0; hf < 2; ++hf) {
        f32x4 v[4][4];
#pragma unroll
        for (int i = 0; i < 4; ++i)
#pragma unroll
            for (int p = 0; p < 4; ++p) v[i][p] = *(const f32x4*)(wp + (size_t)(64 * hf + 16 * i + p) * ldw);
#pragma unroll
        for (int i = 0; i < 4; ++i)
#pragma unroll
            for (int c = 0; c < 4; ++c) scr[(4 * lc + c) * 33 + 16 * hf + 4 * i + lg] = pk4_fp8_raw(v[i][0][c] * scale, v[i][1][c] * scale, v[i][2][c] * scale, v[i][3][c] * scale);
    }
    asm volatile("s_waitcnt lgkmcnt(0)" ::: "memory");
    const int rn = lane >> 3, ch = lane & 7;
#pragma unroll
    for (int j = 0; j < 8; ++j) { const int n = rn + 8 * j; const LAS unsigned* s = scr + n * 33 + 4 * ch; u32x4 o; o.x = s[0]; o.y = s[1]; o.z = s[2]; o.w = s[3];
        *(u32x4*)(WT + (size_t)(dst0 + n) * ldk + k0 + 16 * ch) = o; }
    asm volatile("s_waitcnt lgkmcnt(0)" ::: "memory");
}
constexpr int P0_KD = MIX_FP8 ? 128 : 64;
constexpr int P0_T_HEAD = 768 + 256 + 1, P0_T_ALL = P0_T_HEAD + (2048 / P0_KD) * 136 + 2 * (1024 / P0_KD) * 32 + (2048 / P0_KD) * 32;
__device__ __forceinline__ void p0_prologue(Frame& F, const int t_lo, const int t_hi, const int gw_, const int NGW_) {
    refresh(F);
    LAS unsigned* scr = (LAS unsigned*)(F.lds + RING_OFF + F.wave * 8448);
    LAS f32x4* ca = (LAS f32x4*)(F.lds + RING_OFF + 69632);
    for (int k = F.tid; k < 2048; k += NWAVES * 64) { f32x4 v;
#pragma unroll
        for (int b = 0; b < 4; ++b) { const float cv = F.c[b * 2048 + k]; v[b] = cv / (1.0f + expf(-cv)); }
        ca[k] = v; }
    __syncthreads();
    const int gw = gw_, NGW = NGW_, lane = F.lane;
    constexpr int KD = P0_KD;
    constexpr int T_ADA = 768, T_ROPE = 256, T_BIAS = 1, T_WIN = (2048 / KD) * 136, T_WA = (1024 / KD) * 32, T_WB = (1024 / KD) * 32, T_WOUT = (2048 / KD) * 32;
    constexpr int NT = T_ADA + T_ROPE + T_BIAS + T_WIN + T_WA + T_WB + T_WOUT;
    static_assert(NT == P0_T_ALL && T_ADA + T_ROPE + T_BIAS == P0_T_HEAD, "prologue task list");
    float* mod = wsp<float>(F, WS_MOD); float* cosT = wsp<float>(F, WS_COS); float* sinT = wsp<float>(F, WS_SIN); float* binp = wsp<float>(F, WS_BINP);
    for (int it = t_lo + gw; it < t_hi; it += NGW) {
        int r = it;
        if (r < T_ADA) {
            const int j0 = 16 * r, cl = lane & 3, kr = lane >> 2;
            f32x4 a[4];
#pragma unroll
            for (int b = 0; b < 4; ++b) a[b] = (f32x4){0.f, 0.f, 0.f, 0.f};
            const float* wp = F.w_ada + (size_t)kr * MODW + j0 + 4 * cl;
#pragma unroll 8
            for (int s = 0; s < 128; ++s) { const f32x4 w4 = *(const f32x4*)(wp + (size_t)s * 16 * MODW); const f32x4 c4 = ca[16 * s + kr];
#pragma unroll
                for (int b = 0; b < 4; ++b) a[b] += w4 * c4[b]; }
#pragma unroll
            for (int b = 0; b < 4; ++b)
#pragma unroll
                for (int c = 0; c < 4; ++c) { float v = a[b][c]; v += __shfl_xor(v, 4); v += __shfl_xor(v, 8); v += __shfl_xor(v, 16); v += __shfl_xor(v, 32); a[b][c] = v; }
            if (kr == 0) { const f32x4 bb = *(const f32x4*)(F.b_ada + j0 + 4 * cl);
#pragma unroll
                for (int b = 0; b < 4; ++b) *(f32x4*)(mod + b * MODW + j0 + 4 * cl) = a[b] + bb; }
            continue; } r -= T_ADA;
        if (r < T_ROPE) {
            const int i = lane & 31, ts = lane >> 5; const float inv = 1.0f / powf(10000.0f, (float)(2 * i) / 64.0f);
            for (int j = 0; j < 16; ++j) { const int t = 32 * r + 2 * j + ts; const float ang = (float)F.pos[t] * inv; cosT[t * 32 + i] = cosf(ang); sinT[t * 32 + i] = sinf(ang); }
            continue; } r -= T_ROPE;
        if (r < T_BIAS) { for (int q = lane; q < 8704; q += 64) binp[q] = F.b_in[in_src(q)]; continue; } r -= T_BIAS;
        const float* W; size_t ldw; int kb, nb, s0, s1; unsigned char* WT; size_t ldk;
        if (r < T_WIN) { kb = r / 136; nb = r % 136; W = F.w_in; ldw = INW; s0 = in_src(64 * nb); s1 = in_src(64 * nb + 32); WT = wsp<unsigned char>(F, WS_WIN); ldk = 2048; }
        else if ((r -= T_WIN) < T_WA) { kb = r / 32; nb = r % 32; W = F.w_a; ldw = 2048; s0 = 64 * nb; s1 = s0 + 32; WT = wsp<unsigned char>(F, WS_WAB); ldk = 1024; }
        else if ((r -= T_WA) < T_WB) { kb = r / 32; nb = r % 32; W = F.w_b; ldw = 2048; s0 = 64 * nb; s1 = s0 + 32; WT = wsp<unsigned char>(F, WS_WAB) + (size_t)2048 * 1024 * MIX_EB; ldk = 1024; }
        else { r -= T_WB; W = F.w_out; ldw = 2048; WT = wsp<unsigned char>(F, WS_WOUT); ldk = 2048;
            if constexpr (MIX_FP8 && !P5_FP8) { kb = r / 32; nb = r % 32; s0 = 64 * nb; s1 = s0 + 32;
                transpose_item(W, ldw, 128 * kb, s0, s1, (bf16_t*)WT, ldk, 64 * nb, scr, lane); transpose_item(W, ldw, 128 * kb + 64, s0, s1, (bf16_t*)WT, ldk, 64 * nb, scr, lane); continue; }
            kb = r / 32; nb = r % 32; s0 = 64 * nb; s1 = s0 + 32; }
        if constexpr (MIX_FP8) transpose_item_f8(W, ldw, 128 * kb, s0, s1, WT, ldk, 64 * nb, scr, lane, WSCALE);
        else transpose_item(W, ldw, 64 * kb, s0, s1, (bf16_t*)WT, ldk, 64 * nb, scr, lane);
    }
}
constexpr int T_WGU = MOE_FP8 ? 32 * 16 * 64 : 32 * 32 * 64, T_WD = MOE_FP8 ? 32 * 16 * 32 : 32 * 32 * 32;
__device__ __forceinline__ void convert_item(Frame& F, int r, LAS unsigned* scr, int lane) {
    if (r < T_WGU) {
        if constexpr (MOE_FP8) { const int e = r >> 10, q = r & 1023, kb = q >> 6, nb = q & 63; const int r0 = 64 * nb, src = ((r0 & 255) >> 7) * 2048 + (r0 >> 8) * 128 + (r0 & 127);
            transpose_item_f8(F.w_gu + (size_t)e * 2048 * 4096, 4096, 128 * kb, src, src + 32, wsp<unsigned char>(F, WS_WGU) + (size_t)e * 4096 * 2048, 2048, r0, scr, lane, WSCALE); }
        else { const int e = r >> 11, q = r & 2047, kb = q >> 6, nb = q & 63; const int r0 = 64 * nb, src = ((r0 & 255) >> 7) * 2048 + (r0 >> 8) * 128 + (r0 & 127);
            transpose_item(F.w_gu + (size_t)e * 2048 * 4096, 4096, 64 * kb, src, src + 32, wsp<bf16_t>(F, WS_WGU) + (size_t)e * 4096 * 2048, 2048, r0, scr, lane); }
        return; }
    r -= T_WGU;
    if constexpr (MOE_FP8) { const int e = r >> 9, q = r & 511, kb = q >> 5, nb = q & 31;
        transpose_item_f8(F.w_dn + (size_t)e * 2048 * 2048, 2048, 128 * kb, 64 * nb, 64 * nb + 32, wsp<unsigned char>(F, WS_WD) + (size_t)e * 2048 * 2048, 2048, 64 * nb, scr, lane, WSCALE); }
    else { const int e = r >> 10, q = r & 1023, kb = q >> 5, nb = q & 31;
        transpose_item(F.w_dn + (size_t)e * 2048 * 2048, 2048, 64 * kb, 64 * nb, 64 * nb + 32, wsp<bf16_t>(F, WS_WD) + (size_t)e * 2048 * 2048, 2048, 64 * nb, scr, lane); }
}
struct CvItem { const char* src; unsigned char* dst; };
template <bool GU> __device__ __forceinline__ CvItem cv_decode(Frame& F, int r) {
    constexpr int N = GU ? T_WGU : T_WD; constexpr size_t ldw = GU ? 4096 : 2048;
    r = r < N ? r : 0;
    const int e = r >> (GU ? 10 : 9), q = r & (GU ? 1023 : 511), kb = q >> (GU ? 6 : 5), nb = q & (GU ? 63 : 31), r0 = 64 * nb;
    const int srcc = GU ? ((r0 & 255) >> 7) * 2048 + (r0 >> 8) * 128 + (r0 & 127) : r0;
    CvItem P;
    P.src = (const char*)((GU ? F.w_gu : F.w_dn) + (size_t)e * 2048 * ldw + (size_t)(128 * kb) * ldw + srcc);
    P.dst = (GU ? wsp<unsigned char>(F, WS_WGU) : wsp<unsigned char>(F, WS_WD)) + (size_t)e * ldw * 2048 + (size_t)r0 * 2048 + 128 * kb;
    return P;
}
template <bool GU> __device__ __forceinline__ void convert_loop(Frame& F, unsigned* head) {
    constexpr int N = GU ? T_WGU : T_WD, NP = (N + 2) / 3 * 3; constexpr unsigned ldwb = (GU ? 4096u : 2048u) * 4u;
    LAS unsigned* scr = (LAS unsigned*)(F.lds + RING_OFF + F.wave * 8448);
    const int lane = F.lane, lg = lane >> 4, lc = lane & 15, rn = lane >> 3, ch = lane & 7;
    const unsigned lo = (unsigned)(4 * lg) * ldwb + 16u * (unsigned)lc;
    f32x4 A[4][4], B[4][4], C[4][4];
#define CV_LOAD(buf, P, h) do { _Pragma("unroll") for (int i = 0; i < 4; ++i) _Pragma("unroll") for (int p = 0; p < 4; ++p) { const char* rb_ = (P).src + (size_t)(64 * (h) + 16 * i + p) * ldwb; \
        asm volatile("global_load_dwordx4 %0, %1, %2 nt" : "=v"(buf[i][p]) : "v"(lo), "s"(rb_) : "memory"); } } while (0)
#define CV_WAIT(N, buf) do { asm volatile("s_waitcnt vmcnt(" #N ")" ::: "memory"); _Pragma("unroll") for (int i = 0; i < 4; ++i) asm volatile("" : "+v"(buf[i][0]), "+v"(buf[i][1]), "+v"(buf[i][2]), "+v"(buf[i][3])); } while (0)
#define CV_PROC(buf, h) do { _Pragma("unroll") for (int i = 0; i < 4; ++i) _Pragma("unroll") for (int c = 0; c < 4; ++c) \
        scr[(4 * lc + c) * 33 + 16 * (h) + 4 * i + lg] = pk4_fp8_raw(buf[i][0][c] * WSCALE, buf[i][1][c] * WSCALE, buf[i][2][c] * WSCALE, buf[i][3][c] * WSCALE); } while (0)
#define CV_STORE(P) do { _Pragma("unroll") for (int j = 0; j < 8; ++j) { const LAS unsigned* s_ = scr + (rn + 8 * j) * 33 + 4 * ch; u32x4 o_; o_.x = s_[0]; o_.y = s_[1]; o_.z = s_[2]; o_.w = s_[3]; \
        const unsigned so_ = (unsigned)(rn + 8 * j) * 2048u + 16u * (unsigned)ch; asm volatile("global_store_dwordx4 %0, %1, %2 nt" :: "v"(so_), "v"(o_), "s"((P).dst) : "memory"); } } while (0)
    const unsigned claim_add = 3u, claim_off = 0u; unsigned long long ex_save;
#define CV_CLAIM() asm volatile("s_mov_b64 %1, exec\n\ts_mov_b64 exec, 1\n\tglobal_atomic_add %0, %2, %3, %4 sc0\n\ts_mov_b64 exec, %1" : "+v"(raw), "=&s"(ex_save) : "v"(claim_off), "v"(claim_add), "s"(head) : "memory")
    unsigned raw = 0u;
    CV_CLAIM();
    asm volatile("s_waitcnt vmcnt(0)" : "+v"(raw) :: "memory");
    int base = (int)__builtin_amdgcn_readfirstlane(raw);
    CV_CLAIM();
    CvItem P0 = cv_decode<GU>(F, base), P1, P2;
    CV_LOAD(A, P0, 0); CV_LOAD(B, P0, 1);
    {
      unsigned char* junk = wsp<unsigned char>(F, WS_JUNK) + (size_t)(blockIdx.x * NWAVES + F.wave) * 16384; const u32x4 zz_ = {0u, 0u, 0u, 0u};
#pragma unroll
      for (int j = 0; j < 8; ++j) { const unsigned so_ = (unsigned)(rn + 8 * j) * 128u + 16u * (unsigned)ch; asm volatile("global_store_dwordx4 %0, %1, %2 nt" :: "v"(so_), "v"(zz_), "s"(junk) : "memory"); } }
    while (base < NP) {
        P1 = cv_decode<GU>(F, base + 1); P2 = cv_decode<GU>(F, base + 2);
        CV_LOAD(C, P1, 0); CV_WAIT(40, A); CV_PROC(A, 0);
        CV_LOAD(A, P1, 1); CV_WAIT(40, B); CV_PROC(B, 1); CV_STORE(P0);
        CV_LOAD(B, P2, 0); CV_WAIT(40, C); CV_PROC(C, 0);
        CV_LOAD(C, P2, 1); CV_WAIT(40, A); CV_PROC(A, 1); CV_STORE(P1);
        asm volatile("s_waitcnt vmcnt(48)" : "+v"(raw) :: "memory");
        base = (int)__builtin_amdgcn_readfirstlane(raw);
        CV_CLAIM();
        P0 = cv_decode<GU>(F, base);
        CV_LOAD(A, P0, 0); CV_WAIT(41, B); CV_PROC(B, 0);
        CV_LOAD(B, P0, 1); CV_WAIT(41, C); CV_PROC(C, 1); CV_STORE(P2);
    }
#undef CV_WAIT
    asm volatile("s_waitcnt vmcnt(0)" ::: "memory");
#undef CV_CLAIM
#undef CV_LOAD
#undef CV_PROC
#undef CV_STORE
}
__device__ __forceinline__ void convert_queue(Frame& F) {
    refresh(F);
    __syncthreads();
    if constexpr (!MOE_FP8) {
        LAS unsigned* scr0 = (LAS unsigned*)(F.lds + RING_OFF + F.wave * 8448); unsigned* head0 = F.ctl + CW_CQ; constexpr int NQ0 = T_WGU + T_WD;
        for (;;) { unsigned raw0 = 0u; if (F.lane == 0) raw0 = __hip_atomic_fetch_add(head0, 1u, __ATOMIC_RELAXED, __HIP_MEMORY_SCOPE_AGENT); const int it = (int)__builtin_amdgcn_readfirstlane(raw0); if (it >= NQ0) break; convert_item(F, it, scr0, F.lane); }
        __syncthreads(); return; }
    convert_loop<true>(F, F.ctl + CW_CQ);
    convert_loop<false>(F, F.ctl + CW_CQ + 128);
    __syncthreads();
}


constexpr int CS_GU = 32 * 8 * 16, CS_DN = 32 * 8 * 8, CS_N = CS_GU + CS_DN, CS_PITCH = 65;
__device__ __forceinline__ void convert_coop(Frame& F) {
    refresh(F);
    __syncthreads();
    LAS unsigned* tile0 = (LAS unsigned*)(F.lds + RING_OFF);
    unsigned* head = F.ctl + CW_CQ + 256;
    const int lane = F.lane, w = F.wave;
    if (F.tid == 0) F.MISC[104] = __hip_atomic_fetch_add(head, 1u, __ATOMIC_RELAXED, __HIP_MEMORY_SCOPE_AGENT);
    __syncthreads();
    int slot = 0, p = 0;
    for (;;) {
        const int it = (int)F.MISC[104 + slot];
        if (it >= CS_N) break;
        if (F.tid == 0) F.MISC[104 + (slot ^ 1)] = __hip_atomic_fetch_add(head, 1u, __ATOMIC_RELAXED, __HIP_MEMORY_SCOPE_AGENT);
        const bool gu = it < CS_GU; const int r = gu ? it : it - CS_GU;
        const int e = gu ? (r >> 7) : (r >> 6), q = gu ? (r & 127) : (r & 63), kb = gu ? (q >> 4) : (q >> 3), nb = gu ? (q & 15) : (q & 7);
        const size_t ldw = gu ? 4096 : 2048;
        const float* W = (gu ? F.w_gu : F.w_dn) + (size_t)e * 2048 * ldw + (size_t)(256 * kb + 32 * w) * ldw;
        const int scol = gu ? ((lane >> 5) * 2048 + nb * 128 + 4 * (lane & 31)) : (nb * 256 + 4 * lane);
        unsigned char* O = (gu ? wsp<unsigned char>(F, WS_WGU) : wsp<unsigned char>(F, WS_WD)) + (size_t)e * ldw * 2048 + (size_t)(256 * nb) * 2048 + 256 * kb;
        LAS unsigned* T = tile0 + p * (256 * CS_PITCH);
        f32x4 v[32];
#pragma unroll
        for (int i = 0; i < 32; ++i) v[i] = __builtin_nontemporal_load((const f32x4*)(W + (size_t)i * ldw + scol));
#pragma unroll
        for (int kk = 0; kk < 8; ++kk)
#pragma unroll
            for (int c = 0; c < 4; ++c) T[(4 * lane + c) * CS_PITCH + 8 * w + kk] = pk4_fp8_raw(v[4 * kk][c] * WSCALE, v[4 * kk + 1][c] * WSCALE, v[4 * kk + 2][c] * WSCALE, v[4 * kk + 3][c] * WSCALE);
        __syncthreads();
#pragma unroll
        for (int i = 0; i < 8; ++i) { const int n = 32 * w + 4 * i + (lane >> 4), ch = lane & 15; const LAS unsigned* s_ = T + n * CS_PITCH + 4 * ch; u32x4 o; o.x = s_[0]; o.y = s_[1]; o.z = s_[2]; o.w = s_[3];
            __builtin_nontemporal_store(o, (u32x4*)(O + (size_t)n * 2048 + 16 * ch)); }
        slot ^= 1; p ^= 1;
    }
    __syncthreads();
}

__device__ __forceinline__ void p1_norm_fb(Frame& F) {
    refresh(F);
#pragma unroll 1
    for (int i0 = F.tid; i0 < 2048 * 4; i0 += 8 * NWAVES * 64) {
        f32x4 v[8];
#pragma unroll
        for (int u = 0; u < 8; ++u) { const int i = i0 + u * NWAVES * 64, k = i >> 2, q = i & 3; v[u] = *(const f32x4*)(F.w_in + (size_t)k * INW + 4608 + 4 * q); }
#pragma unroll
        for (int u = 0; u < 8; ++u) { const int i = i0 + u * NWAVES * 64, k = i >> 2, q = i & 3; const int j = k >> 8, l = (k & 255) >> 2, c = k & 3; *(LAS f32x4*)(F.lds + RING_OFF + ((((j * 4 + c) * 4 + q) * 64 + l) << 4)) = v[u]; } }
    __syncthreads();
    const int gw = F.vcu * NWAVES + F.wave, NGW = F.G * NWAVES, lane = F.lane;
    const float* mod = wsp<float>(F, WS_MOD); unsigned char* XN = wsp<unsigned char>(F, WS_XN); float* LOGF = wsp<float>(F, WS_LOGF);
    for (int row = gw; row < NTOK; row += NGW) {
        const int b = row >> 11; const float* xr = F.x + (size_t)row * DM; const float* sh = mod + b * MODW, *sc = mod + b * MODW + 2048;
        f32x4 v[8]; float ss = 0.f;
#pragma unroll
        for (int j = 0; j < 8; ++j) { v[j] = *(const f32x4*)(xr + 256 * j + 4 * lane); ss += v[j][0] * v[j][0] + v[j][1] * v[j][1] + v[j][2] * v[j][2] + v[j][3] * v[j][3]; }
        ss = wave_sum(ss); const float rstd = 1.0f / sqrtf(ss * (1.0f / DM) + 1e-5f);
        float fa[16];
#pragma unroll
        for (int h = 0; h < 16; ++h) fa[h] = 0.f;
#pragma unroll
        for (int j = 0; j < 8; ++j) { const int col = 256 * j + 4 * lane; const f32x4 g = *(const f32x4*)(F.g_mix + col), s1 = *(const f32x4*)(sc + col), h1 = *(const f32x4*)(sh + col);
            const f32x4 y = v[j] * rstd * g * (s1 + 1.0f) + h1;
            if constexpr (MIX_FP8) *(unsigned*)(XN + (size_t)row * DM + col) = pk4_fp8(y[0], y[1], y[2], y[3]);
            else { u32x2 w; w.x = pk2(y[0], y[1]); w.y = pk2(y[2], y[3]); *(u32x2*)((bf16_t*)XN + (size_t)row * DM + col) = w; }
#pragma unroll
            for (int c = 0; c < 4; ++c) {
#pragma unroll
                for (int q = 0; q < 4; ++q) { const f32x4 wv = *(const LAS f32x4*)(F.lds + RING_OFF + ((((j * 4 + c) * 4 + q) * 64 + lane) << 4));
#pragma unroll
                    for (int e = 0; e < 4; ++e) fa[4 * q + e] += y[c] * wv[e]; }
                if (c & 1) asm volatile("" ::: "memory"); } }
#pragma unroll
        for (int h = 0; h < 16; ++h) fa[h] = wave_sum(fa[h]);
        float mine = 0.f;
#pragma unroll
        for (int h = 0; h < 16; ++h) mine = (lane == h) ? fa[h] : mine;
        if (lane < 16) { const float f = mine + F.b_in[4608 + lane]; LOGF[row * 16 + lane] = fminf(f, 0.f) - log1pf(expf(-fabsf(f))); }
    }
}
__device__ __forceinline__ void p2_cumsum(Frame& F) {
    refresh(F);
    volatile LAS float* wsum_s = (volatile LAS float*)(F.MISC + 96);
    const float* LOGF = wsp<float>(F, WS_LOGF); float* CUM = wsp<float>(F, WS_CUM);
    for (int bh = F.vcu; bh < 64; bh += F.G) {
        const int b = bh >> 4, h = bh & 15, t0 = 4 * F.tid;
        float a[4];
#pragma unroll
        for (int i = 0; i < 4; ++i) a[i] = LOGF[(size_t)(b * SEQ + t0 + i) * 16 + h];
        a[1] += a[0]; a[2] += a[1]; a[3] += a[2];
        float s = a[3];
#pragma unroll
        for (int o = 1; o < 64; o <<= 1) { const float t = __shfl_up(s, o); if (F.lane >= o) s += t; }
        if (F.lane == 63) wsum_s[F.wave] = s;
        __syncthreads();
        float base = 0.f;
        for (int w = 0; w < F.wave; ++w) base += wsum_s[w];
        const float excl = base + s - a[3];
#pragma unroll
        for (int i = 0; i < 4; ++i) CUM[(size_t)bh * SEQ + t0 + i] = excl + a[i];
        __syncthreads();
    }
}

constexpr int AT_KOFF = 0, AT_VOFF = 9216, AT_COFF = 17920, AT_BUF = 18432;
template <int MODE>
__device__ __forceinline__ void attn_unit(LAS unsigned char* lds, const bf16_t* __restrict__ Q, const bf16_t* __restrict__ Kt, const bf16_t* __restrict__ Vt, const float* __restrict__ cum, unsigned char* __restrict__ O,
                                          int b, int h, int qb, float sink2, int wid) {
    const int lane = lane_id(), tid = wid * 64 + lane, r32 = lane & 31, hi = lane >> 5;
    constexpr int KP = MODE ? 1024 : 256;
    const int kvh = MODE ? h : (h >> 2);
    const int q0 = qb * 256, w0 = q0 + 32 * wid;
    const size_t rowbase = (size_t)b * SEQ;
    bf16x8 qf[4];
    { const bf16_t* qp = Q + (rowbase + w0 + r32) * 1024 + h * 64 + hi * 8;
#pragma unroll
      for (int d0 = 0; d0 < 4; ++d0) qf[d0] = *(const bf16x8*)(qp + d0 * 16); }
    const int kt_lo = MODE ? 0 : (q0 >= 128 ? ((q0 - 128) >> 6) : 0), kt_hi = (q0 + 255) >> 6;
    const int skey = tid >> 3, sch = tid & 7, vp = (tid & 255) >> 3;
    const bf16_t* kg = Kt + (rowbase + skey) * KP + kvh * 64 + sch * 8;
    const bf16_t* vg = Vt + (rowbase + 2 * vp) * KP + kvh * 64 + sch * 8;
    u32x4 kreg, vr0, vr1; float ckreg = 0.f;
#define AT_LOAD(kt) do { kreg = *(const u32x4*)(kg + (size_t)(kt) * 64 * KP); if (tid >= 256) { vr0 = *(const u32x4*)(vg + (size_t)(kt) * 64 * KP); vr1 = *(const u32x4*)(vg + (size_t)(kt) * 64 * KP + KP); } \
        if (MODE && tid < 64) ckreg = cum[(kt) * 64 + tid] * LOG2E; } while (0)
    AT_LOAD(kt_lo);
    float m = MODE ? -1e30f : sink2, l = (MODE == 0 && hi == 0) ? 1.0f : 0.0f;
    const float cq2 = MODE ? cum[w0 + r32] * LOG2E : 0.f;
    f32x16 o0 = {}, o1 = {};
    for (int kt = kt_lo; kt <= kt_hi; ++kt) {
        LAS unsigned char* buf = lds + ((kt - kt_lo) & 1) * AT_BUF;
        *(LAS u32x4*)(buf + AT_KOFF + skey * 144 + sch * 16) = kreg;
        if (tid >= 256) {
#pragma unroll
            for (int i = 0; i < 8; ++i) { const unsigned a = vr0[i >> 1], c = vr1[i >> 1];
                *(LAS unsigned*)(buf + AT_VOFF + (8 * sch + i) * 136 + vp * 4) = __builtin_amdgcn_perm(c, a, (i & 1) ? 0x07060302u : 0x05040100u); } }
        if (MODE && tid < 64) *(LAS float*)(buf + AT_COFF + tid * 4) = ckreg;
        __syncthreads();
        if (kt < kt_hi) AT_LOAD(kt + 1);
        const int k0 = kt * 64;
        const bool active = (k0 <= w0 + 31) && (MODE || (k0 + 63 >= w0 - 127));
        if (active) {
            f32x16 p0 = {}, p1 = {};
            { const LAS unsigned char* kb = buf + AT_KOFF + r32 * 144 + hi * 16;
#pragma unroll
              for (int d0 = 0; d0 < 4; ++d0) { const bf16x8 ka = *(const LAS bf16x8*)(kb + d0 * 32), kc = *(const LAS bf16x8*)(kb + 32 * 144 + d0 * 32);
                  p0 = __builtin_amdgcn_mfma_f32_32x32x16_bf16(ka, qf[d0], p0, 0, 0, 0); p1 = __builtin_amdgcn_mfma_f32_32x32x16_bf16(kc, qf[d0], p1, 0, 0, 0); } }
            if (MODE) {
#pragma unroll
                for (int g = 0; g < 4; ++g) { const f32x4 c0 = *(const LAS f32x4*)(buf + AT_COFF + (8 * g + 4 * hi) * 4), c1 = *(const LAS f32x4*)(buf + AT_COFF + (32 + 8 * g + 4 * hi) * 4);
#pragma unroll
                    for (int j = 0; j < 4; ++j) { p0[4 * g + j] += cq2 - c0[j]; p1[4 * g + j] += cq2 - c1[j]; } } }
            const bool need_mask = MODE ? (k0 + 63 > w0) : true;
            if (need_mask) { const int q = w0 + r32;
#pragma unroll
                for (int r = 0; r < 16; ++r) { const int key = k0 + (r & 3) + 8 * (r >> 2) + 4 * hi;
                    const bool v0 = (key <= q) && (MODE || key + 127 >= q), v1 = (key + 32 <= q) && (MODE || key + 32 + 127 >= q);
                    p0[r] = v0 ? p0[r] : -INFINITY; p1[r] = v1 ? p1[r] : -INFINITY; } }
            float rm = __builtin_fmaxf(p0[0], p1[0]);
#pragma unroll
            for (int r = 1; r < 16; ++r) rm = __builtin_fmaxf(__builtin_fmaxf(rm, p0[r]), p1[r]);
            { const unsigned ru = __builtin_bit_cast(unsigned, rm); auto rr = __builtin_amdgcn_permlane32_swap(ru, ru, false, false);
              rm = __builtin_fmaxf(__builtin_bit_cast(float, rr[0]), __builtin_bit_cast(float, rr[1])); }
            const float mn = fmaxf(m, rm), alpha = __builtin_amdgcn_exp2f(m - mn);
            const bool grew = mn > m; m = mn;
            float ps = 0.f;
#pragma unroll
            for (int r = 0; r < 16; ++r) { p0[r] = __builtin_amdgcn_exp2f(p0[r] - mn); p1[r] = __builtin_amdgcn_exp2f(p1[r] - mn); ps += p0[r] + p1[r]; }
            l = l * alpha + ps;
            if (__any(grew)) {
#pragma unroll
                for (int r = 0; r < 16; ++r) { o0[r] *= alpha; o1[r] *= alpha; } }
            bf16x8 pf[4];
            { u32x4 w;
              w.x = pk2(p0[0], p0[1]); w.y = pk2(p0[2], p0[3]); w.z = pk2(p0[4], p0[5]); w.w = pk2(p0[6], p0[7]); pf[0] = __builtin_bit_cast(bf16x8, w);
              w.x = pk2(p0[8], p0[9]); w.y = pk2(p0[10], p0[11]); w.z = pk2(p0[12], p0[13]); w.w = pk2(p0[14], p0[15]); pf[1] = __builtin_bit_cast(bf16x8, w);
              w.x = pk2(p1[0], p1[1]); w.y = pk2(p1[2], p1[3]); w.z = pk2(p1[4], p1[5]); w.w = pk2(p1[6], p1[7]); pf[2] = __builtin_bit_cast(bf16x8, w);
              w.x = pk2(p1[8], p1[9]); w.y = pk2(p1[10], p1[11]); w.z = pk2(p1[12], p1[13]); w.w = pk2(p1[14], p1[15]); pf[3] = __builtin_bit_cast(bf16x8, w); }
            const LAS unsigned char* vb = buf + AT_VOFF + r32 * 136 + hi * 8;
#pragma unroll
            for (int ks = 0; ks < 4; ++ks) {
                { const u32x2 lo = *(const LAS u32x2*)(vb + ks * 32), hh = *(const LAS u32x2*)(vb + ks * 32 + 16); const u32x4 w = {lo.x, lo.y, hh.x, hh.y};
                  o0 = __builtin_amdgcn_mfma_f32_32x32x16_bf16(__builtin_bit_cast(bf16x8, w), pf[ks], o0, 0, 0, 0); }
                { const u32x2 lo = *(const LAS u32x2*)(vb + 32 * 136 + ks * 32), hh = *(const LAS u32x2*)(vb + 32 * 136 + ks * 32 + 16); const u32x4 w = {lo.x, lo.y, hh.x, hh.y};
                  o1 = __builtin_amdgcn_mfma_f32_32x32x16_bf16(__builtin_bit_cast(bf16x8, w), pf[ks], o1, 0, 0, 0); } }
        }
    }
#undef AT_LOAD
    l += __shfl_xor(l, 32);
    const float inv = 1.0f / l;
    const size_t oe = (rowbase + w0 + r32) * 2048 + MODE * 1024 + h * 64 + 4 * hi;
#pragma unroll
    for (int g = 0; g < 4; ++g) {
        if constexpr (MIX_FP8) { *(unsigned*)(O + oe + 8 * g) = pk4_fp8(o0[4 * g] * inv, o0[4 * g + 1] * inv, o0[4 * g + 2] * inv, o0[4 * g + 3] * inv);
            *(unsigned*)(O + oe + 32 + 8 * g) = pk4_fp8(o1[4 * g] * inv, o1[4 * g + 1] * inv, o1[4 * g + 2] * inv, o1[4 * g + 3] * inv); }
        else { bf16_t* op = (bf16_t*)O + oe; u32x2 w; w.x = pk2(o0[4 * g] * inv, o0[4 * g + 1] * inv); w.y = pk2(o0[4 * g + 2] * inv, o0[4 * g + 3] * inv); *(u32x2*)(op + 8 * g) = w;
            w.x = pk2(o1[4 * g] * inv, o1[4 * g + 1] * inv); w.y = pk2(o1[4 * g + 2] * inv, o1[4 * g + 3] * inv); *(u32x2*)(op + 32 + 8 * g) = w; } }
    __syncthreads();
}
__device__ __forceinline__ void p3_attention(Frame& F) {
    refresh(F);
    const bf16_t *QA = wsp<bf16_t>(F, WS_QA), *KA = wsp<bf16_t>(F, WS_KA), *VA = wsp<bf16_t>(F, WS_VA), *QB = wsp<bf16_t>(F, WS_QB), *KB = wsp<bf16_t>(F, WS_KB), *VB = wsp<bf16_t>(F, WS_VB);
    const float* CUM = wsp<float>(F, WS_CUM); unsigned char* YAB = wsp<unsigned char>(F, WS_YAB);
    LAS unsigned char* lds = F.lds + RING_OFF;
    unsigned* head = F.ctl + CW_AQ;
    for (;;) {
        __syncthreads();
        if (F.tid == 0) F.MISC[100] = __hip_atomic_fetch_add(head, 1u, __ATOMIC_RELAXED, __HIP_MEMORY_SCOPE_AGENT);
        __syncthreads();
        const int u = (int)F.MISC[100];
        if (u >= 1024) break;
        if (u < 512) { const int bh = u & 63, qb = 7 - (u >> 6); attn_unit<1>(lds, QB, KB, VB, CUM + (size_t)bh * SEQ, YAB, bh >> 4, bh & 15, qb, 0.f, F.wave); }
        else { const int v = u - 512, bh = v >> 3, qb = v & 7; attn_unit<0>(lds, QA, KA, VA, nullptr, YAB, bh >> 4, bh & 15, qb, F.sinks[bh & 15] * LOG2E, F.wave); }
    }
}

template <int HH>
__device__ __forceinline__ void p6_half(Frame& F) {
    refresh(F);
    const int gw = F.vcu * NWAVES + F.wave, NGW = F.G * NWAVES, lane = F.lane;
    const float* mod = wsp<float>(F, WS_MOD); const float* H1 = wsp<float>(F, WS_H1); unsigned char* XN2 = wsp<unsigned char>(F, WS_XN2);
    int* TEID = wsp<int>(F, WS_TEID); int* TPOS = wsp<int>(F, WS_TPOS); float* TGATE = wsp<float>(F, WS_TGATE); int* TOKOF = wsp<int>(F, WS_TOKOF);
    LAS float* part = (LAS float*)(F.lds + TBL_OFF) + F.wave * 256 + lane;
    __syncthreads();
#pragma unroll 1
    for (int i0 = F.tid; i0 < 1024 * 8; i0 += 8 * NWAVES * 64) {
        f32x4 v[8];
#pragma unroll
        for (int u = 0; u < 8; ++u) { const int i = i0 + u * NWAVES * 64, kk = i >> 3, q = i & 7; v[u] = *(const f32x4*)(F.w_r + (size_t)(1024 * HH + kk) * 32 + 4 * q); }
#pragma unroll
        for (int u = 0; u < 8; ++u) { const int i = i0 + u * NWAVES * 64, kk = i >> 3, q = i & 7; const int jj = kk >> 8, l = (kk & 255) >> 2, c = kk & 3; *(LAS f32x4*)(F.lds + RING_OFF + ((((jj * 4 + c) * 8 + q) * 64 + l) << 4)) = v[u]; } }
    __syncthreads();
#pragma unroll 1
    for (int ri = 0; ri < 4; ++ri) {
        const int row = gw + ri * NGW; if (row >= NTOK) break;
        int lane4 = 4 * lane; asm volatile("" : "+v"(lane4));
        const int b = row >> 11; const float* xr = H1 + (size_t)row * DM + lane4; const float* sh = mod + b * MODW + 6144 + lane4, *sc = mod + b * MODW + 8192 + lane4; const float* gp = F.g_ffn + lane4;
        f32x4 v[4]; float ss = 0.f;
#pragma unroll
        for (int j = 0; j < 4; ++j) { v[j] = *(const f32x4*)(xr + 256 * (4 * HH + j)); const f32x4 o = *(const f32x4*)(xr + 256 * (4 * (1 - HH) + j));
            ss += v[j][0] * v[j][0] + v[j][1] * v[j][1] + v[j][2] * v[j][2] + v[j][3] * v[j][3] + o[0] * o[0] + o[1] * o[1] + o[2] * o[2] + o[3] * o[3]; }
        ss = wave_sum(ss); const float rstd = 1.0f / sqrtf(ss * (1.0f / DM) + 1e-5f);
        float a[32];
#pragma unroll
        for (int e = 0; e < 32; ++e) a[e] = 0.f;
        const LAS unsigned char* wl = F.lds + RING_OFF + 4 * lane4;
#pragma unroll
        for (int jj = 0; jj < 4; ++jj) { const int col = 256 * (4 * HH + jj); const f32x4 g = *(const f32x4*)(gp + col), s1 = *(const f32x4*)(sc + col), h1 = *(const f32x4*)(sh + col);
            const f32x4 y = v[jj] * rstd * g * (s1 + 1.0f) + h1;
            if constexpr (MOE_FP8) *(unsigned*)(XN2 + (size_t)row * DM + col + lane4) = pk4_fp8(y[0], y[1], y[2], y[3]);
            else { u32x2 w; w.x = pk2(y[0], y[1]); w.y = pk2(y[2], y[3]); *(u32x2*)((bf16_t*)XN2 + (size_t)row * DM + col + lane4) = w; }
#pragma unroll
            for (int c = 0; c < 4; ++c) {
#pragma unroll
                for (int q = 0; q < 8; ++q) { const f32x4 wv = *(const LAS f32x4*)(wl + ((((jj * 4 + c) * 8 + q) * 64) << 4));
#pragma unroll
                    for (int e = 0; e < 4; ++e) a[4 * q + e] += y[c] * wv[e]; }
                asm volatile("" ::: "memory"); } }
#define P6_RSTEP(XF, MASK, HALF) { const bool up = (lane & (MASK)) != 0; _Pragma("unroll") for (int i = 0; i < (HALF); ++i) { const float keep = up ? a[i + (HALF)] : a[i], give = up ? a[i] : a[i + (HALF)]; a[i] = keep + XF; } }
        P6_RSTEP(__shfl_xor(give, 32), 32, 16) P6_RSTEP(__shfl_xor(give, 16), 16, 8) P6_RSTEP(__shfl_xor(give, 8), 8, 4) P6_RSTEP(__shfl_xor(give, 4), 4, 2) P6_RSTEP(__shfl_xor(give, 2), 2, 1)
#undef P6_RSTEP
        float lg = a[0] + __shfl_xor(a[0], 1);
        if (HH == 0) { part[ri * 64] = lg; continue; }
        lg += part[ri * 64] + F.b_r[lane >> 1];
        float val[4]; int idx[4];
        float cur = lg;
#pragma unroll
        for (int k = 0; k < 4; ++k) { float bv = cur; int bi = lane >> 1;
#pragma unroll
            for (int o = 1; o < 64; o <<= 1) { const float ov = __shfl_xor(bv, o); const int oi = __shfl_xor(bi, o); if (ov > bv || (ov == bv && oi < bi)) { bv = ov; bi = oi; } }
            val[k] = bv; idx[k] = bi; if ((lane >> 1) == bi) cur = -INFINITY; }
        float ex[4], sm = 0.f;
#pragma unroll
        for (int k = 0; k < 4; ++k) { ex[k] = expf(val[k] - val[0]); sm += ex[k]; }
        if (lane < 4) { int e = idx[0]; float gt = ex[0];
#pragma unroll
            for (int k = 1; k < 4; ++k) if (lane == k) { e = idx[k]; gt = ex[k]; }
            const int p = (int)atomicAdd(F.ctl + CW_CNT + e, 1u);
            TOKOF[e * NTOK + p] = row; TEID[row * 4 + lane] = e; TPOS[row * 4 + lane] = p; TGATE[row * 4 + lane] = gt / sm; }
    }
}
__device__ __forceinline__ void p6_norm_router(Frame& F) { p6_half<0>(F); p6_half<1>(F); }
__device__ __forceinline__ void moe_tables(Frame& F) {
    refresh(F);
    __syncthreads();
    if (F.tid == 0) { unsigned s = 0, h = 0, nl = 0;
        for (int e = 0; e < 32; ++e) { const unsigned c = __hip_atomic_load(F.ctl + CW_CNT + e, __ATOMIC_RELAXED, __HIP_MEMORY_SCOPE_AGENT); F.MISC[48 + e] = c; F.MISC[8 + e] = s; s += (c + 255u) >> 8;
            const unsigned rem = c & 255u; F.MISC[112 + e] = h; h += (c >> 8) + (rem > 128u ? 1u : 0u); if (rem >= 1u && rem <= 128u) { F.MISC[152 + nl] = (unsigned)e; ++nl; } }
        F.MISC[8 + 32] = s; F.MISC[112 + 32] = h; F.MISC[190] = nl; }
    __syncthreads();
}
__device__ __forceinline__ void p7_gu(Frame& F) {
    moe_tables(F);
    MoeSched<true> S; S.tpre = F.MISC + 8; S.cnt = F.MISC + 48; S.hpre = F.MISC + 112; S.lexp = F.MISC + 152; S.nlight = (int)F.MISC[190]; S.tbl = (const LAS unsigned*)(F.lds + TBL_OFF); S.A = (const char*)wsp<bf16_t>(F, WS_XN2); S.Bt = (const char*)wsp<bf16_t>(F, WS_WGU); S.NN = 16; S.ldb2 = 2048 * MOE_EB; S.K = 2048;
    S.G = F.G; S.vcu = F.vcu; S.b_estride = (size_t)4096 * 2048 * MOE_EB;
    { const int* TOKOF = wsp<int>(F, WS_TOKOF); Unit u; LAS unsigned* tbl = (LAS unsigned*)(F.lds + TBL_OFF);
      for (int i = 0; i < 10 && S.next(i, u); ++i) { if (F.tid < 256) { const int e = u.aux, p = (u.pm - (int)F.MISC[8 + e]) * 256 + F.tid, cnt = (int)F.MISC[48 + e]; const int tok = TOKOF[e * NTOK + (p < cnt ? p : 0)]; tbl[i * 256 + F.tid] = (unsigned)tok * (2048u * MOE_EB); } }
      __syncthreads(); }
    EpiGU E{F.b_gu, wsp<unsigned char>(F, WS_ACT)};
    gemm_phase<EpiGU, MoeSched<true>, true, MOE_FP8>(F.lds + RING_OFF, S, E, F.wave);
}
__device__ __forceinline__ void p8_down(Frame& F) {
    moe_tables(F);
    MoeSched<false> S; S.tpre = F.MISC + 8; S.cnt = F.MISC + 48; S.hpre = F.MISC + 112; S.lexp = F.MISC + 152; S.nlight = (int)F.MISC[190]; S.tbl = nullptr; S.A = (const char*)wsp<bf16_t>(F, WS_ACT); S.Bt = (const char*)wsp<bf16_t>(F, WS_WD); S.NN = 8; S.ldb2 = 2048 * MOE_EB; S.K = 2048;
    S.G = F.G; S.vcu = F.vcu; S.b_estride = (size_t)2048 * 2048 * MOE_EB;
    EpiDown E{F.b_dn, wsp<bf16_t>(F, WS_YS)};
    gemm_phase<EpiDown, MoeSched<false>, true, MOE_FP8>(F.lds + RING_OFF, S, E, F.wave);
}
__device__ __forceinline__ void p9_final(Frame& F) {
    refresh(F);
    moe_tables(F);
    const int gw = F.vcu * NWAVES + F.wave, NGW = F.G * NWAVES, lane = F.lane;
    const float* mod = wsp<float>(F, WS_MOD); const float* H1 = wsp<float>(F, WS_H1); const bf16_t* YS = wsp<bf16_t>(F, WS_YS);
    const int* TEID = wsp<int>(F, WS_TEID); const int* TPOS = wsp<int>(F, WS_TPOS); const float* TGATE = wsp<float>(F, WS_TGATE);
    for (int row = gw; row < NTOK; row += NGW) {
        const int b = row >> 11; const float* gt = mod + b * MODW + 10240;
        const bf16_t* yr[4]; float gw4[4];
#pragma unroll
        for (int k = 0; k < 4; ++k) { const int e = TEID[row * 4 + k]; yr[k] = YS + ((size_t)F.MISC[8 + e] * 256 + TPOS[row * 4 + k]) * 2048; gw4[k] = TGATE[row * 4 + k]; }
        f32x4 v[8]; float ss = 0.f;
#pragma unroll
        for (int j = 0; j < 8; ++j) { const int col = 256 * j + 4 * lane; f32x4 y = {0.f, 0.f, 0.f, 0.f};
#pragma unroll
            for (int k = 0; k < 4; ++k) { const u32x2 w = *(const u32x2*)(yr[k] + col); y += (f32x4){bflo(w.x), bfhi(w.x), bflo(w.y), bfhi(w.y)} * gw4[k]; }
            v[j] = *(const f32x4*)(H1 + (size_t)row * DM + col) + *(const f32x4*)(gt + col) * y;
            ss += v[j][0] * v[j][0] + v[j][1] * v[j][1] + v[j][2] * v[j][2] + v[j][3] * v[j][3]; }
        ss = wave_sum(ss); const float rstd = 1.0f / sqrtf(ss * (1.0f / DM) + 1e-5f);
#pragma unroll
        for (int j = 0; j < 8; ++j) { const int col = 256 * j + 4 * lane; *(f32x4*)(F.out + (size_t)row * DM + col) = v[j] * rstd * *(const f32x4*)(F.g_fin + col); }
    }
}

constexpr int PER_PHASE = 10;
struct Args { const void* in[20]; float* out; unsigned char* ws; int ph_lo, ph_hi; };
__global__ void __launch_bounds__(NWAVES * 64, 2) mega_fwd(Args args) {
    extern __shared__ __attribute__((aligned(16))) unsigned char lds_raw[];
    Frame F;
    F.lds = (LAS unsigned char*)lds_raw; F.MISC = (volatile LAS unsigned*)(F.lds + MISC_OFF);
    F.tid = threadIdx.x; F.lane = F.tid & 63; F.wave = __builtin_amdgcn_readfirstlane(F.tid >> 6);
    F.G = gridDim.x; { const int bx = blockIdx.x; F.vcu = (F.G % 8 == 0) ? (bx % 8) * (F.G / 8) + bx / 8 : bx; }
    F.ws = args.ws; F.ctl = (unsigned*)(args.ws + WS_CTL); F.out = args.out;
    F.x = (const float*)args.in[0]; F.c = (const float*)args.in[1]; F.pos = (const int*)args.in[2]; F.w_ada = (const float*)args.in[3]; F.b_ada = (const float*)args.in[4]; F.g_mix = (const float*)args.in[5];
    F.w_in = (const float*)args.in[6]; F.b_in = (const float*)args.in[7]; F.sinks = (const float*)args.in[8]; F.w_a = (const float*)args.in[9]; F.w_b = (const float*)args.in[10]; F.w_out = (const float*)args.in[11];
    F.g_ffn = (const float*)args.in[12]; F.w_r = (const float*)args.in[13]; F.b_r = (const float*)args.in[14]; F.w_gu = (const float*)args.in[15]; F.b_gu = (const float*)args.in[16]; F.w_dn = (const float*)args.in[17];
    F.b_dn = (const float*)args.in[18]; F.g_fin = (const float*)args.in[19];
    for (int u = F.tid; u < 256; u += NWAVES * 64) F.MISC[u] = 0u;
    __syncthreads();
    refresh(F);
    const int lo = args.ph_lo, hi = args.ph_hi;
    const bool one_launch = true; (void)lo; (void)hi;
    XcdBarrier bar; bar.bar = (unsigned*)(F.ctl + CW_BAR); bar.x = 0; bar.st = nullptr; bar.total = 0;
    XcdBarrier bar2 = bar;
    const bool is_comp = (int)blockIdx.x < NCOMP || F.G <= NCOMP;
    const int ncomp = F.G <= NCOMP ? F.G : NCOMP;
    if (one_launch) { bar = xcd_barrier_post((unsigned*)(F.ctl + CW_BAR), F.MISC + 0, (unsigned)F.G);
        if (is_comp) bar2 = xcd_barrier_post((unsigned*)(F.ctl + CW_BAR2), F.MISC + 2, (unsigned)ncomp); }
#ifndef REPEAT_MASK
#define REPEAT_MASK 0
#endif
#define IN(k) true
#define REP(k, body) do { if ((REPEAT_MASK >> (k)) & 1) { body; xcd_barrier(bar); } } while (0)
#define REP2(k, body) do { if ((REPEAT_MASK >> (k)) & 1) { body; xcd_barrier(bar2); } } while (0)
#define SEAM(k) do { if (IN(k) && IN((k) + 1)) xcd_barrier(bar); } while (0)
    if (one_launch) {
        if (is_comp) {
            const int G0 = F.G, v0 = F.vcu; F.G = ncomp; { const int bx = blockIdx.x; F.vcu = (ncomp % 8 == 0) ? (bx % 8) * (ncomp / 8) + bx / 8 : bx; }
            const bool split0 = ncomp < G0;
            p0_prologue(F, 0, split0 ? P0_T_HEAD : P0_T_ALL, F.vcu * NWAVES + F.wave, F.G * NWAVES); xcd_barrier(bar2);
            REP2(1, p1_norm_fb(F)); p1_norm_fb(F); xcd_barrier(bar2);
            if (split0) {
                if (F.tid == 0) { unsigned* flag = F.ctl + CW_SFLAG; unsigned* tmo = (unsigned*)(F.ctl + CW_BAR) + XB_TMO; const unsigned want = (unsigned)(G0 - ncomp);
                    XB_SPIN(xb_ld(flag) < want, (unsigned*)(F.ctl + CW_BAR)); (void)tmo;
                    __builtin_amdgcn_fence(__ATOMIC_ACQUIRE, "agent"); asm volatile("s_waitcnt vmcnt(0)" ::: "memory"); }
                __syncthreads(); }
            { p2_cumsum(F);
              DenseSched S; S.init(wsp<bf16_t>(F, WS_XN), 2048 * MIX_EB, wsp<bf16_t>(F, WS_WIN), 2048 * MIX_EB, 2048, NTOK, 8704, ncomp, (int)blockIdx.x);
              EpiInProj E{wsp<bf16_t>(F, WS_QA), wsp<bf16_t>(F, WS_KA), wsp<bf16_t>(F, WS_VA), wsp<bf16_t>(F, WS_QB), wsp<bf16_t>(F, WS_KB), wsp<bf16_t>(F, WS_VB), wsp<bf16_t>(F, WS_SGA), wsp<bf16_t>(F, WS_SGB),
                          wsp<float>(F, WS_BINP), wsp<float>(F, WS_COS), wsp<float>(F, WS_SIN)};
              REP2(2, (gemm_phase<EpiInProj, DenseSched, true, MIX_FP8>(F.lds + RING_OFF, S, E, F.wave)));
              gemm_phase<EpiInProj, DenseSched, true, MIX_FP8>(F.lds + RING_OFF, S, E, F.wave); }
            xcd_barrier(bar2);
            p3_attention(F);
            xcd_barrier(bar2);
            {
                BranchSched S; S.d.init(wsp<bf16_t>(F, WS_YAB), 2048 * MIX_EB, wsp<bf16_t>(F, WS_WAB), 1024 * MIX_EB, 1024, NTOK, 2048, ncomp, (int)blockIdx.x); S.ldb2 = 1024 * MIX_EB; S.K = 1024;
                EpiBranch E{wsp<bf16_t>(F, WS_SGA), wsp<bf16_t>(F, WS_SGB), wsp<float>(F, WS_T1), wsp<unsigned char>(F, WS_MERGED)};
                gemm_phase<EpiBranch, BranchSched, true, MIX_FP8>(F.lds + RING_OFF, S, E, F.wave); }
            xcd_barrier(bar2);
            {
                DenseSched S; S.init(wsp<bf16_t>(F, WS_MERGED), 2048 * P5_EB, wsp<bf16_t>(F, WS_WOUT), 2048 * P5_EB, 2048, NTOK, 2048, ncomp, (int)blockIdx.x);
                EpiOut E{F.x, wsp<float>(F, WS_MOD), wsp<float>(F, WS_H1)};
                gemm_phase<EpiOut, DenseSched, true, P5_FP8>(F.lds + RING_OFF, S, E, F.wave); }
            F.G = G0; F.vcu = v0;
        }
#ifndef CONV_COOP
#define CONV_COOP 1
#endif
        if (!is_comp) {
            p0_prologue(F, P0_T_HEAD, P0_T_ALL, ((int)blockIdx.x - ncomp) * NWAVES + F.wave, (F.G - ncomp) * NWAVES);
            asm volatile("s_waitcnt vmcnt(0)" ::: "memory"); __syncthreads();
            if (F.tid == 0) { __builtin_amdgcn_fence(__ATOMIC_RELEASE, "agent"); asm volatile("s_waitcnt vmcnt(0)" ::: "memory"); (void)xb_add(F.ctl + CW_SFLAG, 1u); }
        }
        if (CONV_MODE == 0 || (CONV_MODE == 1 && !is_comp) || (CONV_MODE == 2 && is_comp)) { if (CONV_COOP && MOE_FP8) convert_coop(F); else convert_queue(F); }
        xcd_barrier(bar);
    }
    if (IN(6)) { p6_norm_router(F); } SEAM(6);
    if (IN(7)) { REP(7, p7_gu(F)); p7_gu(F); } SEAM(7);
    if (IN(8)) { REP(8, p8_down(F)); p8_down(F); } SEAM(8);
    if (IN(9)) { REP(9, p9_final(F)); p9_final(F); }
#undef IN
#undef SEAM
}

static void run_opt(void* const* d_in, float* out, unsigned char* ws, hipStream_t stream, int n_launches) {
    static int grid = 0;
    if (grid == 0) {
        int dev = 0, cus = 0;
        if (hipGetDevice(&dev) != hipSuccess || hipDeviceGetAttribute(&cus, hipDeviceAttributeMultiprocessorCount, dev) != hipSuccess) { grid = -1; return; }
        if (hipFuncSetAttribute((const void*)mega_fwd, hipFuncAttributeMaxDynamicSharedMemorySize, LDS_BYTES) != hipSuccess) { grid = -1; return; }
        int per_cu = 0; (void)hipOccupancyMaxActiveBlocksPerMultiprocessor(&per_cu, (const void*)mega_fwd, NWAVES * 64, LDS_BYTES); (void)hipGetLastError();
        grid = cus;
    }
    if (grid < 0) return;
    (void)hipMemsetAsync(ws + WS_CTL, 0, CTL_ZERO_BYTES, stream);
    Args a{};
    for (int i = 0; i < 20; ++i) a.in[i] = d_in[i];
    a.out = out; a.ws = ws;
    (void)n_launches; a.ph_lo = 0; a.ph_hi = PER_PHASE; hipLaunchKernelGGL(mega_fwd, dim3(grid), dim3(NWAVES * 64), LDS_BYTES, stream, a);
}
}

extern "C" void kernel_launch(void* const* d_in, const int* in_sizes, int n_in, void* d_out, int out_size, void* d_ws, size_t ws_size, hipStream_t stream) {
    mk::run_opt(d_in, (float*)d_out, (unsigned char*)d_ws, stream, 1);
}
```

```cpp
#include <hip/hip_runtime.h>
#include <stdint.h>
#include <math.h>
namespace mk {
#define LAS __attribute__((address_space(3)))
#define GAS __attribute__((address_space(1)))
typedef unsigned short bf16_t;
typedef short bf16x8 __attribute__((ext_vector_type(8)));
typedef float f32x4 __attribute__((ext_vector_type(4)));
typedef float f32x2 __attribute__((ext_vector_type(2)));
typedef float f32x16 __attribute__((ext_vector_type(16)));
typedef unsigned u32x4 __attribute__((ext_vector_type(4)));
typedef unsigned u32x2 __attribute__((ext_vector_type(2)));
typedef __bf16 bf16x2_t __attribute__((ext_vector_type(2)));
typedef int i32x4 __attribute__((ext_vector_type(4)));
typedef int i32x8 __attribute__((ext_vector_type(8)));

constexpr int NTOK = 8192, DM = 2048, SEQ = 2048, INW = 8720, NEXP = 32, MODW = 12288;
constexpr float LOG2E = 1.4426950408889634f;
constexpr float QSCALE = 0.125f * LOG2E;

__device__ __forceinline__ unsigned pk2(float lo, float hi) { f32x2 v = {lo, hi}; bf16x2_t b = __builtin_convertvector(v, bf16x2_t); return __builtin_bit_cast(unsigned, b); }
__device__ __forceinline__ float bflo(unsigned u) { return __builtin_bit_cast(float, u << 16); }
__device__ __forceinline__ float bfhi(unsigned u) { return __builtin_bit_cast(float, u & 0xffff0000u); }
__device__ __forceinline__ unsigned pk4_fp8_raw(float a, float b, float c, float d) { int w = 0; w = __builtin_amdgcn_cvt_pk_fp8_f32(a, b, w, false); w = __builtin_amdgcn_cvt_pk_fp8_f32(c, d, w, true); return (unsigned)w; }
__device__ __forceinline__ float sat448(float x) { return __builtin_amdgcn_fmed3f(x, -448.0f, 448.0f); }
__device__ __forceinline__ unsigned pk4_fp8(float a, float b, float c, float d) { return pk4_fp8_raw(a, b, c, d); }
__device__ __forceinline__ i32x8 cat8(bf16x8 lo, bf16x8 hi) { return __builtin_shufflevector(__builtin_bit_cast(i32x4, lo), __builtin_bit_cast(i32x4, hi), 0, 1, 2, 3, 4, 5, 6, 7); }
__device__ __forceinline__ int lane_id() { int l = (int)__builtin_amdgcn_mbcnt_hi(~0u, __builtin_amdgcn_mbcnt_lo(~0u, 0u)); asm volatile("" : "+v"(l)); return l; }
template <int CTRL> __device__ __forceinline__ float dpp_mov(float x) { return __builtin_bit_cast(float, __builtin_amdgcn_update_dpp(0, __builtin_bit_cast(int, x), CTRL, 0xF, 0xF, true)); }
__device__ __forceinline__ float lx1(float x) { return dpp_mov<0xB1>(x); }
__device__ __forceinline__ float lx2(float x) { return dpp_mov<0x4E>(x); }
__device__ __forceinline__ float lx4(float x) { return dpp_mov<0x1B>(dpp_mov<0x141>(x)); }
__device__ __forceinline__ float lx8(float x) { return dpp_mov<0x128>(x); }
__device__ __forceinline__ float lx16(float x, int lane) { const unsigned u = __builtin_bit_cast(unsigned, x); auto rr = __builtin_amdgcn_permlane16_swap(u, u, false, false); return __builtin_bit_cast(float, (lane & 16) ? rr[0] : rr[1]); }
__device__ __forceinline__ float lx32(float x, int lane) { const unsigned u = __builtin_bit_cast(unsigned, x); auto rr = __builtin_amdgcn_permlane32_swap(u, u, false, false); return __builtin_bit_cast(float, (lane & 32) ? rr[0] : rr[1]); }
__device__ __forceinline__ float wave_sum_v(float v) {
    v += lx1(v); v += lx2(v); v += lx4(v); v += lx8(v);
    { const unsigned u = __builtin_bit_cast(unsigned, v); auto rr = __builtin_amdgcn_permlane16_swap(u, u, false, false); v = __builtin_bit_cast(float, rr[0]) + __builtin_bit_cast(float, rr[1]); }
    { const unsigned u = __builtin_bit_cast(unsigned, v); auto rr = __builtin_amdgcn_permlane32_swap(u, u, false, false); v = __builtin_bit_cast(float, rr[0]) + __builtin_bit_cast(float, rr[1]); }
    return v;
}
__device__ __forceinline__ float fast_sigmoid(float x) { return __builtin_amdgcn_rcpf(1.0f + __builtin_amdgcn_exp2f(-x * LOG2E)); }

constexpr int BM = 256, BK = 64, HALF = 128, HTB = HALF * BK * 2, STAGE_BYTES = 8 * HTB, NXCD = 8, WGM = 8;
__host__ __device__ __forceinline__ int lds_byte(int r, int c) { const int st = (r >> 4) * 2 + (c >> 5), rr = r & 15, cc = c & 31, ob = rr * 64 + cc * 2; return st * 1024 + (ob ^ (((ob >> 9) & 1) << 5)); }
__host__ __device__ __forceinline__ void stage_rc(int b, int& R, int& C) { const int st = b / 1024, sb = b % 1024, swz = sb ^ (((sb >> 9) & 1) << 5); R = (st >> 1) * 16 + swz / 64; C = (st & 1) * 32 + (swz % 64) / 2; }
__host__ __device__ __forceinline__ int perm32(int rho) { const int n = rho >> 4, i = rho & 15; return 8 * (i >> 2) + 4 * n + (i & 3); }

struct Unit { int pm, pn, aux; };

template <class Epi, class Sched, bool ALIGN_EPI, bool FP8 = false>
__device__ __forceinline__ void gemm_phase(LAS unsigned char* lds, const Sched& S, const Epi& E, int wid  ) {
    const int lane = lane_id(), tid = wid * 64 + lane, wr = wid >> 2, wc = wid & 3, fr = lane & 15, fq = lane >> 4;
    const int K = S.K, nt = FP8 ? K / (2 * BK) : K / BK;
    int sR[2], sC[2]; unsigned voffB[2];
#pragma unroll
    for (int i = 0; i < 2; ++i) { stage_rc(tid * 16 + i * 8192, sR[i], sC[i]); const int Rb = Epi::PERM ? ((sR[i] & ~31) + perm32(sR[i] & 31)) : sR[i]; voffB[i] = (unsigned)Rb * S.ldb2 + (unsigned)sC[i] * 2u; }
    const size_t kstep = (size_t)(BK * 2);
    const size_t hstepB = (size_t)HALF * S.ldb2;
    const unsigned ldsw = (unsigned)wid * 1024u;
    const int aoff = lds_byte(wr * 64 + fr, fq * 8), boff = lds_byte(wc * 32 + fr, fq * 8);
#define PG8_SA(b, h) (((b) * 2 + (h)) * HTB)
#define PG8_SB(b, h) ((4 + (b) * 2 + (h)) * HTB)
#define PG8_STAGE(bufoff, gbase, voff) do { _Pragma("unroll") for (int _i = 0; _i < 2; ++_i) \
        __builtin_amdgcn_global_load_lds((const unsigned*)((const char*)(gbase) + (voff)[_i]), (LAS unsigned*)(lds + (bufoff) + ldsw + _i * 8192), 16, 0, 0); } while (0)
#define PG8_LDA(dst, b, h) do { _Pragma("unroll") for (int m = 0; m < 4; ++m) { if constexpr (FP8) dst##8[m] = cat8(*(const LAS bf16x8*)(lds + PG8_SA(b, h) + aoff + m * 2048), *(const LAS bf16x8*)(lds + PG8_SA(b, h) + aoff + m * 2048 + 1024)); \
        else { _Pragma("unroll") for (int k = 0; k < 2; ++k) dst[m][k] = *(const LAS bf16x8*)(lds + PG8_SA(b, h) + aoff + m * 2048 + k * 1024); } } } while (0)
#define PG8_LDB(dst, b, h) do { _Pragma("unroll") for (int n = 0; n < 2; ++n) { if constexpr (FP8) dst##8[n] = cat8(*(const LAS bf16x8*)(lds + PG8_SB(b, h) + boff + n * 2048), *(const LAS bf16x8*)(lds + PG8_SB(b, h) + boff + n * 2048 + 1024)); \
        else { _Pragma("unroll") for (int k = 0; k < 2; ++k) dst[n][k] = *(const LAS bf16x8*)(lds + PG8_SB(b, h) + boff + n * 2048 + k * 1024); } } } while (0)
#define PG8_MMA(ai, bj, At, Bt) do { __builtin_amdgcn_s_setprio(1); _Pragma("unroll") for (int m = 0; m < 4; ++m) _Pragma("unroll") for (int n = 0; n < 2; ++n) { \
        if constexpr (FP8) asm volatile("v_mfma_scale_f32_16x16x128_f8f6f4 %0, %1, %2, %0, %3, %3 op_sel_hi:[0,0,0]" : "+v"(acc[ai][bj][m][n]) : "v"(Bt##8[n]), "v"(At##8[m]), "v"(fp8_unit_scale)); \
        else { _Pragma("unroll") for (int k = 0; k < 2; ++k) acc[ai][bj][m][n] = __builtin_amdgcn_mfma_f32_16x16x32_bf16(Bt[n][k], At[m][k], acc[ai][bj][m][n], 0, 0, 0); } } __builtin_amdgcn_s_setprio(0); } while (0)
#define PG8_WAIT_V(n) asm volatile("s_waitcnt vmcnt(" #n ")" ::: "memory")
#define PG8_WAIT_L(n) asm volatile("s_waitcnt lgkmcnt(" #n ")" ::: "memory")
#define PG8_BAR __builtin_amdgcn_s_barrier()
#define PG8_SCHED __builtin_amdgcn_sched_barrier(0)
#define PG8_AOFFS(dst, u, ui) do { _Pragma("unroll") for (int _h = 0; _h < 2; ++_h) _Pragma("unroll") for (int _i = 0; _i < 2; ++_i) dst[_h][_i] = S.a_rowoff(u, ui, sR[_i] + _h * HALF) + (unsigned)sC[_i] * 2u; } while (0)
    Unit cur, nxt; int ui = 0;
    if (!S.next(0, cur)) return;
    int vrows = 256; if constexpr (Sched::RAGGED) vrows = S.rows(cur);
#define PG8_DO0 (!Sched::RAGGED || vrows > 64 || wr == 0)
#define PG8_DO1 (!Sched::RAGGED || vrows > 128)
    f32x4 acc[2][2][4][2];
#pragma unroll
    for (int a = 0; a < 2; ++a)
#pragma unroll
        for (int b = 0; b < 2; ++b)
#pragma unroll
            for (int m = 0; m < 4; ++m)
#pragma unroll
                for (int n = 0; n < 2; ++n) acc[a][b][m][n] = (f32x4){0.f, 0.f, 0.f, 0.f};
    bf16x8 At[4][2], B0[2][2], B1[2][2]; i32x8 At8[4], B08[2], B18[2];
    constexpr bool GA = Sched::GATHER;
    const unsigned fp8_unit_scale = 0x7f7f7f7fu;
    unsigned vAc[2][2], vAn[2][2];
    PG8_AOFFS(vAc, cur, 0);
    const size_t hstepA = GA ? 0 : (size_t)(vAc[1][0] - vAc[0][0]);
#define PG8_H1(v) (GA ? (v)[1] : (v)[0])
    const char* cA = S.a_base(cur); const char* cB = S.b_base(cur);
    PG8_STAGE(PG8_SB(0, 0), cB, voffB); PG8_STAGE(PG8_SB(0, 1), cB + hstepB, voffB); PG8_STAGE(PG8_SA(0, 0), cA, vAc[0]); PG8_STAGE(PG8_SA(0, 1), cA + hstepA, PG8_H1(vAc));
    if (wr == 1) PG8_BAR;
    PG8_WAIT_V(2); PG8_BAR;
    PG8_STAGE(PG8_SB(1, 0), cB + kstep, voffB); PG8_STAGE(PG8_SA(1, 0), cA + kstep, vAc[0]); PG8_STAGE(PG8_SB(1, 1), cB + hstepB + kstep, voffB);
    PG8_WAIT_V(6); PG8_BAR;
    for (;;) {
        const bool has_next = S.next(ui + 1, nxt);
        const char* nA = cA; const char* nB = cB;
        if (has_next) { nA = S.a_base(nxt); nB = S.b_base(nxt); if constexpr (GA) PG8_AOFFS(vAn, nxt, ui + 1); }
        else if constexpr (GA) {
#pragma unroll
            for (int _h = 0; _h < 2; ++_h)
#pragma unroll
                for (int _i = 0; _i < 2; ++_i) vAn[_h][_i] = vAc[_h][_i]; }
        for (int t = 0; t < nt; t += 2) {
            const bool last = (t == nt - 2);
            const char* a1 = cA + (size_t)(t + 1) * kstep;
            const char* a2 = last ? nA : cA + (size_t)(t + 2) * kstep; const char* b2 = last ? nB : cB + (size_t)(t + 2) * kstep;
            const char* a3 = a2 + kstep; const char* b3 = b2 + kstep;
            unsigned vS[2][2];
#pragma unroll
            for (int _h = 0; _h < 2; ++_h)
#pragma unroll
                for (int _i = 0; _i < 2; ++_i) vS[_h][_i] = (GA && last) ? vAn[_h][_i] : vAc[_h][_i];
            PG8_LDB(B0, 0, 0); PG8_LDB(B1, 0, 1); PG8_SCHED; PG8_LDA(At, 0, 0); PG8_STAGE(PG8_SA(1, 1), a1 + hstepA, PG8_H1(vAc));
            PG8_WAIT_V(8); PG8_WAIT_L(0); PG8_BAR; if (PG8_DO0) { PG8_MMA(0, 0, At, B0); PG8_MMA(0, 1, At, B1); } PG8_BAR; PG8_SCHED;
            PG8_LDA(At, 0, 1); PG8_STAGE(PG8_SB(0, 0), b2, voffB); PG8_STAGE(PG8_SB(0, 1), b2 + hstepB, voffB); PG8_STAGE(PG8_SA(0, 0), a2, vS[0]);
            PG8_WAIT_V(8); PG8_WAIT_L(0); PG8_BAR; if (PG8_DO1) { PG8_MMA(1, 0, At, B0); PG8_MMA(1, 1, At, B1); } PG8_BAR; PG8_SCHED;
            PG8_LDB(B0, 1, 0); PG8_LDB(B1, 1, 1); PG8_SCHED; PG8_LDA(At, 1, 0); PG8_STAGE(PG8_SA(0, 1), a2 + hstepA, PG8_H1(vS));
            PG8_WAIT_V(8); PG8_WAIT_L(0); PG8_BAR; if (PG8_DO0) { PG8_MMA(0, 0, At, B0); PG8_MMA(0, 1, At, B1); } PG8_BAR; PG8_SCHED;
            PG8_LDA(At, 1, 1); PG8_STAGE(PG8_SB(1, 0), b3, voffB); PG8_STAGE(PG8_SB(1, 1), b3 + hstepB, voffB); PG8_STAGE(PG8_SA(1, 0), a3, vS[0]);
            PG8_WAIT_V(8); PG8_WAIT_L(0); PG8_BAR; if (PG8_DO1) { PG8_MMA(1, 0, At, B0); PG8_MMA(1, 1, At, B1); } PG8_BAR; PG8_SCHED;
        }
        if constexpr (ALIGN_EPI) { if (wr == 0) PG8_BAR; }
        if constexpr (FP8) asm volatile("s_nop 15\n\ts_nop 15\n\ts_nop 15\n\ts_nop 15" ::: "memory");
        E(acc, cur, wr, wc, fr, fq);
        if (!has_next) break;
#pragma unroll
        for (int a = 0; a < 2; ++a)
#pragma unroll
            for (int b = 0; b < 2; ++b)
#pragma unroll
                for (int m = 0; m < 4; ++m)
#pragma unroll
                    for (int n = 0; n < 2; ++n) acc[a][b][m][n] = (f32x4){0.f, 0.f, 0.f, 0.f};
        cur = nxt; cA = nA; cB = nB; ++ui;
        if constexpr (Sched::RAGGED) vrows = S.rows(cur);
        if constexpr (GA) {
#pragma unroll
        for (int _h = 0; _h < 2; ++_h)
#pragma unroll
            for (int _i = 0; _i < 2; ++_i) vAc[_h][_i] = vAn[_h][_i]; }
        if constexpr (ALIGN_EPI) { if (wr == 1) PG8_BAR; }
    }
    PG8_WAIT_V(0);
    if constexpr (!ALIGN_EPI) { if (wr == 0) PG8_BAR; }
    PG8_BAR;
#undef PG8_SA
#undef PG8_SB
#undef PG8_STAGE
#undef PG8_LDA
#undef PG8_LDB
#undef PG8_MMA
#undef PG8_WAIT_V
#undef PG8_WAIT_L
#undef PG8_BAR
#undef PG8_SCHED
#undef PG8_AOFFS
#undef PG8_DO0
#undef PG8_DO1
#undef PG8_H1
}

#define XB_TMO      128
#define XB_XCNT(j)  (256  + 64 * (j))
#define XB_XSUB(j)  (1280 + 64 * (j))
#define XB_XGEN(j)  (2304 + 64 * (j))
#define XB_TOP      3328
#define XB_TOPGEN   3392
#define XCD_BAR_WORDS 3456
#define XB_SPIN_CAP (1u << 18)
__device__ __forceinline__ unsigned xb_ld(unsigned* p)              { return __hip_atomic_load(p, __ATOMIC_RELAXED, __HIP_MEMORY_SCOPE_AGENT); }
__device__ __forceinline__ unsigned xb_add(unsigned* p, unsigned v) { return __hip_atomic_fetch_add(p, v, __ATOMIC_RELAXED, __HIP_MEMORY_SCOPE_AGENT); }
__device__ __forceinline__ unsigned xb_xcc_id() { return (unsigned)__builtin_amdgcn_s_getreg((3 << 11) | 20) & 0xFu; }
#define XB_SPIN(cond, bar) do { unsigned _sp = 0; while (cond) { __builtin_amdgcn_s_sleep(1); \
    if ((++_sp & 255u) == 0u) { if (xb_ld(&(bar)[XB_TMO])) break; if (_sp > XB_SPIN_CAP) { atomicAdd(&(bar)[XB_TMO], 1u); break; } } } } while (0)
struct XcdBarrier { unsigned* bar; unsigned x; volatile LAS unsigned* st; unsigned total; };
__device__ __forceinline__ XcdBarrier xcd_barrier_post(unsigned* bar, volatile LAS unsigned* st, unsigned total) {
    XcdBarrier b; b.bar = bar; b.x = xb_xcc_id(); b.st = st; b.total = total;
    if (threadIdx.x == 0) (void)xb_add(&bar[XB_XCNT(b.x)], 1u);
    return b;
}
__device__ __forceinline__ void xcd_barrier_complete(unsigned* bar, unsigned x, unsigned G, unsigned& nloc, unsigned& nx) {
    unsigned sum, cnt, mine, sp = 0u;
    for (;;) {
        sum = 0u; cnt = 0u; mine = 0u;
#pragma unroll
        for (unsigned j = 0; j < 16; ++j) { const unsigned c = xb_ld(&bar[XB_XCNT(j)]); sum += c; cnt += (c > 0u) ? 1u : 0u; mine = (j == x) ? c : mine; }
        if (sum == G) break;
        __builtin_amdgcn_s_sleep(1);
        if ((++sp & 255u) == 0u) { if (xb_ld(&bar[XB_TMO])) break; if (sp > XB_SPIN_CAP) { atomicAdd(&bar[XB_TMO], 1u); break; } }
    }
    nloc = mine > 0u ? mine : 1u; nx = cnt > 0u ? cnt : 1u;
}
__device__ __forceinline__ void xcd_barrier(const XcdBarrier& b) {
    asm volatile("s_waitcnt vmcnt(0)" ::: "memory");
    __syncthreads();
    if (threadIdx.x == 0) {
        unsigned* bar = b.bar;
        __builtin_amdgcn_s_waitcnt(0);
        unsigned nloc = b.st[0], nx = b.st[1];
        if (nloc == 0u) { xcd_barrier_complete(bar, b.x, b.total, nloc, nx); b.st[0] = nloc; b.st[1] = nx; }
        const unsigned old = xb_add(&bar[XB_XSUB(b.x)], 1u);
        const unsigned gen = old / nloc;
        if (old + 1u == (gen + 1u) * nloc) {
            __builtin_amdgcn_fence(__ATOMIC_RELEASE, "agent");
            asm volatile("s_waitcnt vmcnt(0)" ::: "memory");
            const unsigned og = xb_add(&bar[XB_TOP], 1u);
            const unsigned tg = og / nx;
            if (og + 1u == (tg + 1u) * nx) xb_add(&bar[XB_TOPGEN], 1u);
            else XB_SPIN(xb_ld(&bar[XB_TOPGEN]) == tg, bar);
            __builtin_amdgcn_fence(__ATOMIC_ACQUIRE, "agent");
            xb_add(&bar[XB_XGEN(b.x)], 1u);
            asm volatile("s_waitcnt vmcnt(0)" ::: "memory");
        } else {
            XB_SPIN(xb_ld(&bar[XB_XGEN(b.x)]) == gen, bar);
            __builtin_amdgcn_fence(__ATOMIC_ACQUIRE, "agent");
            asm volatile("s_waitcnt vmcnt(0)" ::: "memory");
        }
    }
    __syncthreads();
}
}
namespace mk {
constexpr size_t MiB = 1ull << 20;
constexpr size_t WS_CTL = 0, CTL_ZERO_BYTES = 1 * MiB;
constexpr size_t WS_MOD = 1 * MiB, WS_COS = 2 * MiB, WS_SIN = 3 * MiB, WS_LOGF = 4 * MiB, WS_CUM = 5 * MiB, WS_TEID = 6 * MiB, WS_TPOS = 6 * MiB + 512 * 1024, WS_TGATE = 7 * MiB, WS_BINP = 7 * MiB + 512 * 1024,
                 WS_TOKOF = 8 * MiB  , WS_XN = 16 * MiB  , WS_WIN = 48 * MiB  , WS_WAB = 84 * MiB  , WS_WOUT = 92 * MiB  , WS_QA = 100 * MiB  , WS_KA = 116 * MiB  ,
                 WS_VA = 120 * MiB  , WS_QB = 124 * MiB  , WS_KB = 140 * MiB, WS_VB = 156 * MiB, WS_SGA = 172 * MiB  , WS_SGB = 204 * MiB  , WS_YAB = 236 * MiB  ,
                 WS_T1 = 268 * MiB  , WS_MERGED = 332 * MiB  , WS_H1 = 364 * MiB  , WS_XN2 = 428 * MiB  , WS_ACT = 460 * MiB  , WS_YS = 620 * MiB  ,
                 WS_WGU = 780 * MiB  , WS_WD = 1292 * MiB  , WS_JUNK = 1548 * MiB  , WS_END = 1580 * MiB;
constexpr int CW_CNT = 1024;
constexpr int CW_BAR = 4096;
constexpr int CW_BAR2 = 8192;
constexpr int CW_CQ = 2048;
constexpr int CW_AQ = 2112;
constexpr int CW_SFLAG = 2560;
#ifndef CONV_MODE
#define CONV_MODE 0
#endif
#ifndef NCOMP_DEF
#define NCOMP_DEF 184
#endif
constexpr int NCOMP = NCOMP_DEF;
constexpr int RING_OFF = 0, RING_BYTES = 131072;
constexpr int TBL_OFF = RING_BYTES;
constexpr int MISC_OFF = TBL_OFF + 10240;
constexpr int LDS_BYTES = 147456;
static_assert(MISC_OFF + 1024 <= LDS_BYTES, "LDS map");
constexpr int NWAVES = 8;
constexpr bool MOE_FP8 = true;
constexpr float WSCALE = 32.0f, WSCALE_INV = 1.0f / 32.0f;
constexpr bool MIX_FP8 = true;
constexpr int MIX_EB = MIX_FP8 ? 1 : 2;
#ifndef P5_FP8_DEF
#define P5_FP8_DEF 1
#endif
constexpr bool P5_FP8 = MIX_FP8 && P5_FP8_DEF;
constexpr int P5_EB = P5_FP8 ? 1 : 2;
constexpr int MOE_EB = MOE_FP8 ? 1 : 2;

struct Frame {
    LAS unsigned char* lds; volatile LAS unsigned* MISC; unsigned* ctl;
    int tid, lane, wave, vcu, G;
    const float *x, *c, *w_ada, *b_ada, *g_mix, *w_in, *b_in, *sinks, *w_a, *w_b, *w_out, *g_ffn, *w_r, *b_r, *w_gu, *b_gu, *w_dn, *b_dn, *g_fin; const int* pos;
    float* out; unsigned char* ws;
};
__device__ __forceinline__ void refresh(Frame& F) { F.lane = lane_id(); F.tid = F.wave * 64 + F.lane; }
template <class T> __device__ __forceinline__ T* wsp(const Frame& F, size_t off) { return (T*)(F.ws + off); }

__device__ __forceinline__ float wave_sum(float v) {
#pragma unroll
    for (int o = 1; o < 64; o <<= 1) v += __shfl_xor(v, o);
    return v;
}

struct DenseSched {
    static constexpr bool GATHER = false, RAGGED = false;
    const char* A; const char* Bt; unsigned lda2, ldb2; int K; int nM, nN, nwg, G, c;
    __device__ __forceinline__ void init(const void* A_, unsigned lda2_, const void* Bt_, unsigned ldb2_, int K_, int M, int N, int G_, int c_) {
        A = (const char*)A_; Bt = (const char*)Bt_; lda2 = lda2_; ldb2 = ldb2_; K = K_; nM = M / BM; nN = N / BM; nwg = nM * nN; G = G_; c = c_; }
    __device__ __forceinline__ bool tile(long L, Unit& u) const {
        if (L >= nwg) return false;
        int wgid = (int)L; { const int q = nwg / NXCD, r = nwg % NXCD, xcd = wgid % NXCD, off = wgid / NXCD; wgid = (xcd < r ? xcd * (q + 1) : r * (q + 1) + (xcd - r) * q) + off; }
        const int nig = WGM * nN, gid = wgid / nig, fm = gid * WGM, gsz = (nM - fm) < WGM ? (nM - fm) : WGM;
        u.pm = fm + ((wgid % nig) % gsz); u.pn = (wgid % nig) / gsz; u.aux = 0; return true; }
    __device__ __forceinline__ bool next(int i, Unit& u) const { return tile((long)i * G + c, u); }
    __device__ __forceinline__ const char* a_base(const Unit& u) const { return A + (size_t)u.pm * BM * lda2; }
    __device__ __forceinline__ unsigned a_rowoff(const Unit&, int, int R) const { return (unsigned)R * lda2; }
    __device__ __forceinline__ const char* b_base(const Unit& u) const { return Bt + (size_t)u.pn * BM * ldb2; }
};
struct BranchSched {
    static constexpr bool GATHER = false, RAGGED = false;
    DenseSched d; unsigned ldb2; int K;
    __device__ __forceinline__ bool next(int i, Unit& u) const { if (!d.tile((long)(i >> 1) * d.G + d.c, u)) return false; u.aux = i & 1; return true; }
    __device__ __forceinline__ const char* a_base(const Unit& u) const { return d.A + (size_t)u.pm * BM * (2048 * MIX_EB) + (size_t)u.aux * (1024 * MIX_EB); }
    __device__ __forceinline__ unsigned a_rowoff(const Unit&, int, int R) const { return (unsigned)R * (2048u * MIX_EB); }
    __device__ __forceinline__ const char* b_base(const Unit& u) const { return d.Bt + ((size_t)u.aux * 2048 + (size_t)u.pn * BM) * (1024 * MIX_EB); }
};
template <bool GATHER_>
struct MoeSched {
    static constexpr bool GATHER = GATHER_, gather = GATHER_, RAGGED = true;
    const volatile LAS unsigned* cnt;
    __device__ __forceinline__ int rows(const Unit& u) const { const int r = (int)cnt[u.aux] - (u.pm - (int)tpre[u.aux]) * 256; return r < 256 ? r : 256; }
    const volatile LAS unsigned* tpre; const LAS unsigned* tbl; const char* A; const char* Bt; int NN; unsigned ldb2; int K; int G, vcu;
    size_t b_estride;
    const volatile LAS unsigned* hpre; const volatile LAS unsigned* lexp; int nlight;
    __device__ __forceinline__ bool next(int i, Unit& u) const {
        const int L = i * G + vcu; const int NH = NN * (int)hpre[32];
        if (L < NH) {
            int e = 0;
            for (int j = 1; j < 32; ++j) if (NN * (int)hpre[j] <= L) e = j;
            const int l = L - NN * (int)hpre[e], T = (int)hpre[e + 1] - (int)hpre[e];
            u.pn = l / T; u.pm = (int)tpre[e] + (l - u.pn * T); u.aux = e; return true; }
        const int l2 = L - NH, j = l2 / NN; if (j >= nlight) return false;
        const int e = (int)lexp[j]; u.pn = l2 - j * NN; u.pm = (int)tpre[e + 1] - 1; u.aux = e; return true; }
    __device__ __forceinline__ const char* a_base(const Unit& u) const { return gather ? A : A + (size_t)u.pm * BM * (2048 * MOE_EB); }
    __device__ __forceinline__ unsigned a_rowoff(const Unit&, int ui, int R) const { return gather ? tbl[ui * 256 + R] : (unsigned)R * (2048u * MOE_EB); }
    __device__ __forceinline__ const char* b_base(const Unit& u) const { return Bt + (size_t)u.aux * b_estride + (size_t)u.pn * BM * ldb2; }
};

__device__ __forceinline__ void st8bf(bf16_t* p, f32x4 a, f32x4 b) { u32x4 w; w.x = pk2(a[0], a[1]); w.y = pk2(a[2], a[3]); w.z = pk2(b[0], b[1]); w.w = pk2(b[2], b[3]); *(u32x4*)p = w; }
struct EpiInProj {
    static constexpr bool PERM = true;
    bf16_t *QA, *KA, *VA, *QB, *KB, *VB, *SGA, *SGB; const float* bias; const float* cosT; const float* sinT;
    __device__ __forceinline__ void operator()(const f32x4 (&acc)[2][2][4][2], const Unit& u, int wr, int wc, int fr, int fq) const {
        const int pn = u.pn, row0 = u.pm * BM + wr * 64 + fr, cw = wc * 32 + 8 * fq;
        const float ws = MIX_FP8 ? WSCALE_INV : 1.0f;
        f32x4 bv[2][2];
#pragma unroll
        for (int bj = 0; bj < 2; ++bj)
#pragma unroll
            for (int n = 0; n < 2; ++n) bv[bj][n] = *(const f32x4*)(bias + pn * 256 + bj * 128 + cw + 4 * n);
        if (pn < 5) {
            bf16_t* O = pn < 4 ? QA : KA; const int ldo = pn < 4 ? 1024 : 256; const int hcol = (pn < 4 ? pn * 256 : 0) + wc * 64 + 8 * fq; const float qs = pn < 4 ? QSCALE : 1.0f;
#pragma unroll
            for (int ai = 0; ai < 2; ++ai)
#pragma unroll
                for (int m = 0; m < 4; ++m) { const int row = row0 + ai * HALF + m * 16;
                    f32x4 o1[2], o2[2];
#pragma unroll
                    for (int n = 0; n < 2; ++n) { const f32x4 cs = *(const f32x4*)(cosT + (size_t)row * 32 + 8 * fq + 4 * n), sn = *(const f32x4*)(sinT + (size_t)row * 32 + 8 * fq + 4 * n);
                        const f32x4 x1 = acc[ai][0][m][n] * ws + bv[0][n], x2 = acc[ai][1][m][n] * ws + bv[1][n];
                        o1[n] = (x1 * cs - x2 * sn) * qs; o2[n] = (x2 * cs + x1 * sn) * qs; }
                    bf16_t* rp = O + (size_t)row * ldo + hcol; st8bf(rp, o1[0], o1[1]); st8bf(rp + 32, o2[0], o2[1]); }
        } else if (pn < 18) {
            bf16_t* O; int ldo, col0; float sc = 1.0f;
            if (pn == 5) { O = VA; ldo = 256; col0 = 0; } else if (pn < 10) { O = QB; ldo = 1024; col0 = (pn - 6) * 256; sc = QSCALE; } else if (pn < 14) { O = KB; ldo = 1024; col0 = (pn - 10) * 256; } else { O = VB; ldo = 1024; col0 = (pn - 14) * 256; }
#pragma unroll
            for (int ai = 0; ai < 2; ++ai)
#pragma unroll
                for (int m = 0; m < 4; ++m) { bf16_t* rp = O + (size_t)(row0 + ai * HALF + m * 16) * ldo + col0 + cw;
#pragma unroll
                    for (int bj = 0; bj < 2; ++bj) st8bf(rp + bj * HALF, (acc[ai][bj][m][0] * ws + bv[bj][0]) * sc, (acc[ai][bj][m][1] * ws + bv[bj][1]) * sc); }
        } else {
            bf16_t* O = pn < 26 ? SGA : SGB; const int col0 = ((pn - 18) & 7) * 256;
#pragma unroll
            for (int ai = 0; ai < 2; ++ai)
#pragma unroll
                for (int m = 0; m < 4; ++m) { bf16_t* rp = O + (size_t)(row0 + ai * HALF + m * 16) * 2048 + col0 + cw;
#pragma unroll
                    for (int bj = 0; bj < 2; ++bj) { f32x4 a = acc[ai][bj][m][0] * ws + bv[bj][0], b = acc[ai][bj][m][1] * ws + bv[bj][1];
#pragma unroll
                        for (int j = 0; j < 4; ++j) { a[j] = fast_sigmoid(a[j]); b[j] = fast_sigmoid(b[j]); }
                        st8bf(rp + bj * HALF, a, b); } }
        }
    }
};
struct EpiBranch {
    static constexpr bool PERM = true;
    const bf16_t *SGA, *SGB; float* T1; unsigned char* MERGED;
    __device__ __forceinline__ void operator()(const f32x4 (&acc)[2][2][4][2], const Unit& u, int wr, int wc, int fr, int fq) const {
        const int row0 = u.pm * BM + wr * 64 + fr, col0 = u.pn * BM + wc * 32 + 8 * fq;
        const bf16_t* SG = u.aux ? SGB : SGA;
#pragma unroll
        for (int ai = 0; ai < 2; ++ai)
#pragma unroll
            for (int m = 0; m < 4; ++m) { const size_t off = (size_t)(row0 + ai * HALF + m * 16) * 2048 + col0;
#pragma unroll
                for (int bj = 0; bj < 2; ++bj) { const u32x4 g = *(const u32x4*)(SG + off + bj * HALF);
                    const f32x4 g0 = {bflo(g.x), bfhi(g.x), bflo(g.y), bfhi(g.y)}, g1 = {bflo(g.z), bfhi(g.z), bflo(g.w), bfhi(g.w)};
                    const float ws = MIX_FP8 ? WSCALE_INV : 1.0f;
                    f32x4 a = acc[ai][bj][m][0] * g0 * ws, b = acc[ai][bj][m][1] * g1 * ws;
                    bf16_t* tp = (bf16_t*)T1 + off + bj * HALF;
                    if (u.aux == 0) { st8bf(tp, a, b); }
                    else { const u32x4 t = *(const u32x4*)tp; a += (f32x4){bflo(t.x), bfhi(t.x), bflo(t.y), bfhi(t.y)}; b += (f32x4){bflo(t.z), bfhi(t.z), bflo(t.w), bfhi(t.w)};
                        if constexpr (P5_FP8) { u32x2 w; w.x = pk4_fp8(a[0], a[1], a[2], a[3]); w.y = pk4_fp8(b[0], b[1], b[2], b[3]); *(u32x2*)(MERGED + off + bj * HALF) = w; }
                        else st8bf((bf16_t*)MERGED + off + bj * HALF, a, b); } } }
    }
};
struct EpiOut {
    static constexpr bool PERM = false;
    const float* x; const float* mod; float* H1;
    __device__ __forceinline__ void operator()(const f32x4 (&acc)[2][2][4][2], const Unit& u, int wr, int wc, int fr, int fq) const {
        const int row0 = u.pm * BM + wr * 64 + fr, col0 = u.pn * BM + wc * 32 + 4 * fq; const float* gt = mod + (size_t)(u.pm >> 3) * MODW + 4096;
#pragma unroll
        for (int bj = 0; bj < 2; ++bj)
#pragma unroll
            for (int n = 0; n < 2; ++n) { const int col = col0 + bj * HALF + n * 16; const f32x4 g = *(const f32x4*)(gt + col);
#pragma unroll
                for (int ai = 0; ai < 2; ++ai)
#pragma unroll
                    for (int m = 0; m < 4; ++m) { const size_t off = (size_t)(row0 + ai * HALF + m * 16) * 2048 + col; *(f32x4*)(H1 + off) = *(const f32x4*)(x + off) + g * (acc[ai][bj][m][n] * (P5_FP8 ? WSCALE_INV : 1.0f)); } }
    }
};
struct EpiGU {
    static constexpr bool PERM = true;
    const float* b_gu; unsigned char* ACT;
    __device__ __forceinline__ void operator()(const f32x4 (&acc)[2][2][4][2], const Unit& u, int wr, int wc, int fr, int fq) const {
        const int row0 = u.pm * BM + wr * 64 + fr, cw = wc * 32 + 8 * fq; const float* bg = b_gu + (size_t)u.aux * 4096 + u.pn * 128 + cw;
        const float ws = MOE_FP8 ? WSCALE_INV : 1.0f;
        f32x4 bv[2][2];
#pragma unroll
        for (int bj = 0; bj < 2; ++bj)
#pragma unroll
            for (int n = 0; n < 2; ++n) bv[bj][n] = *(const f32x4*)(bg + bj * 2048 + 4 * n);
#pragma unroll
        for (int ai = 0; ai < 2; ++ai)
#pragma unroll
            for (int m = 0; m < 4; ++m) { f32x4 o[2];
#pragma unroll
                for (int n = 0; n < 2; ++n) { const f32x4 g = acc[ai][0][m][n] * ws + bv[0][n], l = acc[ai][1][m][n] * ws + bv[1][n];
#pragma unroll
                    for (int j = 0; j < 4; ++j) { const float gg = fminf(g[j], 7.0f), ll = fminf(fmaxf(l[j], -7.0f), 7.0f);
                        o[n][j] = gg * (ll + 1.0f) * __builtin_amdgcn_rcpf(1.0f + __builtin_amdgcn_exp2f(-1.702f * LOG2E * gg)); } }
                const size_t eo = (size_t)(row0 + ai * HALF + m * 16) * 2048 + u.pn * 128 + cw;
                if constexpr (MOE_FP8) { u32x2 w; w.x = pk4_fp8(o[0][0], o[0][1], o[0][2], o[0][3]); w.y = pk4_fp8(o[1][0], o[1][1], o[1][2], o[1][3]); *(u32x2*)(ACT + eo) = w; }
                else st8bf((bf16_t*)ACT + eo, o[0], o[1]); }
    }
};
struct EpiDown {
    static constexpr bool PERM = true;
    const float* b_dn; bf16_t* YS;
    __device__ __forceinline__ void operator()(const f32x4 (&acc)[2][2][4][2], const Unit& u, int wr, int wc, int fr, int fq) const {
        const int row0 = u.pm * BM + wr * 64 + fr, col0 = u.pn * BM + wc * 32 + 8 * fq; const float* bd = b_dn + (size_t)u.aux * 2048 + col0;
        const float ws = MOE_FP8 ? WSCALE_INV : 1.0f;
        f32x4 bv[2][2];
#pragma unroll
        for (int bj = 0; bj < 2; ++bj)
#pragma unroll
            for (int n = 0; n < 2; ++n) bv[bj][n] = *(const f32x4*)(bd + bj * HALF + 4 * n);
#pragma unroll
        for (int ai = 0; ai < 2; ++ai)
#pragma unroll
            for (int m = 0; m < 4; ++m) { bf16_t* rp = YS + (size_t)(row0 + ai * HALF + m * 16) * 2048 + col0;
#pragma unroll
                for (int bj = 0; bj < 2; ++bj) st8bf(rp + bj * HALF, acc[ai][bj][m][0] * ws + bv[bj][0], acc[ai][bj][m][1] * ws + bv[bj][1]); }
    }
};

__device__ __forceinline__ int in_src(int r) { const int pn = r >> 8, c = r & 255; if (pn < 5) return pn * 256 + ((c & 127) >> 5) * 64 + (c >> 7) * 32 + (c & 31); return pn < 18 ? r : r + 16; }
__device__ __forceinline__ void transpose_item(const float* __restrict__ W, size_t ldw, int k0, int src0, int src1, bf16_t* __restrict__ WT, size_t ldk, int dst0, LAS unsigned* scr, int lane) {
    const int lg = lane >> 4, lc = lane & 15;
    const int scol = (lc < 8 ? src0 : src1 - 32) + 4 * lc;
    f32x4 v[8][2];
#pragma unroll
    for (int i = 0; i < 8; ++i)
#pragma unroll
        for (int p = 0; p < 2; ++p) v[i][p] = *(const f32x4*)(W + (size_t)(k0 + 8 * i + 2 * lg + p) * ldw + scol);
#pragma unroll
    for (int i = 0; i < 8; ++i)
#pragma unroll
        for (int c = 0; c < 4; ++c) scr[(4 * lc + c) * 33 + 4 * i + lg] = pk2(v[i][0][c], v[i][1][c]);
    asm volatile("s_waitcnt lgkmcnt(0)" ::: "memory");
    const int rn = lane >> 3, ch = lane & 7;
#pragma unroll
    for (int j = 0; j < 8; ++j) { const int n = rn + 8 * j; const LAS unsigned* s = scr + n * 33 + 4 * ch; u32x4 o; o.x = s[0]; o.y = s[1]; o.z = s[2]; o.w = s[3];
        *(u32x4*)(WT + (size_t)(dst0 + n) * ldk + k0 + 8 * ch) = o; }
    asm volatile("s_waitcnt lgkmcnt(0)" ::: "memory");
}
__device__ __forceinline__ void transpose_item_f8(const float* __restrict__ W, size_t ldw, int k0, int src0, int src1, unsigned char* __restrict__ WT, size_t ldk, int dst0, LAS unsigned* scr, int lane, float scale) {
    const int lg = lane >> 4, lc = lane & 15;
    const float* wp = W + (size_t)(k0 + 4 * lg) * ldw + (lc < 8 ? src0 : src1 - 32) + 4 * lc;
#pragma unroll
    for (int hf = 0; hf < 2; ++hf) {
        f32x4 v[4][4];
#pragma unroll
        for (int i = 0; i < 4; ++i)
#pragma unroll
            for (int p = 0; p < 4; ++p) v[i][p] = *(const f32x4*)(wp + (size_t)(64 * hf + 16 * i + p) * ldw);
#pragma unroll
        for (int i = 0; i < 4; ++i)
#pragma unroll
            for (int c = 0; c < 4; ++c) scr[(4 * lc + c) * 33 + 16 * hf + 4 * i + lg] = pk4_fp8_raw(v[i][0][c] * scale, v[i][1][c] * scale, v[i][2][c] * scale, v[i][3][c] * scale);
    }
    asm volatile("s_waitcnt lgkmcnt(0)" ::: "memory");
    const int rn = lane >> 3, ch = lane & 7;
#pragma unroll
    for (int j = 0; j < 8; ++j) { const int n = rn + 8 * j; const LAS unsigned* s = scr + n * 33 + 4 * ch; u32x4 o; o.x = s[0]; o.y = s[1]; o.z = s[2]; o.w = s[3];
        *(u32x4*)(WT + (size_t)(dst0 + n) * ldk + k0 + 16 * ch) = o; }
    asm volatile("s_waitcnt lgkmcnt(0)" ::: "memory");
}
constexpr int P0_KD = MIX_FP8 ? 128 : 64;
constexpr int P0_T_HEAD = 768 + 256 + 1, P0_T_ALL = P0_T_HEAD + (2048 / P0_KD) * 136 + 2 * (1024 / P0_KD) * 32 + (2048 / P0_KD) * 32;
__device__ __forceinline__ void p0_prologue(Frame& F, const int t_lo, const int t_hi, const int gw_, const int NGW_) {
    refresh(F);
    LAS unsigned* scr = (LAS unsigned*)(F.lds + RING_OFF + F.wave * 8448);
    LAS f32x4* ca = (LAS f32x4*)(F.lds + RING_OFF + 69632);
    for (int k = F.tid; k < 2048; k += NWAVES * 64) { f32x4 v;
#pragma unroll
        for (int b = 0; b < 4; ++b) { const float cv = F.c[b * 2048 + k]; v[b] = cv / (1.0f + expf(-cv)); }
        ca[k] = v; }
    __syncthreads();
    const int gw = gw_, NGW = NGW_, lane = F.lane;
    constexpr int KD = P0_KD;
    constexpr int T_ADA = 768, T_ROPE = 256, T_BIAS = 1, T_WIN = (2048 / KD) * 136, T_WA = (1024 / KD) * 32, T_WB = (1024 / KD) * 32, T_WOUT = (2048 / KD) * 32;
    constexpr int NT = T_ADA + T_ROPE + T_BIAS + T_WIN + T_WA + T_WB + T_WOUT;
    static_assert(NT == P0_T_ALL && T_ADA + T_ROPE + T_BIAS == P0_T_HEAD, "prologue task list");
    float* mod = wsp<float>(F, WS_MOD); float* cosT = wsp<float>(F, WS_COS); float* sinT = wsp<float>(F, WS_SIN); float* binp = wsp<float>(F, WS_BINP);
    for (int it = t_lo + gw; it < t_hi; it += NGW) {
        int r = it;
        if (r < T_ADA) {
            const int j0 = 16 * r, cl = lane & 3, kr = lane >> 2;
            f32x4 a[4];
#pragma unroll
            for (int b = 0; b < 4; ++b) a[b] = (f32x4){0.f, 0.f, 0.f, 0.f};
            const float* wp = F.w_ada + (size_t)kr * MODW + j0 + 4 * cl;
#pragma unroll 8
            for (int s = 0; s < 128; ++s) { const f32x4 w4 = *(const f32x4*)(wp + (size_t)s * 16 * MODW); const f32x4 c4 = ca[16 * s + kr];
#pragma unroll
                for (int b = 0; b < 4; ++b) a[b] += w4 * c4[b]; }
#pragma unroll
            for (int b = 0; b < 4; ++b)
#pragma unroll
                for (int c = 0; c < 4; ++c) { float v = a[b][c]; v += __shfl_xor(v, 4); v += __shfl_xor(v, 8); v += __shfl_xor(v, 16); v += __shfl_xor(v, 32); a[b][c] = v; }
            if (kr == 0) { const f32x4 bb = *(const f32x4*)(F.b_ada + j0 + 4 * cl);
#pragma unroll
                for (int b = 0; b < 4; ++b) *(f32x4*)(mod + b * MODW + j0 + 4 * cl) = a[b] + bb; }
            continue; } r -= T_ADA;
        if (r < T_ROPE) {
            const int i = lane & 31, ts = lane >> 5; const float inv = 1.0f / powf(10000.0f, (float)(2 * i) / 64.0f);
            for (int j = 0; j < 16; ++j) { const int t = 32 * r + 2 * j + ts; const float ang = (float)F.pos[t] * inv; cosT[t * 32 + i] = cosf(ang); sinT[t * 32 + i] = sinf(ang); }
            continue; } r -= T_ROPE;
        if (r < T_BIAS) { for (int q = lane; q < 8704; q += 64) binp[q] = F.b_in[in_src(q)]; continue; } r -= T_BIAS;
        const float* W; size_t ldw; int kb, nb, s0, s1; unsigned char* WT; size_t ldk;
        if (r < T_WIN) { kb = r / 136; nb = r % 136; W = F.w_in; ldw = INW; s0 = in_src(64 * nb); s1 = in_src(64 * nb + 32); WT = wsp<unsigned char>(F, WS_WIN); ldk = 2048; }
        else if ((r -= T_WIN) < T_WA) { kb = r / 32; nb = r % 32; W = F.w_a; ldw = 2048; s0 = 64 * nb; s1 = s0 + 32; WT = wsp<unsigned char>(F, WS_WAB); ldk = 1024; }
        else if ((r -= T_WA) < T_WB) { kb = r / 32; nb = r % 32; W = F.w_b; ldw = 2048; s0 = 64 * nb; s1 = s0 + 32; WT = wsp<unsigned char>(F, WS_WAB) + (size_t)2048 * 1024 * MIX_EB; ldk = 1024; }
        else { r -= T_WB; W = F.w_out; ldw = 2048; WT = wsp<unsigned char>(F, WS_WOUT); ldk = 2048;
            if constexpr (MIX_FP8 && !P5_FP8) { kb = r / 32; nb = r % 32; s0 = 64 * nb; s1 = s0 + 32;
                transpose_item(W, ldw, 128 * kb, s0, s1, (bf16_t*)WT, ldk, 64 * nb, scr, lane); transpose_item(W, ldw, 128 * kb + 64, s0, s1, (bf16_t*)WT, ldk, 64 * nb, scr, lane); continue; }
            kb = r / 32; nb = r % 32; s0 = 64 * nb; s1 = s0 + 32; }
        if constexpr (MIX_FP8) transpose_item_f8(W, ldw, 128 * kb, s0, s1, WT, ldk, 64 * nb, scr, lane, WSCALE);
        else transpose_item(W, ldw, 64 * kb, s0, s1, (bf16_t*)WT, ldk, 64 * nb, scr, lane);
    }
}
constexpr int T_WGU = MOE_FP8 ? 32 * 16 * 64 : 32 * 32 * 64, T_WD = MOE_FP8 ? 32 * 16 * 32 : 32 * 32 * 32;
__device__ __forceinline__ void convert_item(Frame& F, int r, LAS unsigned* scr, int lane) {
    if (r < T_WGU) {
        if constexpr (MOE_FP8) { const int e = r >> 10, q = r & 1023, kb = q >> 6, nb = q & 63; const int r0 = 64 * nb, src = ((r0 & 255) >> 7) * 2048 + (r0 >> 8) * 128 + (r0 & 127);
            transpose_item_f8(F.w_gu + (size_t)e * 2048 * 4096, 4096, 128 * kb, src, src + 32, wsp<unsigned char>(F, WS_WGU) + (size_t)e * 4096 * 2048, 2048, r0, scr, lane, WSCALE); }
        else { const int e = r >> 11, q = r & 2047, kb = q >> 6, nb = q & 63; const int r0 = 64 * nb, src = ((r0 & 255) >> 7) * 2048 + (r0 >> 8) * 128 + (r0 & 127);
            transpose_item(F.w_gu + (size_t)e * 2048 * 4096, 4096, 64 * kb, src, src + 32, wsp<bf16_t>(F, WS_WGU) + (size_t)e * 4096 * 2048, 2048, r0, scr, lane); }
        return; }
    r -= T_WGU;
    if constexpr (MOE_FP8) { const int e = r >> 9, q = r & 511, kb = q >> 5, nb = q & 31;
        transpose_item_f8(F.w_dn + (size_t)e * 2048 * 2048, 2048, 128 * kb, 64 * nb, 64 * nb + 32, wsp<unsigned char>(F, WS_WD) + (size_t)e * 2048 * 2048, 2048, 64 * nb, scr, lane, WSCALE); }
    else { const int e = r >> 10, q = r & 1023, kb = q >> 5, nb = q & 31;
        transpose_item(F.w_dn + (size_t)e * 2048 * 2048, 2048, 64 * kb, 64 * nb, 64 * nb + 32, wsp<bf16_t>(F, WS_WD) + (size_t)e * 2048 * 2048, 2048, 64 * nb, scr, lane); }
}
struct CvItem { const char* src; unsigned char* dst; };
template <bool GU> __device__ __forceinline__ CvItem cv_decode(Frame& F, int r) {
    constexpr int N = GU ? T_WGU : T_WD; constexpr size_t ldw = GU ? 4096 : 2048;
    r = r < N ? r : 0;
    const int e = r >> (GU ? 10 : 9), q = r & (GU ? 1023 : 511), kb = q >> (GU ? 6 : 5), nb = q & (GU ? 63 : 31), r0 = 64 * nb;
    const int srcc = GU ? ((r0 & 255) >> 7) * 2048 + (r0 >> 8) * 128 + (r0 & 127) : r0;
    CvItem P;
    P.src = (const char*)((GU ? F.w_gu : F.w_dn) + (size_t)e * 2048 * ldw + (size_t)(128 * kb) * ldw + srcc);
    P.dst = (GU ? wsp<unsigned char>(F, WS_WGU) : wsp<unsigned char>(F, WS_WD)) + (size_t)e * ldw * 2048 + (size_t)r0 * 2048 + 128 * kb;
    return P;
}
template <bool GU> __device__ __forceinline__ void convert_loop(Frame& F, unsigned* head) {
    constexpr int N = GU ? T_WGU : T_WD, NP = (N + 2) / 3 * 3; constexpr unsigned ldwb = (GU ? 4096u : 2048u) * 4u;
    LAS unsigned* scr = (LAS unsigned*)(F.lds + RING_OFF + F.wave * 8448);
    const int lane = F.lane, lg = lane >> 4, lc = lane & 15, rn = lane >> 3, ch = lane & 7;
    const unsigned lo = (unsigned)(4 * lg) * ldwb + 16u * (unsigned)lc;
    f32x4 A[4][4], B[4][4], C[4][4];
#define CV_LOAD(buf, P, h) do { _Pragma("unroll") for (int i = 0; i < 4; ++i) _Pragma("unroll") for (int p = 0; p < 4; ++p) { const char* rb_ = (P).src + (size_t)(64 * (h) + 16 * i + p) * ldwb; \
        asm volatile("global_load_dwordx4 %0, %1, %2 nt" : "=v"(buf[i][p]) : "v"(lo), "s"(rb_) : "memory"); } } while (0)
#define CV_WAIT(N, buf) do { asm volatile("s_waitcnt vmcnt(" #N ")" ::: "memory"); _Pragma("unroll") for (int i = 0; i < 4; ++i) asm volatile("" : "+v"(buf[i][0]), "+v"(buf[i][1]), "+v"(buf[i][2]), "+v"(buf[i][3])); } while (0)
#define CV_PROC(buf, h) do { _Pragma("unroll") for (int i = 0; i < 4; ++i) _Pragma("unroll") for (int c = 0; c < 4; ++c) \
        scr[(4 * lc + c) * 33 + 16 * (h) + 4 * i + lg] = pk4_fp8_raw(buf[i][0][c] * WSCALE, buf[i][1][c] * WSCALE, buf[i][2][c] * WSCALE, buf[i][3][c] * WSCALE); } while (0)
#define CV_STORE(P) do { _Pragma("unroll") for (int j = 0; j < 8; ++j) { const LAS unsigned* s_ = scr + (rn + 8 * j) * 33 + 4 * ch; u32x4 o_; o_.x = s_[0]; o_.y = s_[1]; o_.z = s_[2]; o_.w = s_[3]; \
        const unsigned so_ = (unsigned)(rn + 8 * j) * 2048u + 16u * (unsigned)ch; asm volatile("global_store_dwordx4 %0, %1, %2 nt" :: "v"(so_), "v"(o_), "s"((P).dst) : "memory"); } } while (0)
    const unsigned claim_add = 3u, claim_off = 0u; unsigned long long ex_save;
#define CV_CLAIM() asm volatile("s_mov_b64 %1, exec\n\ts_mov_b64 exec, 1\n\tglobal_atomic_add %0, %2, %3, %4 sc0\n\ts_mov_b64 exec, %1" : "+v"(raw), "=&s"(ex_save) : "v"(claim_off), "v"(claim_add), "s"(head) : "memory")
    unsigned raw = 0u;
    CV_CLAIM();
    asm volatile("s_waitcnt vmcnt(0)" : "+v"(raw) :: "memory");
    int base = (int)__builtin_amdgcn_readfirstlane(raw);
    CV_CLAIM();
    CvItem P0 = cv_decode<GU>(F, base), P1, P2;
    CV_LOAD(A, P0, 0); CV_LOAD(B, P0, 1);
    {
      unsigned char* junk = wsp<unsigned char>(F, WS_JUNK) + (size_t)(blockIdx.x * NWAVES + F.wave) * 16384; const u32x4 zz_ = {0u, 0u, 0u, 0u};
#pragma unroll
      for (int j = 0; j < 8; ++j) { const unsigned so_ = (unsigned)(rn + 8 * j) * 128u + 16u * (unsigned)ch; asm volatile("global_store_dwordx4 %0, %1, %2 nt" :: "v"(so_), "v"(zz_), "s"(junk) : "memory"); } }
    while (base < NP) {
        P1 = cv_decode<GU>(F, base + 1); P2 = cv_decode<GU>(F, base + 2);
        CV_LOAD(C, P1, 0); CV_WAIT(40, A); CV_PROC(A, 0);
        CV_LOAD(A, P1, 1); CV_WAIT(40, B); CV_PROC(B, 1); CV_STORE(P0);
        CV_LOAD(B, P2, 0); CV_WAIT(40, C); CV_PROC(C, 0);
        CV_LOAD(C, P2, 1); CV_WAIT(40, A); CV_PROC(A, 1); CV_STORE(P1);
        asm volatile("s_waitcnt vmcnt(48)" : "+v"(raw) :: "memory");
        base = (int)__builtin_amdgcn_readfirstlane(raw);
        CV_CLAIM();
        P0 = cv_decode<GU>(F, base);
        CV_LOAD(A, P0, 0); CV_WAIT(41, B); CV_PROC(B, 0);
        CV_LOAD(B, P0, 1); CV_WAIT(41, C); CV_PROC(C, 1); CV_STORE(P2);
    }
#undef CV_WAIT
    asm volatile("s_waitcnt vmcnt(0)" ::: "memory");
#undef CV_CLAIM
#undef CV_LOAD
#undef CV_PROC
#undef CV_STORE
}
__device__ __forceinline__ void convert_queue(Frame& F) {
    refresh(F);
    __syncthreads();
    if constexpr (!MOE_FP8) {
        LAS unsigned* scr0 = (LAS unsigned*)(F.lds + RING_OFF + F.wave * 8448); unsigned* head0 = F.ctl + CW_CQ; constexpr int NQ0 = T_WGU + T_WD;
        for (;;) { unsigned raw0 = 0u; if (F.lane == 0) raw0 = __hip_atomic_fetch_add(head0, 1u, __ATOMIC_RELAXED, __HIP_MEMORY_SCOPE_AGENT); const int it = (int)__builtin_amdgcn_readfirstlane(raw0); if (it >= NQ0) break; convert_item(F, it, scr0, F.lane); }
        __syncthreads(); return; }
    convert_loop<true>(F, F.ctl + CW_CQ);
    convert_loop<false>(F, F.ctl + CW_CQ + 128);
    __syncthreads();
}


constexpr int CS_GU = 32 * 8 * 16, CS_DN = 32 * 8 * 8, CS_N = CS_GU + CS_DN, CS_PITCH = 65;
__device__ __forceinline__ void convert_coop(Frame& F) {
    refresh(F);
    __syncthreads();
    LAS unsigned* tile0 = (LAS unsigned*)(F.lds + RING_OFF);
    unsigned* head = F.ctl + CW_CQ + 256;
    const int lane = F.lane, w = F.wave;
    if (F.tid == 0) F.MISC[104] = __hip_atomic_fetch_add(head, 1u, __ATOMIC_RELAXED, __HIP_MEMORY_SCOPE_AGENT);
    __syncthreads();
    int slot = 0, p = 0;
    for (;;) {
        const int it = (int)F.MISC[104 + slot];
        if (it >= CS_N) break;
        if (F.tid == 0) F.MISC[104 + (slot ^ 1)] = __hip_atomic_fetch_add(head, 1u, __ATOMIC_RELAXED, __HIP_MEMORY_SCOPE_AGENT);
        const bool gu = it < CS_GU; const int r = gu ? it : it - CS_GU;
        const int e = gu ? (r >> 7) : (r >> 6), q = gu ? (r & 127) : (r & 63), kb = gu ? (q >> 4) : (q >> 3), nb = gu ? (q & 15) : (q & 7);
        const size_t ldw = gu ? 4096 : 2048;
        const float* W = (gu ? F.w_gu : F.w_dn) + (size_t)e * 2048 * ldw + (size_t)(256 * kb + 32 * w) * ldw;
        const int scol = gu ? ((lane >> 5) * 2048 + nb * 128 + 4 * (lane & 31)) : (nb * 256 + 4 * lane);
        unsigned char* O = (gu ? wsp<unsigned char>(F, WS_WGU) : wsp<unsigned char>(F, WS_WD)) + (size_t)e * ldw * 2048 + (size_t)(256 * nb) * 2048 + 256 * kb;
        LAS unsigned* T = tile0 + p * (256 * CS_PITCH);
        f32x4 v[32];
#pragma unroll
        for (int i = 0; i < 32; ++i) v[i] = __builtin_nontemporal_load((const f32x4*)(W + (size_t)i * ldw + scol));
#pragma unroll
        for (int kk = 0; kk < 8; ++kk)
#pragma unroll
            for (int c = 0; c < 4; ++c) T[(4 * lane + c) * CS_PITCH + 8 * w + kk] = pk4_fp8_raw(v[4 * kk][c] * WSCALE, v[4 * kk + 1][c] * WSCALE, v[4 * kk + 2][c] * WSCALE, v[4 * kk + 3][c] * WSCALE);
        __syncthreads();
#pragma unroll
        for (int i = 0; i < 8; ++i) { const int n = 32 * w + 4 * i + (lane >> 4), ch = lane & 15; const LAS unsigned* s_ = T + n * CS_PITCH + 4 * ch; u32x4 o; o.x = s_[0]; o.y = s_[1]; o.z = s_[2]; o.w = s_[3];
            __builtin_nontemporal_store(o, (u32x4*)(O + (size_t)n * 2048 + 16 * ch)); }
        slot ^= 1; p ^= 1;
    }
    __syncthreads();
}

__device__ __forceinline__ void p1_norm_fb(Frame& F) {
    refresh(F);
#pragma unroll 1
    for (int i0 = F.tid; i0 < 2048 * 4; i0 += 8 * NWAVES * 64) {
        f32x4 v[8];
#pragma unroll
        for (int u = 0; u < 8; ++u) { const int i = i0 + u * NWAVES * 64, k = i >> 2, q = i & 3; v[u] = *(const f32x4*)(F.w_in + (size_t)k * INW + 4608 + 4 * q); }
#pragma unroll
        for (int u = 0; u < 8; ++u) { const int i = i0 + u * NWAVES * 64, k = i >> 2, q = i & 3; const int j = k >> 8, l = (k & 255) >> 2, c = k & 3; *(LAS f32x4*)(F.lds + RING_OFF + ((((j * 4 + c) * 4 + q) * 64 + l) << 4)) = v[u]; } }
    __syncthreads();
    const int gw = F.vcu * NWAVES + F.wave, NGW = F.G * NWAVES, lane = F.lane;
    const float* mod = wsp<float>(F, WS_MOD); unsigned char* XN = wsp<unsigned char>(F, WS_XN); float* LOGF = wsp<float>(F, WS_LOGF);
    for (int row = gw; row < NTOK; row += NGW) {
        const int b = row >> 11; const float* xr = F.x + (size_t)row * DM; const float* sh = mod + b * MODW, *sc = mod + b * MODW + 2048;
        f32x4 v[8]; float ss = 0.f;
#pragma unroll
        for (int j = 0; j < 8; ++j) { v[j] = *(const f32x4*)(xr + 256 * j + 4 * lane); ss += v[j][0] * v[j][0] + v[j][1] * v[j][1] + v[j][2] * v[j][2] + v[j][3] * v[j][3]; }
        ss = wave_sum(ss); const float rstd = 1.0f / sqrtf(ss * (1.0f / DM) + 1e-5f);
        float fa[16];
#pragma unroll
        for (int h = 0; h < 16; ++h) fa[h] = 0.f;
#pragma unroll
        for (int j = 0; j < 8; ++j) { const int col = 256 * j + 4 * lane; const f32x4 g = *(const f32x4*)(F.g_mix + col), s1 = *(const f32x4*)(sc + col), h1 = *(const f32x4*)(sh + col);
            const f32x4 y = v[j] * rstd * g * (s1 + 1.0f) + h1;
            if constexpr (MIX_FP8) *(unsigned*)(XN + (size_t)row * DM + col) = pk4_fp8(y[0], y[1], y[2], y[3]);
            else { u32x2 w; w.x = pk2(y[0], y[1]); w.y = pk2(y[2], y[3]); *(u32x2*)((bf16_t*)XN + (size_t)row * DM + col) = w; }
#pragma unroll
            for (int c = 0; c < 4; ++c) {
#pragma unroll
                for (int q = 0; q < 4; ++q) { const f32x4 wv = *(const LAS f32x4*)(F.lds + RING_OFF + ((((j * 4 + c) * 4 + q) * 64 + lane) << 4));
#pragma unroll
                    for (int e = 0; e < 4; ++e) fa[4 * q + e] += y[c] * wv[e]; }
                if (c & 1) asm volatile("" ::: "memory"); } }
#pragma unroll
        for (int h = 0; h < 16; ++h) fa[h] = wave_sum(fa[h]);
        float mine = 0.f;
#pragma unroll
        for (int h = 0; h < 16; ++h) mine = (lane == h) ? fa[h] : mine;
        if (lane < 16) { const float f = mine + F.b_in[4608 + lane]; LOGF[row * 16 + lane] = fminf(f, 0.f) - log1pf(expf(-fabsf(f))); }
    }
}
__device__ __forceinline__ void p2_cumsum(Frame& F) {
    refresh(F);
    volatile LAS float* wsum_s = (volatile LAS float*)(F.MISC + 96);
    const float* LOGF = wsp<float>(F, WS_LOGF); float* CUM = wsp<float>(F, WS_CUM);
    for (int bh = F.vcu; bh < 64; bh += F.G) {
        const int b = bh >> 4, h = bh & 15, t0 = 4 * F.tid;
        float a[4];
#pragma unroll
        for (int i = 0; i < 4; ++i) a[i] = LOGF[(size_t)(b * SEQ + t0 + i) * 16 + h];
        a[1] += a[0]; a[2] += a[1]; a[3] += a[2];
        float s = a[3];
#pragma unroll
        for (int o = 1; o < 64; o <<= 1) { const float t = __shfl_up(s, o); if (F.lane >= o) s += t; }
        if (F.lane == 63) wsum_s[F.wave] = s;
        __syncthreads();
        float base = 0.f;
        for (int w = 0; w < F.wave; ++w) base += wsum_s[w];
        const float excl = base + s - a[3];
#pragma unroll
        for (int i = 0; i < 4; ++i) CUM[(size_t)bh * SEQ + t0 + i] = excl + a[i];
        __syncthreads();
    }
}

constexpr int AT_KOFF = 0, AT_VOFF = 9216, AT_COFF = 17920, AT_BUF = 18432;
template <int MODE>
__device__ __forceinline__ void attn_unit(LAS unsigned char* lds, const bf16_t* __restrict__ Q, const bf16_t* __restrict__ Kt, const bf16_t* __restrict__ Vt, const float* __restrict__ cum, unsigned char* __restrict__ O,
                                          int b, int h, int qb, float sink2, int wid) {
    const int lane = lane_id(), tid = wid * 64 + lane, r32 = lane & 31, hi = lane >> 5;
    constexpr int KP = MODE ? 1024 : 256;
    const int kvh = MODE ? h : (h >> 2);
    const int q0 = qb * 256, w0 = q0 + 32 * wid;
    const size_t rowbase = (size_t)b * SEQ;
    bf16x8 qf[4];
    { const bf16_t* qp = Q + (rowbase + w0 + r32) * 1024 + h * 64 + hi * 8;
#pragma unroll
      for (int d0 = 0; d0 < 4; ++d0) qf[d0] = *(const bf16x8*)(qp + d0 * 16); }
    const int kt_lo = MODE ? 0 : (q0 >= 128 ? ((q0 - 128) >> 6) : 0), kt_hi = (q0 + 255) >> 6;
    const int skey = tid >> 3, sch = tid & 7, vp = (tid & 255) >> 3;
    const bf16_t* kg = Kt + (rowbase + skey) * KP + kvh * 64 + sch * 8;
    const bf16_t* vg = Vt + (rowbase + 2 * vp) * KP + kvh * 64 + sch * 8;
    u32x4 kreg, vr0, vr1; float ckreg = 0.f;
#define AT_LOAD(kt) do { kreg = *(const u32x4*)(kg + (size_t)(kt) * 64 * KP); if (tid >= 256) { vr0 = *(const u32x4*)(vg + (size_t)(kt) * 64 * KP); vr1 = *(const u32x4*)(vg + (size_t)(kt) * 64 * KP + KP); } \
        if (MODE && tid < 64) ckreg = cum[(kt) * 64 + tid] * LOG2E; } while (0)
    AT_LOAD(kt_lo);
    float m = MODE ? -1e30f : sink2, l = (MODE == 0 && hi == 0) ? 1.0f : 0.0f;
    const float cq2 = MODE ? cum[w0 + r32] * LOG2E : 0.f;
    f32x16 o0 = {}, o1 = {};
    for (int kt = kt_lo; kt <= kt_hi; ++kt) {
        LAS unsigned char* buf = lds + ((kt - kt_lo) & 1) * AT_BUF;
        *(LAS u32x4*)(buf + AT_KOFF + skey * 144 + sch * 16) = kreg;
        if (tid >= 256) {
#pragma unroll
            for (int i = 0; i < 8; ++i) { const unsigned a = vr0[i >> 1], c = vr1[i >> 1];
                *(LAS unsigned*)(buf + AT_VOFF + (8 * sch + i) * 136 + vp * 4) = __builtin_amdgcn_perm(c, a, (i & 1) ? 0x07060302u : 0x05040100u); } }
        if (MODE && tid < 64) *(LAS float*)(buf + AT_COFF + tid * 4) = ckreg;
        __syncthreads();
        if (kt < kt_hi) AT_LOAD(kt + 1);
        const int k0 = kt * 64;
        const bool active = (k0 <= w0 + 31) && (MODE || (k0 + 63 >= w0 - 127));
        if (active) {
            f32x16 p0 = {}, p1 = {};
            { const LAS unsigned char* kb = buf + AT_KOFF + r32 * 144 + hi * 16;
#pragma unroll
              for (int d0 = 0; d0 < 4; ++d0) { const bf16x8 ka = *(const LAS bf16x8*)(kb + d0 * 32), kc = *(const LAS bf16x8*)(kb + 32 * 144 + d0 * 32);
                  p0 = __builtin_amdgcn_mfma_f32_32x32x16_bf16(ka, qf[d0], p0, 0, 0, 0); p1 = __builtin_amdgcn_mfma_f32_32x32x16_bf16(kc, qf[d0], p1, 0, 0, 0); } }
            if (MODE) {
#pragma unroll
                for (int g = 0; g < 4; ++g) { const f32x4 c0 = *(const LAS f32x4*)(buf + AT_COFF + (8 * g + 4 * hi) * 4), c1 = *(const LAS f32x4*)(buf + AT_COFF + (32 + 8 * g + 4 * hi) * 4);
#pragma unroll
                    for (int j = 0; j < 4; ++j) { p0[4 * g + j] += cq2 - c0[j]; p1[4 * g + j] += cq2 - c1[j]; } } }
            const bool need_mask = MODE ? (k0 + 63 > w0) : true;
            if (need_mask) { const int q = w0 + r32;
#pragma unroll
                for (int r = 0; r < 16; ++r) { const int key = k0 + (r & 3) + 8 * (r >> 2) + 4 * hi;
                    const bool v0 = (key <= q) && (MODE || key + 127 >= q), v1 = (key + 32 <= q) && (MODE || key + 32 + 127 >= q);
                    p0[r] = v0 ? p0[r] : -INFINITY; p1[r] = v1 ? p1[r] : -INFINITY; } }
            float rm = __builtin_fmaxf(p0[0], p1[0]);
#pragma unroll
            for (int r = 1; r < 16; ++r) rm = __builtin_fmaxf(__builtin_fmaxf(rm, p0[r]), p1[r]);
            { const unsigned ru = __builtin_bit_cast(unsigned, rm); auto rr = __builtin_amdgcn_permlane32_swap(ru, ru, false, false);
              rm = __builtin_fmaxf(__builtin_bit_cast(float, rr[0]), __builtin_bit_cast(float, rr[1])); }
            const float mn = fmaxf(m, rm), alpha = __builtin_amdgcn_exp2f(m - mn);
            const bool grew = mn > m; m = mn;
            float ps = 0.f;
#pragma unroll
            for (int r = 0; r < 16; ++r) { p0[r] = __builtin_amdgcn_exp2f(p0[r] - mn); p1[r] = __builtin_amdgcn_exp2f(p1[r] - mn); ps += p0[r] + p1[r]; }
            l = l * alpha + ps;
            if (__any(grew)) {
#pragma unroll
                for (int r = 0; r < 16; ++r) { o0[r] *= alpha; o1[r] *= alpha; } }
            bf16x8 pf[4];
            { u32x4 w;
              w.x = pk2(p0[0], p0[1]); w.y = pk2(p0[2], p0[3]); w.z = pk2(p0[4], p0[5]); w.w = pk2(p0[6], p0[7]); pf[0] = __builtin_bit_cast(bf16x8, w);
              w.x = pk2(p0[8], p0[9]); w.y = pk2(p0[10], p0[11]); w.z = pk2(p0[12], p0[13]); w.w = pk2(p0[14], p0[15]); pf[1] = __builtin_bit_cast(bf16x8, w);
              w.x = pk2(p1[0], p1[1]); w.y = pk2(p1[2], p1[3]); w.z = pk2(p1[4], p1[5]); w.w = pk2(p1[6], p1[7]); pf[2] = __builtin_bit_cast(bf16x8, w);
              w.x = pk2(p1[8], p1[9]); w.y = pk2(p1[10], p1[11]); w.z = pk2(p1[12], p1[13]); w.w = pk2(p1[14], p1[15]); pf[3] = __builtin_bit_cast(bf16x8, w); }
            const LAS unsigned char* vb = buf + AT_VOFF + r32 * 136 + hi * 8;
#pragma unroll
            for (int ks = 0; ks < 4; ++ks) {
                { const u32x2 lo = *(const LAS u32x2*)(vb + ks * 32), hh = *(const LAS u32x2*)(vb + ks * 32 + 16); const u32x4 w = {lo.x, lo.y, hh.x, hh.y};
                  o0 = __builtin_amdgcn_mfma_f32_32x32x16_bf16(__builtin_bit_cast(bf16x8, w), pf[ks], o0, 0, 0, 0); }
                { const u32x2 lo = *(const LAS u32x2*)(vb + 32 * 136 + ks * 32), hh = *(const LAS u32x2*)(vb + 32 * 136 + ks * 32 + 16); const u32x4 w = {lo.x, lo.y, hh.x, hh.y};
                  o1 = __builtin_amdgcn_mfma_f32_32x32x16_bf16(__builtin_bit_cast(bf16x8, w), pf[ks], o1, 0, 0, 0); } }
        }
    }
#undef AT_LOAD
    l += __shfl_xor(l, 32);
    const float inv = 1.0f / l;
    const size_t oe = (rowbase + w0 + r32) * 2048 + MODE * 1024 + h * 64 + 4 * hi;
#pragma unroll
    for (int g = 0; g < 4; ++g) {
        if constexpr (MIX_FP8) { *(unsigned*)(O + oe + 8 * g) = pk4_fp8(o0[4 * g] * inv, o0[4 * g + 1] * inv, o0[4 * g + 2] * inv, o0[4 * g + 3] * inv);
            *(unsigned*)(O + oe + 32 + 8 * g) = pk4_fp8(o1[4 * g] * inv, o1[4 * g + 1] * inv, o1[4 * g + 2] * inv, o1[4 * g + 3] * inv); }
        else { bf16_t* op = (bf16_t*)O + oe; u32x2 w; w.x = pk2(o0[4 * g] * inv, o0[4 * g + 1] * inv); w.y = pk2(o0[4 * g + 2] * inv, o0[4 * g + 3] * inv); *(u32x2*)(op + 8 * g) = w;
            w.x = pk2(o1[4 * g] * inv, o1[4 * g + 1] * inv); w.y = pk2(o1[4 * g + 2] * inv, o1[4 * g + 3] * inv); *(u32x2*)(op + 32 + 8 * g) = w; } }
    __syncthreads();
}
__device__ __forceinline__ void p3_attention(Frame& F) {
    refresh(F);
    const bf16_t *QA = wsp<bf16_t>(F, WS_QA), *KA = wsp<bf16_t>(F, WS_KA), *VA = wsp<bf16_t>(F, WS_VA), *QB = wsp<bf16_t>(F, WS_QB), *KB = wsp<bf16_t>(F, WS_KB), *VB = wsp<bf16_t>(F, WS_VB);
    const float* CUM = wsp<float>(F, WS_CUM); unsigned char* YAB = wsp<unsigned char>(F, WS_YAB);
    LAS unsigned char* lds = F.lds + RING_OFF;
    unsigned* head = F.ctl + CW_AQ;
    for (;;) {
        __syncthreads();
        if (F.tid == 0) F.MISC[100] = __hip_atomic_fetch_add(head, 1u, __ATOMIC_RELAXED, __HIP_MEMORY_SCOPE_AGENT);
        __syncthreads();
        const int u = (int)F.MISC[100];
        if (u >= 1024) break;
        if (u < 512) { const int bh = u & 63, qb = 7 - (u >> 6); attn_unit<1>(lds, QB, KB, VB, CUM + (size_t)bh * SEQ, YAB, bh >> 4, bh & 15, qb, 0.f, F.wave); }
        else { const int v = u - 512, bh = v >> 3, qb = v & 7; attn_unit<0>(lds, QA, KA, VA, nullptr, YAB, bh >> 4, bh & 15, qb, F.sinks[bh & 15] * LOG2E, F.wave); }
    }
}

template <int HH>
__device__ __forceinline__ void p6_half(Frame& F) {
    refresh(F);
    const int gw = F.vcu * NWAVES + F.wave, NGW = F.G * NWAVES, lane = F.lane;
    const float* mod = wsp<float>(F, WS_MOD); const float* H1 = wsp<float>(F, WS_H1); unsigned char* XN2 = wsp<unsigned char>(F, WS_XN2);
    int* TEID = wsp<int>(F, WS_TEID); int* TPOS = wsp<int>(F, WS_TPOS); float* TGATE = wsp<float>(F, WS_TGATE); int* TOKOF = wsp<int>(F, WS_TOKOF);
    LAS float* part = (LAS float*)(F.lds + TBL_OFF) + F.wave * 256 + lane;
    __syncthreads();
#pragma unroll 1
    for (int i0 = F.tid; i0 < 1024 * 8; i0 += 8 * NWAVES * 64) {
        f32x4 v[8];
#pragma unroll
        for (int u = 0; u < 8; ++u) { const int i = i0 + u * NWAVES * 64, kk = i >> 3, q = i & 7; v[u] = *(const f32x4*)(F.w_r + (size_t)(1024 * HH + kk) * 32 + 4 * q); }
#pragma unroll
        for (int u = 0; u < 8; ++u) { const int i = i0 + u * NWAVES * 64, kk = i >> 3, q = i & 7; const int jj = kk >> 8, l = (kk & 255) >> 2, c = kk & 3; *(LAS f32x4*)(F.lds + RING_OFF + ((((jj * 4 + c) * 8 + q) * 64 + l) << 4)) = v[u]; } }
    __syncthreads();
#pragma unroll 1
    for (int ri = 0; ri < 4; ++ri) {
        const int row = gw + ri * NGW; if (row >= NTOK) break;
        int lane4 = 4 * lane; asm volatile("" : "+v"(lane4));
        const int b = row >> 11; const float* xr = H1 + (size_t)row * DM + lane4; const float* sh = mod + b * MODW + 6144 + lane4, *sc = mod + b * MODW + 8192 + lane4; const float* gp = F.g_ffn + lane4;
        f32x4 v[4]; float ss = 0.f;
#pragma unroll
        for (int j = 0; j < 4; ++j) { v[j] = *(const f32x4*)(xr + 256 * (4 * HH + j)); const f32x4 o = *(const f32x4*)(xr + 256 * (4 * (1 - HH) + j));
            ss += v[j][0] * v[j][0] + v[j][1] * v[j][1] + v[j][2] * v[j][2] + v[j][3] * v[j][3] + o[0] * o[0] + o[1] * o[1] + o[2] * o[2] + o[3] * o[3]; }
        ss = wave_sum(ss); const float rstd = 1.0f / sqrtf(ss * (1.0f / DM) + 1e-5f);
        float a[32];
#pragma unroll
        for (int e = 0; e < 32; ++e) a[e] = 0.f;
        const LAS unsigned char* wl = F.lds + RING_OFF + 4 * lane4;
#pragma unroll
        for (int jj = 0; jj < 4; ++jj) { const int col = 256 * (4 * HH + jj); const f32x4 g = *(const f32x4*)(gp + col), s1 = *(const f32x4*)(sc + col), h1 = *(const f32x4*)(sh + col);
            const f32x4 y = v[jj] * rstd * g * (s1 + 1.0f) + h1;
            if constexpr (MOE_FP8) *(unsigned*)(XN2 + (size_t)row * DM + col + lane4) = pk4_fp8(y[0], y[1], y[2], y[3]);
            else { u32x2 w; w.x = pk2(y[0], y[1]); w.y = pk2(y[2], y[3]); *(u32x2*)((bf16_t*)XN2 + (size_t)row * DM + col + lane4) = w; }
#pragma unroll
            for (int c = 0; c < 4; ++c) {
#pragma unroll
                for (int q = 0; q < 8; ++q) { const f32x4 wv = *(const LAS f32x4*)(wl + ((((jj * 4 + c) * 8 + q) * 64) << 4));
#pragma unroll
                    for (int e = 0; e < 4; ++e) a[4 * q + e] += y[c] * wv[e]; }
                asm volatile("" ::: "memory"); } }
#define P6_RSTEP(XF, MASK, HALF) { const bool up = (lane & (MASK)) != 0; _Pragma("unroll") for (int i = 0; i < (HALF); ++i) { const float keep = up ? a[i + (HALF)] : a[i], give = up ? a[i] : a[i + (HALF)]; a[i] = keep + XF; } }
        P6_RSTEP(__shfl_xor(give, 32), 32, 16) P6_RSTEP(__shfl_xor(give, 16), 16, 8) P6_RSTEP(__shfl_xor(give, 8), 8, 4) P6_RSTEP(__shfl_xor(give, 4), 4, 2) P6_RSTEP(__shfl_xor(give, 2), 2, 1)
#undef P6_RSTEP
        float lg = a[0] + __shfl_xor(a[0], 1);
        if (HH == 0) { part[ri * 64] = lg; continue; }
        lg += part[ri * 64] + F.b_r[lane >> 1];
        float val[4]; int idx[4];
        float cur = lg;
#pragma unroll
        for (int k = 0; k < 4; ++k) { float bv = cur; int bi = lane >> 1;
#pragma unroll
            for (int o = 1; o < 64; o <<= 1) { const float ov = __shfl_xor(bv, o); const int oi = __shfl_xor(bi, o); if (ov > bv || (ov == bv && oi < bi)) { bv = ov; bi = oi; } }
            val[k] = bv; idx[k] = bi; if ((lane >> 1) == bi) cur = -INFINITY; }
        float ex[4], sm = 0.f;
#pragma unroll
        for (int k = 0; k < 4; ++k) { ex[k] = expf(val[k] - val[0]); sm += ex[k]; }
        if (lane < 4) { int e = idx[0]; float gt = ex[0];
#pragma unroll
            for (int k = 1; k < 4; ++k) if (lane == k) { e = idx[k]; gt = ex[k]; }
            const int p = (int)atomicAdd(F.ctl + CW_CNT + e, 1u);
            TOKOF[e * NTOK + p] = row; TEID[row * 4 + lane] = e; TPOS[row * 4 + lane] = p; TGATE[row * 4 + lane] = gt / sm; }
    }
}
__device__ __forceinline__ void p6_norm_router(Frame& F) { p6_half<0>(F); p6_half<1>(F); }
__device__ __forceinline__ void moe_tables(Frame& F) {
    refresh(F);
    __syncthreads();
    if (F.tid == 0) { unsigned s = 0, h = 0, nl = 0;
        for (int e = 0; e < 32; ++e) { const unsigned c = __hip_atomic_load(F.ctl + CW_CNT + e, __ATOMIC_RELAXED, __HIP_MEMORY_SCOPE_AGENT); F.MISC[48 + e] = c; F.MISC[8 + e] = s; s += (c + 255u) >> 8;
            const unsigned rem = c & 255u; F.MISC[112 + e] = h; h += (c >> 8) + (rem > 128u ? 1u : 0u); if (rem >= 1u && rem <= 128u) { F.MISC[152 + nl] = (unsigned)e; ++nl; } }
        F.MISC[8 + 32] = s; F.MISC[112 + 32] = h; F.MISC[190] = nl; }
    __syncthreads();
}
__device__ __forceinline__ void p7_gu(Frame& F) {
    moe_tables(F);
    MoeSched<true> S; S.tpre = F.MISC + 8; S.cnt = F.MISC + 48; S.hpre = F.MISC + 112; S.lexp = F.MISC + 152; S.nlight = (int)F.MISC[190]; S.tbl = (const LAS unsigned*)(F.lds + TBL_OFF); S.A = (const char*)wsp<bf16_t>(F, WS_XN2); S.Bt = (const char*)wsp<bf16_t>(F, WS_WGU); S.NN = 16; S.ldb2 = 2048 * MOE_EB; S.K = 2048;
    S.G = F.G; S.vcu = F.vcu; S.b_estride = (size_t)4096 * 2048 * MOE_EB;
    { const int* TOKOF = wsp<int>(F, WS_TOKOF); Unit u; LAS unsigned* tbl = (LAS unsigned*)(F.lds + TBL_OFF);
      for (int i = 0; i < 10 && S.next(i, u); ++i) { if (F.tid < 256) { const int e = u.aux, p = (u.pm - (int)F.MISC[8 + e]) * 256 + F.tid, cnt = (int)F.MISC[48 + e]; const int tok = TOKOF[e * NTOK + (p < cnt ? p : 0)]; tbl[i * 256 + F.tid] = (unsigned)tok * (2048u * MOE_EB); } }
      __syncthreads(); }
    EpiGU E{F.b_gu, wsp<unsigned char>(F, WS_ACT)};
    gemm_phase<EpiGU, MoeSched<true>, true, MOE_FP8>(F.lds + RING_OFF, S, E, F.wave);
}
__device__ __forceinline__ void p8_down(Frame& F) {
    moe_tables(F);
    MoeSched<false> S; S.tpre = F.MISC + 8; S.cnt = F.MISC + 48; S.hpre = F.MISC + 112; S.lexp = F.MISC + 152; S.nlight = (int)F.MISC[190]; S.tbl = nullptr; S.A = (const char*)wsp<bf16_t>(F, WS_ACT); S.Bt = (const char*)wsp<bf16_t>(F, WS_WD); S.NN = 8; S.ldb2 = 2048 * MOE_EB; S.K = 2048;
    S.G = F.G; S.vcu = F.vcu; S.b_estride = (size_t)2048 * 2048 * MOE_EB;
    EpiDown E{F.b_dn, wsp<bf16_t>(F, WS_YS)};
    gemm_phase<EpiDown, MoeSched<false>, true, MOE_FP8>(F.lds + RING_OFF, S, E, F.wave);
}
__device__ __forceinline__ void p9_final(Frame& F) {
    refresh(F);
    moe_tables(F);
    const int gw = F.vcu * NWAVES + F.wave, NGW = F.G * NWAVES, lane = F.lane;
    const float* mod = wsp<float>(F, WS_MOD); const float* H1 = wsp<float>(F, WS_H1); const bf16_t* YS = wsp<bf16_t>(F, WS_YS);
    const int* TEID = wsp<int>(F, WS_TEID); const int* TPOS = wsp<int>(F, WS_TPOS); const float* TGATE = wsp<float>(F, WS_TGATE);
    for (int row = gw; row < NTOK; row += NGW) {
        const int b = row >> 11; const float* gt = mod + b * MODW + 10240;
        const bf16_t* yr[4]; float gw4[4];
#pragma unroll
        for (int k = 0; k < 4; ++k) { const int e = TEID[row * 4 + k]; yr[k] = YS + ((size_t)F.MISC[8 + e] * 256 + TPOS[row * 4 + k]) * 2048; gw4[k] = TGATE[row * 4 + k]; }
        f32x4 v[8]; float ss = 0.f;
#pragma unroll
        for (int j = 0; j < 8; ++j) { const int col = 256 * j + 4 * lane; f32x4 y = {0.f, 0.f, 0.f, 0.f};
#pragma unroll
            for (int k = 0; k < 4; ++k) { const u32x2 w = *(const u32x2*)(yr[k] + col); y += (f32x4){bflo(w.x), bfhi(w.x), bflo(w.y), bfhi(w.y)} * gw4[k]; }
            v[j] = *(const f32x4*)(H1 + (size_t)row * DM + col) + *(const f32x4*)(gt + col) * y;
            ss += v[j][0] * v[j][0] + v[j][1] * v[j][1] + v[j][2] * v[j][2] + v[j][3] * v[j][3]; }
        ss = wave_sum(ss); const float rstd = 1.0f / sqrtf(ss * (1.0f / DM) + 1e-5f);
#pragma unroll
        for (int j = 0; j < 8; ++j) { const int col = 256 * j + 4 * lane; *(f32x4*)(F.out + (size_t)row * DM + col) = v[j] * rstd * *(const f32x4*)(F.g_fin + col); }
    }
}

constexpr int PER_PHASE = 10;
struct Args { const void* in[20]; float* out; unsigned char* ws; int ph_lo, ph_hi; };
__global__ void __launch_bounds__(NWAVES * 64, 2) mega_fwd(Args args) {
    extern __shared__ __attribute__((aligned(16))) unsigned char lds_raw[];
    Frame F;
    F.lds = (LAS unsigned char*)lds_raw; F.MISC = (volatile LAS unsigned*)(F.lds + MISC_OFF);
    F.tid = threadIdx.x; F.lane = F.tid & 63; F.wave = __builtin_amdgcn_readfirstlane(F.tid >> 6);
    F.G = gridDim.x; { const int bx = blockIdx.x; F.vcu = (F.G % 8 == 0) ? (bx % 8) * (F.G / 8) + bx / 8 : bx; }
    F.ws = args.ws; F.ctl = (unsigned*)(args.ws + WS_CTL); F.out = args.out;
    F.x = (const float*)args.in[0]; F.c = (const float*)args.in[1]; F.pos = (const int*)args.in[2]; F.w_ada = (const float*)args.in[3]; F.b_ada = (const float*)args.in[4]; F.g_mix = (const float*)args.in[5];
    F.w_in = (const float*)args.in[6]; F.b_in = (const float*)args.in[7]; F.sinks = (const float*)args.in[8]; F.w_a = (const float*)args.in[9]; F.w_b = (const float*)args.in[10]; F.w_out = (const float*)args.in[11];
    F.g_ffn = (const float*)args.in[12]; F.w_r = (const float*)args.in[13]; F.b_r = (const float*)args.in[14]; F.w_gu = (const float*)args.in[15]; F.b_gu = (const float*)args.in[16]; F.w_dn = (const float*)args.in[17];
    F.b_dn = (const float*)args.in[18]; F.g_fin = (const float*)args.in[19];
    for (int u = F.tid; u < 256; u += NWAVES * 64) F.MISC[u] = 0u;
    __syncthreads();
    refresh(F);
    const int lo = args.ph_lo, hi = args.ph_hi;
    const bool one_launch = true; (void)lo; (void)hi;
    XcdBarrier bar; bar.bar = (unsigned*)(F.ctl + CW_BAR); bar.x = 0; bar.st = nullptr; bar.total = 0;
    XcdBarrier bar2 = bar;
    const bool is_comp = (int)blockIdx.x < NCOMP || F.G <= NCOMP;
    const int ncomp = F.G <= NCOMP ? F.G : NCOMP;
    if (one_launch) { bar = xcd_barrier_post((unsigned*)(F.ctl + CW_BAR), F.MISC + 0, (unsigned)F.G);
        if (is_comp) bar2 = xcd_barrier_post((unsigned*)(F.ctl + CW_BAR2), F.MISC + 2, (unsigned)ncomp); }
#ifndef REPEAT_MASK
#define REPEAT_MASK 0
#endif
#define IN(k) true
#define REP(k, body) do { if ((REPEAT_MASK >> (k)) & 1) { body; xcd_barrier(bar); } } while (0)
#define REP2(k, body) do { if ((REPEAT_MASK >> (k)) & 1) { body; xcd_barrier(bar2); } } while (0)
#define SEAM(k) do { if (IN(k) && IN((k) + 1)) xcd_barrier(bar); } while (0)
    if (one_launch) {
        if (is_comp) {
            const int G0 = F.G, v0 = F.vcu; F.G = ncomp; { const int bx = blockIdx.x; F.vcu = (ncomp % 8 == 0) ? (bx % 8) * (ncomp / 8) + bx / 8 : bx; }
            const bool split0 = ncomp < G0;
            p0_prologue(F, 0, split0 ? P0_T_HEAD : P0_T_ALL, F.vcu * NWAVES + F.wave, F.G * NWAVES); xcd_barrier(bar2);
            REP2(1, p1_norm_fb(F)); p1_norm_fb(F); xcd_barrier(bar2);
            if (split0) {
                if (F.tid == 0) { unsigned* flag = F.ctl + CW_SFLAG; unsigned* tmo = (unsigned*)(F.ctl + CW_BAR) + XB_TMO; const unsigned want = (unsigned)(G0 - ncomp);
                    XB_SPIN(xb_ld(flag) < want, (unsigned*)(F.ctl + CW_BAR)); (void)tmo;
                    __builtin_amdgcn_fence(__ATOMIC_ACQUIRE, "agent"); asm volatile("s_waitcnt vmcnt(0)" ::: "memory"); }
                __syncthreads(); }
            { p2_cumsum(F);
              DenseSched S; S.init(wsp<bf16_t>(F, WS_XN), 2048 * MIX_EB, wsp<bf16_t>(F, WS_WIN), 2048 * MIX_EB, 2048, NTOK, 8704, ncomp, (int)blockIdx.x);
              EpiInProj E{wsp<bf16_t>(F, WS_QA), wsp<bf16_t>(F, WS_KA), wsp<bf16_t>(F, WS_VA), wsp<bf16_t>(F, WS_QB), wsp<bf16_t>(F, WS_KB), wsp<bf16_t>(F, WS_VB), wsp<bf16_t>(F, WS_SGA), wsp<bf16_t>(F, WS_SGB),
                          wsp<float>(F, WS_BINP), wsp<float>(F, WS_COS), wsp<float>(F, WS_SIN)};
              REP2(2, (gemm_phase<EpiInProj, DenseSched, true, MIX_FP8>(F.lds + RING_OFF, S, E, F.wave)));
              gemm_phase<EpiInProj, DenseSched, true, MIX_FP8>(F.lds + RING_OFF, S, E, F.wave); }
            xcd_barrier(bar2);
            p3_attention(F);
            xcd_barrier(bar2);
            {
                BranchSched S; S.d.init(wsp<bf16_t>(F, WS_YAB), 2048 * MIX_EB, wsp<bf16_t>(F, WS_WAB), 1024 * MIX_EB, 1024, NTOK, 2048, ncomp, (int)blockIdx.x); S.ldb2 = 1024 * MIX_EB; S.K = 1024;
                EpiBranch E{wsp<bf16_t>(F, WS_SGA), wsp<bf16_t>(F, WS_SGB), wsp<float>(F, WS_T1), wsp<unsigned char>(F, WS_MERGED)};
                gemm_phase<EpiBranch, BranchSched, true, MIX_FP8>(F.lds + RING_OFF, S, E, F.wave); }
            xcd_barrier(bar2);
            {
                DenseSched S; S.init(wsp<bf16_t>(F, WS_MERGED), 2048 * P5_EB, wsp<bf16_t>(F, WS_WOUT), 2048 * P5_EB, 2048, NTOK, 2048, ncomp, (int)blockIdx.x);
                EpiOut E{F.x, wsp<float>(F, WS_MOD), wsp<float>(F, WS_H1)};
                gemm_phase<EpiOut, DenseSched, true, P5_FP8>(F.lds + RING_OFF, S, E, F.wave); }
            F.G = G0; F.vcu = v0;
        }
#ifndef CONV_COOP
#define CONV_COOP 1
#endif
        if (!is_comp) {
            p0_prologue(F, P0_T_HEAD, P0_T_ALL, ((int)blockIdx.x - ncomp) * NWAVES + F.wave, (F.G - ncomp) * NWAVES);
            asm volatile("s_waitcnt vmcnt(0)" ::: "memory"); __syncthreads();
            if (F.tid == 0) { __builtin_amdgcn_fence(__ATOMIC_RELEASE, "agent"); asm volatile("s_waitcnt vmcnt(0)" ::: "memory"); (void)xb_add(F.ctl + CW_SFLAG, 1u); }
        }
        if (CONV_MODE == 0 || (CONV_MODE == 1 && !is_comp) || (CONV_MODE == 2 && is_comp)) { if (CONV_COOP && MOE_FP8) convert_coop(F); else convert_queue(F); }
        xcd_barrier(bar);
    }
    if (IN(6)) { p6_norm_router(F); } SEAM(6);
    if (IN(7)) { REP(7, p7_gu(F)); p7_gu(F); } SEAM(7);
    if (IN(8)) { REP(8, p8_down(F)); p8_down(F); } SEAM(8);
    if (IN(9)) { REP(9, p9_final(F)); p9_final(F); }
#undef IN
#undef SEAM
}

static void run_opt(void* const* d_in, float* out, unsigned char* ws, hipStream_t stream, int n_launches) {
    static int grid = 0;
    if (grid == 0) {
        int dev = 0, cus = 0;
        if (hipGetDevice(&dev) != hipSuccess || hipDeviceGetAttribute(&cus, hipDeviceAttributeMultiprocessorCount, dev) != hipSuccess) { grid = -1; return; }
        if (hipFuncSetAttribute((const void*)mega_fwd, hipFuncAttributeMaxDynamicSharedMemorySize, LDS_BYTES) != hipSuccess) { grid = -1; return; }
        int per_cu = 0; (void)hipOccupancyMaxActiveBlocksPerMultiprocessor(&per_cu, (const void*)mega_fwd, NWAVES * 64, LDS_BYTES); (void)hipGetLastError();
        grid = cus;
    }
    if (grid < 0) return;
    (void)hipMemsetAsync(ws + WS_CTL, 0, CTL_ZERO_BYTES, stream);
    Args a{};
    for (int i = 0; i < 20; ++i) a.in[i] = d_in[i];
    a.out = out; a.ws = ws;
    (void)n_launches; a.ph_lo = 0; a.ph_hi = PER_PHASE; hipLaunchKernelGGL(mega_fwd, dim3(grid), dim3(NWAVES * 64), LDS_BYTES, stream, a);
}
}

extern "C" void kernel_launch(void* const* d_in, const int* in_sizes, int n_in, void* d_out, int out_size, void* d_ws, size_t ws_size, hipStream_t stream) {
    mk::run_opt(d_in, (float*)d_out, (unsigned char*)d_ws, stream, 1);
}
```

```cpp
#include <hip/hip_runtime.h>
#include <stdint.h>
#include <math.h>
namespace mk {
#define LAS __attribute__((address_space(3)))
#define GAS __attribute__((address_space(1)))
typedef unsigned short bf16_t;
typedef short bf16x8 __attribute__((ext_vector_type(8)));
typedef float f32x4 __attribute__((ext_vector_type(4)));
typedef float f32x2 __attribute__((ext_vector_type(2)));
typedef float f32x16 __attribute__((ext_vector_type(16)));
typedef unsigned u32x4 __attribute__((ext_vector_type(4)));
typedef unsigned u32x2 __attribute__((ext_vector_type(2)));
typedef __bf16 bf16x2_t __attribute__((ext_vector_type(2)));
typedef int i32x4 __attribute__((ext_vector_type(4)));
typedef int i32x8 __attribute__((ext_vector_type(8)));

constexpr int NTOK = 8192, DM = 2048, SEQ = 2048, INW = 8720, NEXP = 32, MODW = 12288;
constexpr float LOG2E = 1.4426950408889634f;
constexpr float QSCALE = 0.125f * LOG2E;

__device__ __forceinline__ unsigned pk2(float lo, float hi) { f32x2 v = {lo, hi}; bf16x2_t b = __builtin_convertvector(v, bf16x2_t); return __builtin_bit_cast(unsigned, b); }
__device__ __forceinline__ float bflo(unsigned u) { return __builtin_bit_cast(float, u << 16); }
__device__ __forceinline__ float bfhi(unsigned u) { return __builtin_bit_cast(float, u & 0xffff0000u); }
__device__ __forceinline__ unsigned pk4_fp8_raw(float a, float b, float c, float d) { int w = 0; w = __builtin_amdgcn_cvt_pk_fp8_f32(a, b, w, false); w = __builtin_amdgcn_cvt_pk_fp8_f32(c, d, w, true); return (unsigned)w; }
__device__ __forceinline__ float sat448(float x) { return __builtin_amdgcn_fmed3f(x, -448.0f, 448.0f); }
__device__ __forceinline__ unsigned pk4_fp8(float a, float b, float c, float d) { return pk4_fp8_raw(a, b, c, d); }
__device__ __forceinline__ i32x8 cat8(bf16x8 lo, bf16x8 hi) { return __builtin_shufflevector(__builtin_bit_cast(i32x4, lo), __builtin_bit_cast(i32x4, hi), 0, 1, 2, 3, 4, 5, 6, 7); }
__device__ __forceinline__ int lane_id() { int l = (int)__builtin_amdgcn_mbcnt_hi(~0u, __builtin_amdgcn_mbcnt_lo(~0u, 0u)); asm volatile("" : "+v"(l)); return l; }
template <int CTRL> __device__ __forceinline__ float dpp_mov(float x) { return __builtin_bit_cast(float, __builtin_amdgcn_update_dpp(0, __builtin_bit_cast(int, x), CTRL, 0xF, 0xF, true)); }
__device__ __forceinline__ float lx1(float x) { return dpp_mov<0xB1>(x); }
__device__ __forceinline__ float lx2(float x) { return dpp_mov<0x4E>(x); }
__device__ __forceinline__ float lx4(float x) { return dpp_mov<0x1B>(dpp_mov<0x141>(x)); }
__device__ __forceinline__ float lx8(float x) { return dpp_mov<0x128>(x); }
__device__ __forceinline__ float lx16(float x, int lane) { const unsigned u = __builtin_bit_cast(unsigned, x); auto rr = __builtin_amdgcn_permlane16_swap(u, u, false, false); return __builtin_bit_cast(float, (lane & 16) ? rr[0] : rr[1]); }
__device__ __forceinline__ float lx32(float x, int lane) { const unsigned u = __builtin_bit_cast(unsigned, x); auto rr = __builtin_amdgcn_permlane32_swap(u, u, false, false); return __builtin_bit_cast(float, (lane & 32) ? rr[0] : rr[1]); }
__device__ __forceinline__ float wave_sum_v(float v) {
    v += lx1(v); v += lx2(v); v += lx4(v); v += lx8(v);
    { const unsigned u = __builtin_bit_cast(unsigned, v); auto rr = __builtin_amdgcn_permlane16_swap(u, u, false, false); v = __builtin_bit_cast(float, rr[0]) + __builtin_bit_cast(float, rr[1]); }
    { const unsigned u = __builtin_bit_cast(unsigned, v); auto rr = __builtin_amdgcn_permlane32_swap(u, u, false, false); v = __builtin_bit_cast(float, rr[0]) + __builtin_bit_cast(float, rr[1]); }
    return v;
}
__device__ __forceinline__ float fast_sigmoid(float x) { return __builtin_amdgcn_rcpf(1.0f + __builtin_amdgcn_exp2f(-x * LOG2E)); }

constexpr int BM = 256, BK = 64, HALF = 128, HTB = HALF * BK * 2, STAGE_BYTES = 8 * HTB, NXCD = 8, WGM = 8;
__host__ __device__ __forceinline__ int lds_byte(int r, int c) { const int st = (r >> 4) * 2 + (c >> 5), rr = r & 15, cc = c & 31, ob = rr * 64 + cc * 2; return st * 1024 + (ob ^ (((ob >> 9) & 1) << 5)); }
__host__ __device__ __forceinline__ void stage_rc(int b, int& R, int& C) { const int st = b / 1024, sb = b % 1024, swz = sb ^ (((sb >> 9) & 1) << 5); R = (st >> 1) * 16 + swz / 64; C = (st & 1) * 32 + (swz % 64) / 2; }
__host__ __device__ __forceinline__ int perm32(int rho) { const int n = rho >> 4, i = rho & 15; return 8 * (i >> 2) + 4 * n + (i & 3); }

struct Unit { int pm, pn, aux; };

template <class Epi, class Sched, bool ALIGN_EPI, bool FP8 = false>
__device__ __forceinline__ void gemm_phase(LAS unsigned char* lds, const Sched& S, const Epi& E, int wid  ) {
    const int lane = lane_id(), tid = wid * 64 + lane, wr = wid >> 2, wc = wid & 3, fr = lane & 15, fq = lane >> 4;
    const int K = S.K, nt = FP8 ? K / (2 * BK) : K / BK;
    int sR[2], sC[2]; unsigned voffB[2];
#pragma unroll
    for (int i = 0; i < 2; ++i) { stage_rc(tid * 16 + i * 8192, sR[i], sC[i]); const int Rb = Epi::PERM ? ((sR[i] & ~31) + perm32(sR[i] & 31)) : sR[i]; voffB[i] = (unsigned)Rb * S.ldb2 + (unsigned)sC[i] * 2u; }
    const size_t kstep = (size_t)(BK * 2);
    const size_t hstepB = (size_t)HALF * S.ldb2;
    const unsigned ldsw = (unsigned)wid * 1024u;
    const int aoff = lds_byte(wr * 64 + fr, fq * 8), boff = lds_byte(wc * 32 + fr, fq * 8);
#define PG8_SA(b, h) (((b) * 2 + (h)) * HTB)
#define PG8_SB(b, h) ((4 + (b) * 2 + (h)) * HTB)
#define PG8_STAGE(bufoff, gbase, voff) do { _Pragma("unroll") for (int _i = 0; _i < 2; ++_i) \
        __builtin_amdgcn_global_load_lds((const unsigned*)((const char*)(gbase) + (voff)[_i]), (LAS unsigned*)(lds + (bufoff) + ldsw + _i * 8192), 16, 0, 0); } while (0)
#define PG8_LDA(dst, b, h) do { _Pragma("unroll") for (int m = 0; m < 4; ++m) { if constexpr (FP8) dst##8[m] = cat8(*(const LAS bf16x8*)(lds + PG8_SA(b, h) + aoff + m * 2048), *(const LAS bf16x8*)(lds + PG8_SA(b, h) + aoff + m * 2048 + 1024)); \
        else { _Pragma("unroll") for (int k = 0; k < 2; ++k) dst[m][k] = *(const LAS bf16x8*)(lds + PG8_SA(b, h) + aoff + m * 2048 + k * 1024); } } } while (0)
#define PG8_LDB(dst, b, h) do { _Pragma("unroll") for (int n = 0; n < 2; ++n) { if constexpr (FP8) dst##8[n] = cat8(*(const LAS bf16x8*)(lds + PG8_SB(b, h) + boff + n * 2048), *(const LAS bf16x8*)(lds + PG8_SB(b, h) + boff + n * 2048 + 1024)); \
        else { _Pragma("unroll") for (int k = 0; k < 2; ++k) dst[n][k] = *(const LAS bf16x8*)(lds + PG8_SB(b, h) + boff + n * 2048 + k * 1024); } } } while (0)
#define PG8_MMA(ai, bj, At, Bt) do { __builtin_amdgcn_s_setprio(1); _Pragma("unroll") for (int m = 0; m < 4; ++m) _Pragma("unroll") for (int n = 0; n < 2; ++n) { \
        if constexpr (FP8) asm volatile("v_mfma_scale_f32_16x16x128_f8f6f4 %0, %1, %2, %0, %3, %3 op_sel_hi:[0,0,0]" : "+v"(acc[ai][bj][m][n]) : "v"(Bt##8[n]), "v"(At##8[m]), "v"(fp8_unit_scale)); \
        else { _Pragma("unroll") for (int k = 0; k < 2; ++k) acc[ai][bj][m][n] = __builtin_amdgcn_mfma_f32_16x16x32_bf16(Bt[n][k], At[m][k], acc[ai][bj][m][n], 0, 0, 0); } } __builtin_amdgcn_s_setprio(0); } while (0)
#define PG8_WAIT_V(n) asm volatile("s_waitcnt vmcnt(" #n ")" ::: "memory")
#define PG8_WAIT_L(n) asm volatile("s_waitcnt lgkmcnt(" #n ")" ::: "memory")
#define PG8_BAR __builtin_amdgcn_s_barrier()
#define PG8_SCHED __builtin_amdgcn_sched_barrier(0)
#define PG8_AOFFS(dst, u, ui) do { _Pragma("unroll") for (int _h = 0; _h < 2; ++_h) _Pragma("unroll") for (int _i = 0; _i < 2; ++_i) dst[_h][_i] = S.a_rowoff(u, ui, sR[_i] + _h * HALF) + (unsigned)sC[_i] * 2u; } while (0)
    Unit cur, nxt; int ui = 0;
    if (!S.next(0, cur)) return;
    int vrows = 256; if constexpr (Sched::RAGGED) vrows = S.rows(cur);
#define PG8_DO0 (!Sched::RAGGED || vrows > 64 || wr == 0)
#define PG8_DO1 (!Sched::RAGGED || vrows > 128)
    f32x4 acc[2][2][4][2];
#pragma unroll
    for (int a = 0; a < 2; ++a)
#pragma unroll
        for (int b = 0; b < 2; ++b)
#pragma unroll
            for (int m = 0; m < 4; ++m)
#pragma unroll
                for (int n = 0; n < 2; ++n) acc[a][b][m][n] = (f32x4){0.f, 0.f, 0.f, 0.f};
    bf16x8 At[4][2], B0[2][2], B1[2][2]; i32x8 At8[4], B08[2], B18[2];
    constexpr bool GA = Sched::GATHER;
    const unsigned fp8_unit_scale = 0x7f7f7f7fu;
    unsigned vAc[2][2], vAn[2][2];
    PG8_AOFFS(vAc, cur, 0);
    const size_t hstepA = GA ? 0 : (size_t)(vAc[1][0] - vAc[0][0]);
#define PG8_H1(v) (GA ? (v)[1] : (v)[0])
    const char* cA = S.a_base(cur); const char* cB = S.b_base(cur);
    PG8_STAGE(PG8_SB(0, 0), cB, voffB); PG8_STAGE(PG8_SB(0, 1), cB + hstepB, voffB); PG8_STAGE(PG8_SA(0, 0), cA, vAc[0]); PG8_STAGE(PG8_SA(0, 1), cA + hstepA, PG8_H1(vAc));
    if (wr == 1) PG8_BAR;
    PG8_WAIT_V(2); PG8_BAR;
    PG8_STAGE(PG8_SB(1, 0), cB + kstep, voffB); PG8_STAGE(PG8_SA(1, 0), cA + kstep, vAc[0]); PG8_STAGE(PG8_SB(1, 1), cB + hstepB + kstep, voffB);
    PG8_WAIT_V(6); PG8_BAR;
    for (;;) {
        const bool has_next = S.next(ui + 1, nxt);
        const char* nA = cA; const char* nB = cB;
        if (has_next) { nA = S.a_base(nxt); nB = S.b_base(nxt); if constexpr (GA) PG8_AOFFS(vAn, nxt, ui + 1); }
        else if constexpr (GA) {
#pragma unroll
            for (int _h = 0; _h < 2; ++_h)
#pragma unroll
                for (int _i = 0; _i < 2; ++_i) vAn[_h][_i] = vAc[_h][_i]; }
        for (int t = 0; t < nt; t += 2) {
            const bool last = (t == nt - 2);
            const char* a1 = cA + (size_t)(t + 1) * kstep;
            const char* a2 = last ? nA : cA + (size_t)(t + 2) * kstep; const char* b2 = last ? nB : cB + (size_t)(t + 2) * kstep;
            const char* a3 = a2 + kstep; const char* b3 = b2 + kstep;
            unsigned vS[2][2];
#pragma unroll
            for (int _h = 0; _h < 2; ++_h)
#pragma unroll
                for (int _i = 0; _i < 2; ++_i) vS[_h][_i] = (GA && last) ? vAn[_h][_i] : vAc[_h][_i];
            PG8_LDB(B0, 0, 0); PG8_LDB(B1, 0, 1); PG8_SCHED; PG8_LDA(At, 0, 0); PG8_STAGE(PG8_SA(1, 1), a1 + hstepA, PG8_H1(vAc));
            PG8_WAIT_V(8); PG8_WAIT_L(0); PG8_BAR; if (PG8_DO0) { PG8_MMA(0, 0, At, B0); PG8_MMA(0, 1, At, B1); } PG8_BAR; PG8_SCHED;
            PG8_LDA(At, 0, 1); PG8_STAGE(PG8_SB(0, 0), b2, voffB); PG8_STAGE(PG8_SB(0, 1), b2 + hstepB, voffB); PG8_STAGE(PG8_SA(0, 0), a2, vS[0]);
            PG8_WAIT_V(8); PG8_WAIT_L(0); PG8_BAR; if (PG8_DO1) { PG8_MMA(1, 0, At, B0); PG8_MMA(1, 1, At, B1); } PG8_BAR; PG8_SCHED;
            PG8_LDB(B0, 1, 0); PG8_LDB(B1, 1, 1); PG8_SCHED; PG8_LDA(At, 1, 0); PG8_STAGE(PG8_SA(0, 1), a2 + hstepA, PG8_H1(vS));
            PG8_WAIT_V(8); PG8_WAIT_L(0); PG8_BAR; if (PG8_DO0) { PG8_MMA(0, 0, At, B0); PG8_MMA(0, 1, At, B1); } PG8_BAR; PG8_SCHED;
            PG8_LDA(At, 1, 1); PG8_STAGE(PG8_SB(1, 0), b3, voffB); PG8_STAGE(PG8_SB(1, 1), b3 + hstepB, voffB); PG8_STAGE(PG8_SA(1, 0), a3, vS[0]);
            PG8_WAIT_V(8); PG8_WAIT_L(0); PG8_BAR; if (PG8_DO1) { PG8_MMA(1, 0, At, B0); PG8_MMA(1, 1, At, B1); } PG8_BAR; PG8_SCHED;
        }
        if constexpr (ALIGN_EPI) { if (wr == 0) PG8_BAR; }
        if constexpr (FP8) asm volatile("s_nop 15\n\ts_nop 15\n\ts_nop 15\n\ts_nop 15" ::: "memory");
        E(acc, cur, wr, wc, fr, fq);
        if (!has_next) break;
#pragma unroll
        for (int a = 0; a < 2; ++a)
#pragma unroll
            for (int b = 0; b < 2; ++b)
#pragma unroll
                for (int m = 0; m < 4; ++m)
#pragma unroll
                    for (int n = 0; n < 2; ++n) acc[a][b][m][n] = (f32x4){0.f, 0.f, 0.f, 0.f};
        cur = nxt; cA = nA; cB = nB; ++ui;
        if constexpr (Sched::RAGGED) vrows = S.rows(cur);
        if constexpr (GA) {
#pragma unroll
        for (int _h = 0; _h < 2; ++_h)
#pragma unroll
            for (int _i = 0; _i < 2; ++_i) vAc[_h][_i] = vAn[_h][_i]; }
        if constexpr (ALIGN_EPI) { if (wr == 1) PG8_BAR; }
    }
    PG8_WAIT_V(0);
    if constexpr (!ALIGN_EPI) { if (wr == 0) PG8_BAR; }
    PG8_BAR;
#undef PG8_SA
#undef PG8_SB
#undef PG8_STAGE
#undef PG8_LDA
#undef PG8_LDB
#undef PG8_MMA
#undef PG8_WAIT_V
#undef PG8_WAIT_L
#undef PG8_BAR
#undef PG8_SCHED
#undef PG8_AOFFS
#undef PG8_DO0
#undef PG8_DO1
#undef PG8_H1
}

#define XB_TMO      128
#define XB_XCNT(j)  (256  + 64 * (j))
#define XB_XSUB(j)  (1280 + 64 * (j))
#define XB_XGEN(j)  (2304 + 64 * (j))
#define XB_TOP      3328
#define XB_TOPGEN   3392
#define XCD_BAR_WORDS 3456
#define XB_SPIN_CAP (1u << 18)
__device__ __forceinline__ unsigned xb_ld(unsigned* p)              { return __hip_atomic_load(p, __ATOMIC_RELAXED, __HIP_MEMORY_SCOPE_AGENT); }
__device__ __forceinline__ unsigned xb_add(unsigned* p, unsigned v) { return __hip_atomic_fetch_add(p, v, __ATOMIC_RELAXED, __HIP_MEMORY_SCOPE_AGENT); }
__device__ __forceinline__ unsigned xb_xcc_id() { return (unsigned)__builtin_amdgcn_s_getreg((3 << 11) | 20) & 0xFu; }
#define XB_SPIN(cond, bar) do { unsigned _sp = 0; while (cond) { __builtin_amdgcn_s_sleep(1); \
    if ((++_sp & 255u) == 0u) { if (xb_ld(&(bar)[XB_TMO])) break; if (_sp > XB_SPIN_CAP) { atomicAdd(&(bar)[XB_TMO], 1u); break; } } } } while (0)
struct XcdBarrier { unsigned* bar; unsigned x; volatile LAS unsigned* st; unsigned total; };
__device__ __forceinline__ XcdBarrier xcd_barrier_post(unsigned* bar, volatile LAS unsigned* st, unsigned total) {
    XcdBarrier b; b.bar = bar; b.x = xb_xcc_id(); b.st = st; b.total = total;
    if (threadIdx.x == 0) (void)xb_add(&bar[XB_XCNT(b.x)], 1u);
    return b;
}
__device__ __forceinline__ void xcd_barrier_complete(unsigned* bar, unsigned x, unsigned G, unsigned& nloc, unsigned& nx) {
    unsigned sum, cnt, mine, sp = 0u;
    for (;;) {
        sum = 0u; cnt = 0u; mine = 0u;
#pragma unroll
        for (unsigned j = 0; j < 16; ++j) { const unsigned c = xb_ld(&bar[XB_XCNT(j)]); sum += c; cnt += (c > 0u) ? 1u : 0u; mine = (j == x) ? c : mine; }
        if (sum == G) break;
        __builtin_amdgcn_s_sleep(1);
        if ((++sp & 255u) == 0u) { if (xb_ld(&bar[XB_TMO])) break; if (sp > XB_SPIN_CAP) { atomicAdd(&bar[XB_TMO], 1u); break; } }
    }
    nloc = mine > 0u ? mine : 1u; nx = cnt > 0u ? cnt : 1u;
}
__device__ __forceinline__ void xcd_barrier(const XcdBarrier& b) {
    asm volatile("s_waitcnt vmcnt(0)" ::: "memory");
    __syncthreads();
    if (threadIdx.x == 0) {
        unsigned* bar = b.bar;
        __builtin_amdgcn_s_waitcnt(0);
        unsigned nloc = b.st[0], nx = b.st[1];
        if (nloc == 0u) { xcd_barrier_complete(bar, b.x, b.total, nloc, nx); b.st[0] = nloc; b.st[1] = nx; }
        const unsigned old = xb_add(&bar[XB_XSUB(b.x)], 1u);
        const unsigned gen = old / nloc;
        if (old + 1u == (gen + 1u) * nloc) {
            __builtin_amdgcn_fence(__ATOMIC_RELEASE, "agent");
            asm volatile("s_waitcnt vmcnt(0)" ::: "memory");
            const unsigned og = xb_add(&bar[XB_TOP], 1u);
            const unsigned tg = og / nx;
            if (og + 1u == (tg + 1u) * nx) xb_add(&bar[XB_TOPGEN], 1u);
            else XB_SPIN(xb_ld(&bar[XB_TOPGEN]) == tg, bar);
            __builtin_amdgcn_fence(__ATOMIC_ACQUIRE, "agent");
            xb_add(&bar[XB_XGEN(b.x)], 1u);
            asm volatile("s_waitcnt vmcnt(0)" ::: "memory");
        } else {
            XB_SPIN(xb_ld(&bar[XB_XGEN(b.x)]) == gen, bar);
            __builtin_amdgcn_fence(__ATOMIC_ACQUIRE, "agent");
            asm volatile("s_waitcnt vmcnt(0)" ::: "memory");
        }
    }
    __syncthreads();
}
}
namespace mk {
constexpr size_t MiB = 1ull << 20;
constexpr size_t WS_CTL = 0, CTL_ZERO_BYTES = 65536;
constexpr size_t WS_MOD = 1 * MiB, WS_COS = 2 * MiB, WS_SIN = 3 * MiB, WS_LOGF = 4 * MiB, WS_CUM = 5 * MiB, WS_TEID = 6 * MiB, WS_TPOS = 6 * MiB + 512 * 1024, WS_TGATE = 7 * MiB, WS_BINP = 7 * MiB + 512 * 1024,
                 WS_TOKOF = 8 * MiB  , WS_XN = 16 * MiB  , WS_WIN = 48 * MiB  , WS_WAB = 84 * MiB  , WS_WOUT = 92 * MiB  , WS_QA = 100 * MiB  , WS_KA = 116 * MiB  ,
                 WS_VA = 120 * MiB  , WS_QB = 124 * MiB  , WS_KB = 140 * MiB, WS_VB = 156 * MiB, WS_SGA = 172 * MiB  , WS_SGB = 204 * MiB  , WS_YAB = 236 * MiB  ,
                 WS_T1 = 268 * MiB  , WS_MERGED = 332 * MiB  , WS_H1 = 364 * MiB  , WS_XN2 = 428 * MiB  , WS_ACT = 460 * MiB  , WS_YS = 620 * MiB  ,
                 WS_WGU = 780 * MiB  , WS_WD = 1292 * MiB  , WS_JUNK = 1548 * MiB  , WS_END = 1580 * MiB;
constexpr int CW_CNT = 1024;
constexpr int CW_BAR = 4096;
constexpr int CW_BAR2 = 8192;
constexpr int CW_CQ = 2048;
constexpr int CW_AQ = 2112;
constexpr int CW_SFLAG = 2560;
#ifndef CONV_MODE
#define CONV_MODE 0
#endif
#ifndef NCOMP_DEF
#define NCOMP_DEF 184
#endif
constexpr int NCOMP = NCOMP_DEF;
constexpr int RING_OFF = 0, RING_BYTES = 131072;
constexpr int TBL_OFF = RING_BYTES;
constexpr int MISC_OFF = TBL_OFF + 10240;
constexpr int LDS_BYTES = 147456;
static_assert(MISC_OFF + 1024 <= LDS_BYTES, "LDS map");
constexpr int NWAVES = 8;
constexpr bool MOE_FP8 = true;
constexpr float WSCALE = 32.0f, WSCALE_INV = 1.0f / 32.0f;
constexpr bool MIX_FP8 = true;
constexpr int MIX_EB = MIX_FP8 ? 1 : 2;
#ifndef P5_FP8_DEF
#define P5_FP8_DEF 1
#endif
constexpr bool P5_FP8 = MIX_FP8 && P5_FP8_DEF;
constexpr int P5_EB = P5_FP8 ? 1 : 2;
constexpr int MOE_EB = MOE_FP8 ? 1 : 2;

struct Frame {
    LAS unsigned char* lds; volatile LAS unsigned* MISC; unsigned* ctl;
    int tid, lane, wave, vcu, G;
    const float *x, *c, *w_ada, *b_ada, *g_mix, *w_in, *b_in, *sinks, *w_a, *w_b, *w_out, *g_ffn, *w_r, *b_r, *w_gu, *b_gu, *w_dn, *b_dn, *g_fin; const int* pos;
    float* out; unsigned char* ws;
};
__device__ __forceinline__ void refresh(Frame& F) { F.lane = lane_id(); F.tid = F.wave * 64 + F.lane; }
template <class T> __device__ __forceinline__ T* wsp(const Frame& F, size_t off) { return (T*)(F.ws + off); }

__device__ __forceinline__ float wave_sum(float v) {
#pragma unroll
    for (int o = 1; o < 64; o <<= 1) v += __shfl_xor(v, o);
    return v;
}

struct DenseSched {
    static constexpr bool GATHER = false, RAGGED = false;
    const char* A; const char* Bt; unsigned lda2, ldb2; int K; int nM, nN, nwg, G, c;
    __device__ __forceinline__ void init(const void* A_, unsigned lda2_, const void* Bt_, unsigned ldb2_, int K_, int M, int N, int G_, int c_) {
        A = (const char*)A_; Bt = (const char*)Bt_; lda2 = lda2_; ldb2 = ldb2_; K = K_; nM = M / BM; nN = N / BM; nwg = nM * nN; G = G_; c = c_; }
    __device__ __forceinline__ bool tile(long L, Unit& u) const {
        if (L >= nwg) return false;
        int wgid = (int)L; { const int q = nwg / NXCD, r = nwg % NXCD, xcd = wgid % NXCD, off = wgid / NXCD; wgid = (xcd < r ? xcd * (q + 1) : r * (q + 1) + (xcd - r) * q) + off; }
        const int nig = WGM * nN, gid = wgid / nig, fm = gid * WGM, gsz = (nM - fm) < WGM ? (nM - fm) : WGM;
        u.pm = fm + ((wgid % nig) % gsz); u.pn = (wgid % nig) / gsz; u.aux = 0; return true; }
    __device__ __forceinline__ bool next(int i, Unit& u) const { return tile((long)i * G + c, u); }
    __device__ __forceinline__ const char* a_base(const Unit& u) const { return A + (size_t)u.pm * BM * lda2; }
    __device__ __forceinline__ unsigned a_rowoff(const Unit&, int, int R) const { return (unsigned)R * lda2; }
    __device__ __forceinline__ const char* b_base(const Unit& u) const { return Bt + (size_t)u.pn * BM * ldb2; }
};
struct BranchSched {
    static constexpr bool GATHER = false, RAGGED = false;
    DenseSched d; unsigned ldb2; int K;
    __device__ __forceinline__ bool next(int i, Unit& u) const { if (!d.tile((long)(i >> 1) * d.G + d.c, u)) return false; u.aux = i & 1; return true; }
    __device__ __forceinline__ const char* a_base(const Unit& u) const { return d.A + (size_t)u.pm * BM * (2048 * MIX_EB) + (size_t)u.aux * (1024 * MIX_EB); }
    __device__ __forceinline__ unsigned a_rowoff(const Unit&, int, int R) const { return (unsigned)R * (2048u * MIX_EB); }
    __device__ __forceinline__ const char* b_base(const Unit& u) const { return d.Bt + ((size_t)u.aux * 2048 + (size_t)u.pn * BM) * (1024 * MIX_EB); }
};
template <bool GATHER_>
struct MoeSched {
    static constexpr bool GATHER = GATHER_, gather = GATHER_, RAGGED = true;
    const volatile LAS unsigned* cnt;
    __device__ __forceinline__ int rows(const Unit& u) const { const int r = (int)cnt[u.aux] - (u.pm - (int)tpre[u.aux]) * 256; return r < 256 ? r : 256; }
    const volatile LAS unsigned* tpre; const LAS unsigned* tbl; const char* A; const char* Bt; int NN; unsigned ldb2; int K; int G, vcu;
    size_t b_estride;
    const volatile LAS unsigned* hpre; const volatile LAS unsigned* lexp; int nlight;
    __device__ __forceinline__ bool next(int i, Unit& u) const {
        const int L = i * G + vcu; const int NH = NN * (int)hpre[32];
        if (L < NH) {
            int e = 0;
            for (int j = 1; j < 32; ++j) if (NN * (int)hpre[j] <= L) e = j;
            const int l = L - NN * (int)hpre[e], T = (int)hpre[e + 1] - (int)hpre[e];
            u.pn = l / T; u.pm = (int)tpre[e] + (l - u.pn * T); u.aux = e; return true; }
        const int l2 = L - NH, j = l2 / NN; if (j >= nlight) return false;
        const int e = (int)lexp[j]; u.pn = l2 - j * NN; u.pm = (int)tpre[e + 1] - 1; u.aux = e; return true; }
    __device__ __forceinline__ const char* a_base(const Unit& u) const { return gather ? A : A + (size_t)u.pm * BM * (2048 * MOE_EB); }
    __device__ __forceinline__ unsigned a_rowoff(const Unit&, int ui, int R) const { return gather ? tbl[ui * 256 + R] : (unsigned)R * (2048u * MOE_EB); }
    __device__ __forceinline__ const char* b_base(const Unit& u) const { return Bt + (size_t)u.aux * b_estride + (size_t)u.pn * BM * ldb2; }
};

__device__ __forceinline__ void st8bf(bf16_t* p, f32x4 a, f32x4 b) { u32x4 w; w.x = pk2(a[0], a[1]); w.y = pk2(a[2], a[3]); w.z = pk2(b[0], b[1]); w.w = pk2(b[2], b[3]); *(u32x4*)p = w; }
struct EpiInProj {
    static constexpr bool PERM = true;
    bf16_t *QA, *KA, *VA, *QB, *KB, *VB, *SGA, *SGB; const float* bias; const float* cosT; const float* sinT;
    __device__ __forceinline__ void operator()(const f32x4 (&acc)[2][2][4][2], const Unit& u, int wr, int wc, int fr, int fq) const {
        const int pn = u.pn, row0 = u.pm * BM + wr * 64 + fr, cw = wc * 32 + 8 * fq;
        const float ws = MIX_FP8 ? WSCALE_INV : 1.0f;
        f32x4 bv[2][2];
#pragma unroll
        for (int bj = 0; bj < 2; ++bj)
#pragma unroll
            for (int n = 0; n < 2; ++n) bv[bj][n] = *(const f32x4*)(bias + pn * 256 + bj * 128 + cw + 4 * n);
        if (pn < 5) {
            bf16_t* O = pn < 4 ? QA : KA; const int ldo = pn < 4 ? 1024 : 256; const int hcol = (pn < 4 ? pn * 256 : 0) + wc * 64 + 8 * fq; const float qs = pn < 4 ? QSCALE : 1.0f;
#pragma unroll
            for (int ai = 0; ai < 2; ++ai)
#pragma unroll
                for (int m = 0; m < 4; ++m) { const int row = row0 + ai * HALF + m * 16;
                    f32x4 o1[2], o2[2];
#pragma unroll
                    for (int n = 0; n < 2; ++n) { const f32x4 cs = *(const f32x4*)(cosT + (size_t)row * 32 + 8 * fq + 4 * n), sn = *(const f32x4*)(sinT + (size_t)row * 32 + 8 * fq + 4 * n);
                        const f32x4 x1 = acc[ai][0][m][n] * ws + bv[0][n], x2 = acc[ai][1][m][n] * ws + bv[1][n];
                        o1[n] = (x1 * cs - x2 * sn) * qs; o2[n] = (x2 * cs + x1 * sn) * qs; }
                    bf16_t* rp = O + (size_t)row * ldo + hcol; st8bf(rp, o1[0], o1[1]); st8bf(rp + 32, o2[0], o2[1]); }
        } else if (pn < 18) {
            bf16_t* O; int ldo, col0; float sc = 1.0f;
            if (pn == 5) { O = VA; ldo = 256; col0 = 0; } else if (pn < 10) { O = QB; ldo = 1024; col0 = (pn - 6) * 256; sc = QSCALE; } else if (pn < 14) { O = KB; ldo = 1024; col0 = (pn - 10) * 256; } else { O = VB; ldo = 1024; col0 = (pn - 14) * 256; }
#pragma unroll
            for (int ai = 0; ai < 2; ++ai)
#pragma unroll
                for (int m = 0; m < 4; ++m) { bf16_t* rp = O + (size_t)(row0 + ai * HALF + m * 16) * ldo + col0 + cw;
#pragma unroll
                    for (int bj = 0; bj < 2; ++bj) st8bf(rp + bj * HALF, (acc[ai][bj][m][0] * ws + bv[bj][0]) * sc, (acc[ai][bj][m][1] * ws + bv[bj][1]) * sc); }
        } else {
            bf16_t* O = pn < 26 ? SGA : SGB; const int col0 = ((pn - 18) & 7) * 256;
#pragma unroll
            for (int ai = 0; ai < 2; ++ai)
#pragma unroll
                for (int m = 0; m < 4; ++m) { bf16_t* rp = O + (size_t)(row0 + ai * HALF + m * 16) * 2048 + col0 + cw;
#pragma unroll
                    for (int bj = 0; bj < 2; ++bj) { f32x4 a = acc[ai][bj][m][0] * ws + bv[bj][0], b = acc[ai][bj][m][1] * ws + bv[bj][1];
#pragma unroll
                        for (int j = 0; j < 4; ++j) { a[j] = fast_sigmoid(a[j]); b[j] = fast_sigmoid(b[j]); }
                        st8bf(rp + bj * HALF, a, b); } }
        }
    }
};
struct EpiBranch {
    static constexpr bool PERM = true;
    const bf16_t *SGA, *SGB; float* T1; unsigned char* MERGED;
    __device__ __forceinline__ void operator()(const f32x4 (&acc)[2][2][4][2], const Unit& u, int wr, int wc, int fr, int fq) const {
        const int row0 = u.pm * BM + wr * 64 + fr, col0 = u.pn * BM + wc * 32 + 8 * fq;
        const bf16_t* SG = u.aux ? SGB : SGA;
#pragma unroll
        for (int ai = 0; ai < 2; ++ai)
#pragma unroll
            for (int m = 0; m < 4; ++m) { const size_t off = (size_t)(row0 + ai * HALF + m * 16) * 2048 + col0;
#pragma unroll
                for (int bj = 0; bj < 2; ++bj) { const u32x4 g = *(const u32x4*)(SG + off + bj * HALF);
                    const f32x4 g0 = {bflo(g.x), bfhi(g.x), bflo(g.y), bfhi(g.y)}, g1 = {bflo(g.z), bfhi(g.z), bflo(g.w), bfhi(g.w)};
                    const float ws = MIX_FP8 ? WSCALE_INV : 1.0f;
                    f32x4 a = acc[ai][bj][m][0] * g0 * ws, b = acc[ai][bj][m][1] * g1 * ws;
                    bf16_t* tp = (bf16_t*)T1 + off + bj * HALF;
                    if (u.aux == 0) { st8bf(tp, a, b); }
                    else { const u32x4 t = *(const u32x4*)tp; a += (f32x4){bflo(t.x), bfhi(t.x), bflo(t.y), bfhi(t.y)}; b += (f32x4){bflo(t.z), bfhi(t.z), bflo(t.w), bfhi(t.w)};
                        if constexpr (P5_FP8) { u32x2 w; w.x = pk4_fp8(a[0], a[1], a[2], a[3]); w.y = pk4_fp8(b[0], b[1], b[2], b[3]); *(u32x2*)(MERGED + off + bj * HALF) = w; }
                        else st8bf((bf16_t*)MERGED + off + bj * HALF, a, b); } } }
    }
};
struct EpiOut {
    static constexpr bool PERM = false;
    const float* x; const float* mod; float* H1;
    __device__ __forceinline__ void operator()(const f32x4 (&acc)[2][2][4][2], const Unit& u, int wr, int wc, int fr, int fq) const {
        const int row0 = u.pm * BM + wr * 64 + fr, col0 = u.pn * BM + wc * 32 + 4 * fq; const float* gt = mod + (size_t)(u.pm >> 3) * MODW + 4096;
#pragma unroll
        for (int bj = 0; bj < 2; ++bj)
#pragma unroll
            for (int n = 0; n < 2; ++n) { const int col = col0 + bj * HALF + n * 16; const f32x4 g = *(const f32x4*)(gt + col);
#pragma unroll
                for (int ai = 0; ai < 2; ++ai)
#pragma unroll
                    for (int m = 0; m < 4; ++m) { const size_t off = (size_t)(row0 + ai * HALF + m * 16) * 2048 + col; *(f32x4*)(H1 + off) = *(const f32x4*)(x + off) + g * (acc[ai][bj][m][n] * (P5_FP8 ? WSCALE_INV : 1.0f)); } }
    }
};
struct EpiGU {
    static constexpr bool PERM = true;
    const float* b_gu; unsigned char* ACT;
    __device__ __forceinline__ void operator()(const f32x4 (&acc)[2][2][4][2], const Unit& u, int wr, int wc, int fr, int fq) const {
        const int row0 = u.pm * BM + wr * 64 + fr, cw = wc * 32 + 8 * fq; const float* bg = b_gu + (size_t)u.aux * 4096 + u.pn * 128 + cw;
        const float ws = MOE_FP8 ? WSCALE_INV : 1.0f;
        f32x4 bv[2][2];
#pragma unroll
        for (int bj = 0; bj < 2; ++bj)
#pragma unroll
            for (int n = 0; n < 2; ++n) bv[bj][n] = *(const f32x4*)(bg + bj * 2048 + 4 * n);
#pragma unroll
        for (int ai = 0; ai < 2; ++ai)
#pragma unroll
            for (int m = 0; m < 4; ++m) { f32x4 o[2];
#pragma unroll
                for (int n = 0; n < 2; ++n) { const f32x4 g = acc[ai][0][m][n] * ws + bv[0][n], l = acc[ai][1][m][n] * ws + bv[1][n];
#pragma unroll
                    for (int j = 0; j < 4; ++j) { const float gg = fminf(g[j], 7.0f), ll = fminf(fmaxf(l[j], -7.0f), 7.0f);
                        o[n][j] = gg * (ll + 1.0f) * __builtin_amdgcn_rcpf(1.0f + __builtin_amdgcn_exp2f(-1.702f * LOG2E * gg)); } }
                const size_t eo = (size_t)(row0 + ai * HALF + m * 16) * 2048 + u.pn * 128 + cw;
                if constexpr (MOE_FP8) { u32x2 w; w.x = pk4_fp8(o[0][0], o[0][1], o[0][2], o[0][3]); w.y = pk4_fp8(o[1][0], o[1][1], o[1][2], o[1][3]); *(u32x2*)(ACT + eo) = w; }
                else st8bf((bf16_t*)ACT + eo, o[0], o[1]); }
    }
};
struct EpiDown {
    static constexpr bool PERM = true;
    const float* b_dn; bf16_t* YS;
    __device__ __forceinline__ void operator()(const f32x4 (&acc)[2][2][4][2], const Unit& u, int wr, int wc, int fr, int fq) const {
        const int row0 = u.pm * BM + wr * 64 + fr, col0 = u.pn * BM + wc * 32 + 8 * fq; const float* bd = b_dn + (size_t)u.aux * 2048 + col0;
        const float ws = MOE_FP8 ? WSCALE_INV : 1.0f;
        f32x4 bv[2][2];
#pragma unroll
        for (int bj = 0; bj < 2; ++bj)
#pragma unroll
            for (int n = 0; n < 2; ++n) bv[bj][n] = *(const f32x4*)(bd + bj * HALF + 4 * n);
#pragma unroll
        for (int ai = 0; ai < 2; ++ai)
#pragma unroll
            for (int m = 0; m < 4; ++m) { bf16_t* rp = YS + (size_t)(row0 + ai * HALF + m * 16) * 2048 + col0;
#pragma unroll
                for (int bj = 0; bj < 2; ++bj) st8bf(rp + bj * HALF, acc[ai][bj][m][0] * ws + bv[bj][0], acc[ai][bj][m][1] * ws + bv[bj][1]); }
    }
};

__device__ __forceinline__ int in_src(int r) { const int pn = r >> 8, c = r & 255; if (pn < 5) return pn * 256 + ((c & 127) >> 5) * 64 + (c >> 7) * 32 + (c & 31); return pn < 18 ? r : r + 16; }
__device__ __forceinline__ void transpose_item(const float* __restrict__ W, size_t ldw, int k0, int src0, int src1, bf16_t* __restrict__ WT, size_t ldk, int dst0, LAS unsigned* scr, int lane) {
    const int lg = lane >> 4, lc = lane & 15;
    const int scol = (lc < 8 ? src0 : src1 - 32) + 4 * lc;
    f32x4 v[8][2];
#pragma unroll
    for (int i = 0; i < 8; ++i)
#pragma unroll
        for (int p = 0; p < 2; ++p) v[i][p] = *(const f32x4*)(W + (size_t)(k0 + 8 * i + 2 * lg + p) * ldw + scol);
#pragma unroll
    for (int i = 0; i < 8; ++i)
#pragma unroll
        for (int c = 0; c < 4; ++c) scr[(4 * lc + c) * 33 + 4 * i + lg] = pk2(v[i][0][c], v[i][1][c]);
    asm volatile("s_waitcnt lgkmcnt(0)" ::: "memory");
    const int rn = lane >> 3, ch = lane & 7;
#pragma unroll
    for (int j = 0; j < 8; ++j) { const int n = rn + 8 * j; const LAS unsigned* s = scr + n * 33 + 4 * ch; u32x4 o; o.x = s[0]; o.y = s[1]; o.z = s[2]; o.w = s[3];
        *(u32x4*)(WT + (size_t)(dst0 + n) * ldk + k0 + 8 * ch) = o; }
    asm volatile("s_waitcnt lgkmcnt(0)" ::: "memory");
}
__device__ __forceinline__ void transpose_item_f8(const float* __restrict__ W, size_t ldw, int k0, int src0, int src1, unsigned char* __restrict__ WT, size_t ldk, int dst0, LAS unsigned* scr, int lane, float scale) {
    const int lg = lane >> 4, lc = lane & 15;
    const float* wp = W + (size_t)(k0 + 4 * lg) * ldw + (lc < 8 ? src0 : src1 - 32) + 4 * lc;
#pragma unroll
    for (int hf = 0; hf < 2; ++hf) {
        f32x4 v[4][4];
#pragma unroll
        for (int i = 0; i < 4; ++i)
#pragma unroll
            for (int p = 0; p < 4; ++p) v[i][p] = *(const f32x4*)(wp + (size_t)(64 * hf + 16 * i + p) * ldw);
#pragma unroll
        for (int i = 0; i < 4; ++i)
#pragma unroll
            for (int c = 0; c < 4; ++c) scr[(4 * lc + c) * 33 + 16 * hf + 4 * i + lg] = pk4_fp8_raw(v[i][0][c] * scale, v[i][1][c] * scale, v[i][2][c] * scale, v[i][3][c] * scale);
    }
    asm volatile("s_waitcnt lgkmcnt(0)" ::: "memory");
    const int rn = lane >> 3, ch = lane & 7;
#pragma unroll
    for (int j = 0; j < 8; ++j) { const int n = rn + 8 * j; const LAS unsigned* s = scr + n * 33 + 4 * ch; u32x4 o; o.x = s[0]; o.y = s[1]; o.z = s[2]; o.w = s[3];
        *(u32x4*)(WT + (size_t)(dst0 + n) * ldk + k0 + 16 * ch) = o; }
    asm volatile("s_waitcnt lgkmcnt(0)" ::: "memory");
}
constexpr int P0_KD = MIX_FP8 ? 128 : 64;
constexpr int P0_T_HEAD = 768 + 256 + 1, P0_T_ALL = P0_T_HEAD + (2048 / P0_KD) * 136 + 2 * (1024 / P0_KD) * 32 + (2048 / P0_KD) * 32;
__device__ __forceinline__ void p0_prologue(Frame& F, const int t_lo, const int t_hi, const int gw_, const int NGW_) {
    refresh(F);
    LAS unsigned* scr = (LAS unsigned*)(F.lds + RING_OFF + F.wave * 8448);
    LAS f32x4* ca = (LAS f32x4*)(F.lds + RING_OFF + 69632);
    for (int k = F.tid; k < 2048; k += NWAVES * 64) { f32x4 v;
#pragma unroll
        for (int b = 0; b < 4; ++b) { const float cv = F.c[b * 2048 + k]; v[b] = cv / (1.0f + expf(-cv)); }
        ca[k] = v; }
    __syncthreads();
    const int gw = gw_, NGW = NGW_, lane = F.lane;
    constexpr int KD = P0_KD;
    constexpr int T_ADA = 768, T_ROPE = 256, T_BIAS = 1, T_WIN = (2048 / KD) * 136, T_WA = (1024 / KD) * 32, T_WB = (1024 / KD) * 32, T_WOUT = (2048 / KD) * 32;
    constexpr int NT = T_ADA + T_ROPE + T_BIAS + T_WIN + T_WA + T_WB + T_WOUT;
    static_assert(NT == P0_T_ALL && T_ADA + T_ROPE + T_BIAS == P0_T_HEAD, "prologue task list");
    float* mod = wsp<float>(F, WS_MOD); float* cosT = wsp<float>(F, WS_COS); float* sinT = wsp<float>(F, WS_SIN); float* binp = wsp<float>(F, WS_BINP);
    for (int it = t_lo + gw; it < t_hi; it += NGW) {
        int r = it;
        if (r < T_ADA) {
            const int j0 = 16 * r, cl = lane & 3, kr = lane >> 2;
            f32x4 a[4];
#pragma unroll
            for (int b = 0; b < 4; ++b) a[b] = (f32x4){0.f, 0.f, 0.f, 0.f};
            const float* wp = F.w_ada + (size_t)kr * MODW + j0 + 4 * cl;
#pragma unroll 8
            for (int s = 0; s < 128; ++s) { const f32x4 w4 = *(const f32x4*)(wp + (size_t)s * 16 * MODW); const f32x4 c4 = ca[16 * s + kr];
#pragma unroll
                for (int b = 0; b < 4; ++b) a[b] += w4 * c4[b]; }
#pragma unroll
            for (int b = 0; b < 4; ++b)
#pragma unroll
                for (int c = 0; c < 4; ++c) { float v = a[b][c]; v += __shfl_xor(v, 4); v += __shfl_xor(v, 8); v += __shfl_xor(v, 16); v += __shfl_xor(v, 32); a[b][c] = v; }
            if (kr == 0) { const f32x4 bb = *(const f32x4*)(F.b_ada + j0 + 4 * cl);
#pragma unroll
                for (int b = 0; b < 4; ++b) *(f32x4*)(mod + b * MODW + j0 + 4 * cl) = a[b] + bb; }
            continue; } r -= T_ADA;
        if (r < T_ROPE) {
            const int i = lane & 31, ts = lane >> 5; const float inv = 1.0f / powf(10000.0f, (float)(2 * i) / 64.0f);
            for (int j = 0; j < 16; ++j) { const int t = 32 * r + 2 * j + ts; const float ang = (float)F.pos[t] * inv; cosT[t * 32 + i] = cosf(ang); sinT[t * 32 + i] = sinf(ang); }
            continue; } r -= T_ROPE;
        if (r < T_BIAS) { for (int q = lane; q < 8704; q += 64) binp[q] = F.b_in[in_src(q)]; continue; } r -= T_BIAS;
        const float* W; size_t ldw; int kb, nb, s0, s1; unsigned char* WT; size_t ldk;
        if (r < T_WIN) { kb = r / 136; nb = r % 136; W = F.w_in; ldw = INW; s0 = in_src(64 * nb); s1 = in_src(64 * nb + 32); WT = wsp<unsigned char>(F, WS_WIN); ldk = 2048; }
        else if ((r -= T_WIN) < T_WA) { kb = r / 32; nb = r % 32; W = F.w_a; ldw = 2048; s0 = 64 * nb; s1 = s0 + 32; WT = wsp<unsigned char>(F, WS_WAB); ldk = 1024; }
        else if ((r -= T_WA) < T_WB) { kb = r / 32; nb = r % 32; W = F.w_b; ldw = 2048; s0 = 64 * nb; s1 = s0 + 32; WT = wsp<unsigned char>(F, WS_WAB) + (size_t)2048 * 1024 * MIX_EB; ldk = 1024; }
        else { r -= T_WB; W = F.w_out; ldw = 2048; WT = wsp<unsigned char>(F, WS_WOUT); ldk = 2048;
            if constexpr (MIX_FP8 && !P5_FP8) { kb = r / 32; nb = r % 32; s0 = 64 * nb; s1 = s0 + 32;
                transpose_item(W, ldw, 128 * kb, s0, s1, (bf16_t*)WT, ldk, 64 * nb, scr, lane); transpose_item(W, ldw, 128 * kb + 64, s0, s1, (bf16_t*)WT, ldk, 64 * nb, scr, lane); continue; }
            kb = r / 32; nb = r % 32; s0 = 64 * nb; s1 = s0 + 32; }
        if constexpr (MIX_FP8) transpose_item_f8(W, ldw, 128 * kb, s0, s1, WT, ldk, 64 * nb, scr, lane, WSCALE);
        else transpose_item(W, ldw, 64 * kb, s0, s1, (bf16_t*)WT, ldk, 64 * nb, scr, lane);
    }
}
constexpr int T_WGU = MOE_FP8 ? 32 * 16 * 64 : 32 * 32 * 64, T_WD = MOE_FP8 ? 32 * 16 * 32 : 32 * 32 * 32;
__device__ __forceinline__ void convert_item(Frame& F, int r, LAS unsigned* scr, int lane) {
    if (r < T_WGU) {
        if constexpr (MOE_FP8) { const int e = r >> 10, q = r & 1023, kb = q >> 6, nb = q & 63; const int r0 = 64 * nb, src = ((r0 & 255) >> 7) * 2048 + (r0 >> 8) * 128 + (r0 & 127);
            transpose_item_f8(F.w_gu + (size_t)e * 2048 * 4096, 4096, 128 * kb, src, src + 32, wsp<unsigned char>(F, WS_WGU) + (size_t)e * 4096 * 2048, 2048, r0, scr, lane, WSCALE); }
        else { const int e = r >> 11, q = r & 2047, kb = q >> 6, nb = q & 63; const int r0 = 64 * nb, src = ((r0 & 255) >> 7) * 2048 + (r0 >> 8) * 128 + (r0 & 127);
            transpose_item(F.w_gu + (size_t)e * 2048 * 4096, 4096, 64 * kb, src, src + 32, wsp<bf16_t>(F, WS_WGU) + (size_t)e * 4096 * 2048, 2048, r0, scr, lane); }
        return; }
    r -= T_WGU;
    if constexpr (MOE_FP8) { const int e = r >> 9, q = r & 511, kb = q >> 5, nb = q & 31;
        transpose_item_f8(F.w_dn + (size_t)e * 2048 * 2048, 2048, 128 * kb, 64 * nb, 64 * nb + 32, wsp<unsigned char>(F, WS_WD) + (size_t)e * 2048 * 2048, 2048, 64 * nb, scr, lane, WSCALE); }
    else { const int e = r >> 10, q = r & 1023, kb = q >> 5, nb = q & 31;
        transpose_item(F.w_dn + (size_t)e * 2048 * 2048, 2048, 64 * kb, 64 * nb, 64 * nb + 32, wsp<bf16_t>(F, WS_WD) + (size_t)e * 2048 * 2048, 2048, 64 * nb, scr, lane); }
}
struct CvItem { const char* src; unsigned char* dst; };
template <bool GU> __device__ __forceinline__ CvItem cv_decode(Frame& F, int r) {
    constexpr int N = GU ? T_WGU : T_WD; constexpr size_t ldw = GU ? 4096 : 2048;
    r = r < N ? r : 0;
    const int e = r >> (GU ? 10 : 9), q = r & (GU ? 1023 : 511), kb = q >> (GU ? 6 : 5), nb = q & (GU ? 63 : 31), r0 = 64 * nb;
    const int srcc = GU ? ((r0 & 255) >> 7) * 2048 + (r0 >> 8) * 128 + (r0 & 127) : r0;
    CvItem P;
    P.src = (const char*)((GU ? F.w_gu : F.w_dn) + (size_t)e * 2048 * ldw + (size_t)(128 * kb) * ldw + srcc);
    P.dst = (GU ? wsp<unsigned char>(F, WS_WGU) : wsp<unsigned char>(F, WS_WD)) + (size_t)e * ldw * 2048 + (size_t)r0 * 2048 + 128 * kb;
    return P;
}
template <bool GU> __device__ __forceinline__ void convert_loop(Frame& F, unsigned* head) {
    constexpr int N = GU ? T_WGU : T_WD, NP = (N + 2) / 3 * 3; constexpr unsigned ldwb = (GU ? 4096u : 2048u) * 4u;
    LAS unsigned* scr = (LAS unsigned*)(F.lds + RING_OFF + F.wave * 8448);
    const int lane = F.lane, lg = lane >> 4, lc = lane & 15, rn = lane >> 3, ch = lane & 7;
    const unsigned lo = (unsigned)(4 * lg) * ldwb + 16u * (unsigned)lc;
    f32x4 A[4][4], B[4][4], C[4][4];
#define CV_LOAD(buf, P, h) do { _Pragma("unroll") for (int i = 0; i < 4; ++i) _Pragma("unroll") for (int p = 0; p < 4; ++p) { const char* rb_ = (P).src + (size_t)(64 * (h) + 16 * i + p) * ldwb; \
        asm volatile("global_load_dwordx4 %0, %1, %2 nt" : "=v"(buf[i][p]) : "v"(lo), "s"(rb_) : "memory"); } } while (0)
#define CV_WAIT(N, buf) do { asm volatile("s_waitcnt vmcnt(" #N ")" ::: "memory"); _Pragma("unroll") for (int i = 0; i < 4; ++i) asm volatile("" : "+v"(buf[i][0]), "+v"(buf[i][1]), "+v"(buf[i][2]), "+v"(buf[i][3])); } while (0)
#define CV_PROC(buf, h) do { _Pragma("unroll") for (int i = 0; i < 4; ++i) _Pragma("unroll") for (int c = 0; c < 4; ++c) \
        scr[(4 * lc + c) * 33 + 16 * (h) + 4 * i + lg] = pk4_fp8_raw(buf[i][0][c] * WSCALE, buf[i][1][c] * WSCALE, buf[i][2][c] * WSCALE, buf[i][3][c] * WSCALE); } while (0)
#define CV_STORE(P) do { _Pragma("unroll") for (int j = 0; j < 8; ++j) { const LAS unsigned* s_ = scr + (rn + 8 * j) * 33 + 4 * ch; u32x4 o_; o_.x = s_[0]; o_.y = s_[1]; o_.z = s_[2]; o_.w = s_[3]; \
        const unsigned so_ = (unsigned)(rn + 8 * j) * 2048u + 16u * (unsigned)ch; asm volatile("global_store_dwordx4 %0, %1, %2 nt" :: "v"(so_), "v"(o_), "s"((P).dst) : "memory"); } } while (0)
    const unsigned claim_add = 3u, claim_off = 0u; unsigned long long ex_save;
#define CV_CLAIM() asm volatile("s_mov_b64 %1, exec\n\ts_mov_b64 exec, 1\n\tglobal_atomic_add %0, %2, %3, %4 sc0\n\ts_mov_b64 exec, %1" : "+v"(raw), "=&s"(ex_save) : "v"(claim_off), "v"(claim_add), "s"(head) : "memory")
    unsigned raw = 0u;
    CV_CLAIM();
    asm volatile("s_waitcnt vmcnt(0)" : "+v"(raw) :: "memory");
    int base = (int)__builtin_amdgcn_readfirstlane(raw);
    CV_CLAIM();
    CvItem P0 = cv_decode<GU>(F, base), P1, P2;
    CV_LOAD(A, P0, 0); CV_LOAD(B, P0, 1);
    {
      unsigned char* junk = wsp<unsigned char>(F, WS_JUNK) + (size_t)(blockIdx.x * NWAVES + F.wave) * 16384; const u32x4 zz_ = {0u, 0u, 0u, 0u};
#pragma unroll
      for (int j = 0; j < 8; ++j) { const unsigned so_ = (unsigned)(rn + 8 * j) * 128u + 16u * (unsigned)ch; asm volatile("global_store_dwordx4 %0, %1, %2 nt" :: "v"(so_), "v"(zz_), "s"(junk) : "memory"); } }
    while (base < NP) {
        P1 = cv_decode<GU>(F, base + 1); P2 = cv_decode<GU>(F, base + 2);
        CV_LOAD(C, P1, 0); CV_WAIT(40, A); CV_PROC(A, 0);
        CV_LOAD(A, P1, 1); CV_WAIT(40, B); CV_PROC(B, 1); CV_STORE(P0);
        CV_LOAD(B, P2, 0); CV_WAIT(40, C); CV_PROC(C, 0);
        CV_LOAD(C, P2, 1); CV_WAIT(40, A); CV_PROC(A, 1); CV_STORE(P1);
        asm volatile("s_waitcnt vmcnt(48)" : "+v"(raw) :: "memory");
        base = (int)__builtin_amdgcn_readfirstlane(raw);
        CV_CLAIM();
        P0 = cv_decode<GU>(F, base);
        CV_LOAD(A, P0, 0); CV_WAIT(41, B); CV_PROC(B, 0);
        CV_LOAD(B, P0, 1); CV_WAIT(41, C); CV_PROC(C, 1); CV_STORE(P2);
    }
#undef CV_WAIT
    asm volatile("s_waitcnt vmcnt(0)" ::: "memory");
#undef CV_CLAIM
#undef CV_LOAD
#undef CV_PROC
#undef CV_STORE
}
__device__ __forceinline__ void convert_queue(Frame& F) {
    refresh(F);
    __syncthreads();
    if constexpr (!MOE_FP8) {
        LAS unsigned* scr0 = (LAS unsigned*)(F.lds + RING_OFF + F.wave * 8448); unsigned* head0 = F.ctl + CW_CQ; constexpr int NQ0 = T_WGU + T_WD;
        for (;;) { unsigned raw0 = 0u; if (F.lane == 0) raw0 = __hip_atomic_fetch_add(head0, 1u, __ATOMIC_RELAXED, __HIP_MEMORY_SCOPE_AGENT); const int it = (int)__builtin_amdgcn_readfirstlane(raw0); if (it >= NQ0) break; convert_item(F, it, scr0, F.lane); }
        __syncthreads(); return; }
    convert_loop<true>(F, F.ctl + CW_CQ);
    convert_loop<false>(F, F.ctl + CW_CQ + 128);
    __syncthreads();
}


constexpr int CS_GU = 32 * 8 * 16, CS_DN = 32 * 8 * 8, CS_N = CS_GU + CS_DN, CS_PITCH = 65;
__device__ __forceinline__ void convert_coop(Frame& F) {
    refresh(F);
    __syncthreads();
    LAS unsigned* tile0 = (LAS unsigned*)(F.lds + RING_OFF);
    unsigned* head = F.ctl + CW_CQ + 256;
    const int lane = F.lane, w = F.wave;
    if (F.tid == 0) F.MISC[104] = __hip_atomic_fetch_add(head, 1u, __ATOMIC_RELAXED, __HIP_MEMORY_SCOPE_AGENT);
    __syncthreads();
    int slot = 0, p = 0;
    for (;;) {
        const int it = (int)F.MISC[104 + slot];
        if (it >= CS_N) break;
        if (F.tid == 0) F.MISC[104 + (slot ^ 1)] = __hip_atomic_fetch_add(head, 1u, __ATOMIC_RELAXED, __HIP_MEMORY_SCOPE_AGENT);
        const bool gu = it < CS_GU; const int r = gu ? it : it - CS_GU;
        const int e = gu ? (r >> 7) : (r >> 6), q = gu ? (r & 127) : (r & 63), kb = gu ? (q >> 4) : (q >> 3), nb = gu ? (q & 15) : (q & 7);
        const size_t ldw = gu ? 4096 : 2048;
        const float* W = (gu ? F.w_gu : F.w_dn) + (size_t)e * 2048 * ldw + (size_t)(256 * kb + 32 * w) * ldw;
        const int scol = gu ? ((lane >> 5) * 2048 + nb * 128 + 4 * (lane & 31)) : (nb * 256 + 4 * lane);
        unsigned char* O = (gu ? wsp<unsigned char>(F, WS_WGU) : wsp<unsigned char>(F, WS_WD)) + (size_t)e * ldw * 2048 + (size_t)(256 * nb) * 2048 + 256 * kb;
        LAS unsigned* T = tile0 + p * (256 * CS_PITCH);
        f32x4 v[32];
#pragma unroll
        for (int i = 0; i < 32; ++i) v[i] = __builtin_nontemporal_load((const f32x4*)(W + (size_t)i * ldw + scol));
#pragma unroll
        for (int kk = 0; kk < 8; ++kk)
#pragma unroll
            for (int c = 0; c < 4; ++c) T[(4 * lane + c) * CS_PITCH + 8 * w + kk] = pk4_fp8_raw(v[4 * kk][c] * WSCALE, v[4 * kk + 1][c] * WSCALE, v[4 * kk + 2][c] * WSCALE, v[4 * kk + 3][c] * WSCALE);
        __syncthreads();
#pragma unroll
        for (int i = 0; i < 8; ++i) { const int n = 32 * w + 4 * i + (lane >> 4), ch = lane & 15; const LAS unsigned* s_ = T + n * CS_PITCH + 4 * ch; u32x4 o; o.x = s_[0]; o.y = s_[1]; o.z = s_[2]; o.w = s_[3];
            __builtin_nontemporal_store(o, (u32x4*)(O + (size_t)n * 2048 + 16 * ch)); }
        slot ^= 1; p ^= 1;
    }
    __syncthreads();
}

__device__ __forceinline__ void p1_norm_fb(Frame& F) {
    refresh(F);
#pragma unroll 1
    for (int i0 = F.tid; i0 < 2048 * 4; i0 += 8 * NWAVES * 64) {
        f32x4 v[8];
#pragma unroll
        for (int u = 0; u < 8; ++u) { const int i = i0 + u * NWAVES * 64, k = i >> 2, q = i & 3; v[u] = *(const f32x4*)(F.w_in + (size_t)k * INW + 4608 + 4 * q); }
#pragma unroll
        for (int u = 0; u < 8; ++u) { const int i = i0 + u * NWAVES * 64, k = i >> 2, q = i & 3; const int j = k >> 8, l = (k & 255) >> 2, c = k & 3; *(LAS f32x4*)(F.lds + RING_OFF + ((((j * 4 + c) * 4 + q) * 64 + l) << 4)) = v[u]; } }
    __syncthreads();
    const int gw = F.vcu * NWAVES + F.wave, NGW = F.G * NWAVES, lane = F.lane;
    const float* mod = wsp<float>(F, WS_MOD); unsigned char* XN = wsp<unsigned char>(F, WS_XN); float* LOGF = wsp<float>(F, WS_LOGF);
    for (int row = gw; row < NTOK; row += NGW) {
        const int b = row >> 11; const float* xr = F.x + (size_t)row * DM; const float* sh = mod + b * MODW, *sc = mod + b * MODW + 2048;
        f32x4 v[8]; float ss = 0.f;
#pragma unroll
        for (int j = 0; j < 8; ++j) { v[j] = *(const f32x4*)(xr + 256 * j + 4 * lane); ss += v[j][0] * v[j][0] + v[j][1] * v[j][1] + v[j][2] * v[j][2] + v[j][3] * v[j][3]; }
        ss = wave_sum(ss); const float rstd = 1.0f / sqrtf(ss * (1.0f / DM) + 1e-5f);
        float fa[16];
#pragma unroll
        for (int h = 0; h < 16; ++h) fa[h] = 0.f;
#pragma unroll
        for (int j = 0; j < 8; ++j) { const int col = 256 * j + 4 * lane; const f32x4 g = *(const f32x4*)(F.g_mix + col), s1 = *(const f32x4*)(sc + col), h1 = *(const f32x4*)(sh + col);
            const f32x4 y = v[j] * rstd * g * (s1 + 1.0f) + h1;
            if constexpr (MIX_FP8) *(unsigned*)(XN + (size_t)row * DM + col) = pk4_fp8(y[0], y[1], y[2], y[3]);
            else { u32x2 w; w.x = pk2(y[0], y[1]); w.y = pk2(y[2], y[3]); *(u32x2*)((bf16_t*)XN + (size_t)row * DM + col) = w; }
#pragma unroll
            for (int c = 0; c < 4; ++c) {
#pragma unroll
                for (int q = 0; q < 4; ++q) { const f32x4 wv = *(const LAS f32x4*)(F.lds + RING_OFF + ((((j * 4 + c) * 4 + q) * 64 + lane) << 4));
#pragma unroll
                    for (int e = 0; e < 4; ++e) fa[4 * q + e] += y[c] * wv[e]; }
                if (c & 1) asm volatile("" ::: "memory"); } }
#pragma unroll
        for (int h = 0; h < 16; ++h) fa[h] = wave_sum(fa[h]);
        float mine = 0.f;
#pragma unroll
        for (int h = 0; h < 16; ++h) mine = (lane == h) ? fa[h] : mine;
        if (lane < 16) { const float f = mine + F.b_in[4608 + lane]; LOGF[row * 16 + lane] = fminf(f, 0.f) - log1pf(expf(-fabsf(f))); }
    }
}
__device__ __forceinline__ void p2_cumsum(Frame& F) {
    refresh(F);
    volatile LAS float* wsum_s = (volatile LAS float*)(F.MISC + 96);
    const float* LOGF = wsp<float>(F, WS_LOGF); float* CUM = wsp<float>(F, WS_CUM);
    for (int bh = F.vcu; bh < 64; bh += F.G) {
        const int b = bh >> 4, h = bh & 15, t0 = 4 * F.tid;
        float a[4];
#pragma unroll
        for (int i = 0; i < 4; ++i) a[i] = LOGF[(size_t)(b * SEQ + t0 + i) * 16 + h];
        a[1] += a[0]; a[2] += a[1]; a[3] += a[2];
        float s = a[3];
#pragma unroll
        for (int o = 1; o < 64; o <<= 1) { const float t = __shfl_up(s, o); if (F.lane >= o) s += t; }
        if (F.lane == 63) wsum_s[F.wave] = s;
        __syncthreads();
        float base = 0.f;
        for (int w = 0; w < F.wave; ++w) base += wsum_s[w];
        const float excl = base + s - a[3];
#pragma unroll
        for (int i = 0; i < 4; ++i) CUM[(size_t)bh * SEQ + t0 + i] = excl + a[i];
        __syncthreads();
    }
}

constexpr int AT_KOFF = 0, AT_VOFF = 9216, AT_COFF = 17920, AT_BUF = 18432;
template <int MODE>
__device__ __forceinline__ void attn_unit(LAS unsigned char* lds, const bf16_t* __restrict__ Q, const bf16_t* __restrict__ Kt, const bf16_t* __restrict__ Vt, const float* __restrict__ cum, unsigned char* __restrict__ O,
                                          int b, int h, int qb, float sink2, int wid) {
    const int lane = lane_id(), tid = wid * 64 + lane, r32 = lane & 31, hi = lane >> 5;
    constexpr int KP = MODE ? 1024 : 256;
    const int kvh = MODE ? h : (h >> 2);
    const int q0 = qb * 256, w0 = q0 + 32 * wid;
    const size_t rowbase = (size_t)b * SEQ;
    bf16x8 qf[4];
    { const bf16_t* qp = Q + (rowbase + w0 + r32) * 1024 + h * 64 + hi * 8;
#pragma unroll
      for (int d0 = 0; d0 < 4; ++d0) qf[d0] = *(const bf16x8*)(qp + d0 * 16); }
    const int kt_lo = MODE ? 0 : (q0 >= 128 ? ((q0 - 128) >> 6) : 0), kt_hi = (q0 + 255) >> 6;
    const int skey = tid >> 3, sch = tid & 7, vp = (tid & 255) >> 3;
    const bf16_t* kg = Kt + (rowbase + skey) * KP + kvh * 64 + sch * 8;
    const bf16_t* vg = Vt + (rowbase + 2 * vp) * KP + kvh * 64 + sch * 8;
    u32x4 kreg, vr0, vr1; float ckreg = 0.f;
#define AT_LOAD(kt) do { kreg = *(const u32x4*)(kg + (size_t)(kt) * 64 * KP); if (tid >= 256) { vr0 = *(const u32x4*)(vg + (size_t)(kt) * 64 * KP); vr1 = *(const u32x4*)(vg + (size_t)(kt) * 64 * KP + KP); } \
        if (MODE && tid < 64) ckreg = cum[(kt) * 64 + tid] * LOG2E; } while (0)
    AT_LOAD(kt_lo);
    float m = MODE ? -1e30f : sink2, l = (MODE == 0 && hi == 0) ? 1.0f : 0.0f;
    const float cq2 = MODE ? cum[w0 + r32] * LOG2E : 0.f;
    f32x16 o0 = {}, o1 = {};
    for (int kt = kt_lo; kt <= kt_hi; ++kt) {
        LAS unsigned char* buf = lds + ((kt - kt_lo) & 1) * AT_BUF;
        *(LAS u32x4*)(buf + AT_KOFF + skey * 144 + sch * 16) = kreg;
        if (tid >= 256) {
#pragma unroll
            for (int i = 0; i < 8; ++i) { const unsigned a = vr0[i >> 1], c = vr1[i >> 1];
                *(LAS unsigned*)(buf + AT_VOFF + (8 * sch + i) * 136 + vp * 4) = __builtin_amdgcn_perm(c, a, (i & 1) ? 0x07060302u : 0x05040100u); } }
        if (MODE && tid < 64) *(LAS float*)(buf + AT_COFF + tid * 4) = ckreg;
        __syncthreads();
        if (kt < kt_hi) AT_LOAD(kt + 1);
        const int k0 = kt * 64;
        const bool active = (k0 <= w0 + 31) && (MODE || (k0 + 63 >= w0 - 127));
        if (active) {
            f32x16 p0 = {}, p1 = {};
            { const LAS unsigned char* kb = buf + AT_KOFF + r32 * 144 + hi * 16;
#pragma unroll
              for (int d0 = 0; d0 < 4; ++d0) { const bf16x8 ka = *(const LAS bf16x8*)(kb + d0 * 32), kc = *(const LAS bf16x8*)(kb + 32 * 144 + d0 * 32);
                  p0 = __builtin_amdgcn_mfma_f32_32x32x16_bf16(ka, qf[d0], p0, 0, 0, 0); p1 = __builtin_amdgcn_mfma_f32_32x32x16_bf16(kc, qf[d0], p1, 0, 0, 0); } }
            if (MODE) {
#pragma unroll
                for (int g = 0; g < 4; ++g) { const f32x4 c0 = *(const LAS f32x4*)(buf + AT_COFF + (8 * g + 4 * hi) * 4), c1 = *(const LAS f32x4*)(buf + AT_COFF + (32 + 8 * g + 4 * hi) * 4);
#pragma unroll
                    for (int j = 0; j < 4; ++j) { p0[4 * g + j] += cq2 - c0[j]; p1[4 * g + j] += cq2 - c1[j]; } } }
            const bool need_mask = MODE ? (k0 + 63 > w0) : true;
            if (need_mask) { const int q = w0 + r32;
#pragma unroll
                for (int r = 0; r < 16; ++r) { const int key = k0 + (r & 3) + 8 * (r >> 2) + 4 * hi;
                    const bool v0 = (key <= q) && (MODE || key + 127 >= q), v1 = (key + 32 <= q) && (MODE || key + 32 + 127 >= q);
                    p0[r] = v0 ? p0[r] : -INFINITY; p1[r] = v1 ? p1[r] : -INFINITY; } }
            float rm = __builtin_fmaxf(p0[0], p1[0]);
#pragma unroll
            for (int r = 1; r < 16; ++r) rm = __builtin_fmaxf(__builtin_fmaxf(rm, p0[r]), p1[r]);
            { const unsigned ru = __builtin_bit_cast(unsigned, rm); auto rr = __builtin_amdgcn_permlane32_swap(ru, ru, false, false);
              rm = __builtin_fmaxf(__builtin_bit_cast(float, rr[0]), __builtin_bit_cast(float, rr[1])); }
            const float mn = fmaxf(m, rm), alpha = __builtin_amdgcn_exp2f(m - mn);
            const bool grew = mn > m; m = mn;
            float ps = 0.f;
#pragma unroll
            for (int r = 0; r < 16; ++r) { p0[r] = __builtin_amdgcn_exp2f(p0[r] - mn); p1[r] = __builtin_amdgcn_exp2f(p1[r] - mn); ps += p0[r] + p1[r]; }
            l = l * alpha + ps;
            if (__any(grew)) {
#pragma unroll
                for (int r = 0; r < 16; ++r) { o0[r] *= alpha; o1[r] *= alpha; } }
            bf16x8 pf[4];
            { u32x4 w;
              w.x = pk2(p0[0], p0[1]); w.y = pk2(p0[2], p0[3]); w.z = pk2(p0[4], p0[5]); w.w = pk2(p0[6], p0[7]); pf[0] = __builtin_bit_cast(bf16x8, w);
              w.x = pk2(p0[8], p0[9]); w.y = pk2(p0[10], p0[11]); w.z = pk2(p0[12], p0[13]); w.w = pk2(p0[14], p0[15]); pf[1] = __builtin_bit_cast(bf16x8, w);
              w.x = pk2(p1[0], p1[1]); w.y = pk2(p1[2], p1[3]); w.z = pk2(p1[4], p1[5]); w.w = pk2(p1[6], p1[7]); pf[2] = __builtin_bit_cast(bf16x8, w);
              w.x = pk2(p1[8], p1[9]); w.y = pk2(p1[10], p1[11]); w.z = pk2(p1[12], p1[13]); w.w = pk2(p1[14], p1[15]); pf[3] = __builtin_bit_cast(bf16x8, w); }
            const LAS unsigned char* vb = buf + AT_VOFF + r32 * 136 + hi * 8;
#pragma unroll
            for (int ks = 0; ks < 4; ++ks) {
                { const u32x2 lo = *(const LAS u32x2*)(vb + ks * 32), hh = *(const LAS u32x2*)(vb + ks * 32 + 16); const u32x4 w = {lo.x, lo.y, hh.x, hh.y};
                  o0 = __builtin_amdgcn_mfma_f32_32x32x16_bf16(__builtin_bit_cast(bf16x8, w), pf[ks], o0, 0, 0, 0); }
                { const u32x2 lo = *(const LAS u32x2*)(vb + 32 * 136 + ks * 32), hh = *(const LAS u32x2*)(vb + 32 * 136 + ks * 32 + 16); const u32x4 w = {lo.x, lo.y, hh.x, hh.y};
                  o1 = __builtin_amdgcn_mfma_f32_32x32x16_bf16(__builtin_bit_cast(bf16x8, w), pf[ks], o1, 0, 0, 0); } }
        }
    }
#undef AT_LOAD
    l += __shfl_xor(l, 32);
    const float inv = 1.0f / l;
    const size_t oe = (rowbase + w0 + r32) * 2048 + MODE * 1024 + h * 64 + 4 * hi;
#pragma unroll
    for (int g = 0; g < 4; ++g) {
        if constexpr (MIX_FP8) { *(unsigned*)(O + oe + 8 * g) = pk4_fp8(o0[4 * g] * inv, o0[4 * g + 1] * inv, o0[4 * g + 2] * inv, o0[4 * g + 3] * inv);
            *(unsigned*)(O + oe + 32 + 8 * g) = pk4_fp8(o1[4 * g] * inv, o1[4 * g + 1] * inv, o1[4 * g + 2] * inv, o1[4 * g + 3] * inv); }
        else { bf16_t* op = (bf16_t*)O + oe; u32x2 w; w.x = pk2(o0[4 * g] * inv, o0[4 * g + 1] * inv); w.y = pk2(o0[4 * g + 2] * inv, o0[4 * g + 3] * inv); *(u32x2*)(op + 8 * g) = w;
            w.x = pk2(o1[4 * g] * inv, o1[4 * g + 1] * inv); w.y = pk2(o1[4 * g + 2] * inv, o1[4 * g + 3] * inv); *(u32x2*)(op + 32 + 8 * g) = w; } }
    __syncthreads();
}
__device__ __forceinline__ void p3_attention(Frame& F) {
    refresh(F);
    const bf16_t *QA = wsp<bf16_t>(F, WS_QA), *KA = wsp<bf16_t>(F, WS_KA), *VA = wsp<bf16_t>(F, WS_VA), *QB = wsp<bf16_t>(F, WS_QB), *KB = wsp<bf16_t>(F, WS_KB), *VB = wsp<bf16_t>(F, WS_VB);
    const float* CUM = wsp<float>(F, WS_CUM); unsigned char* YAB = wsp<unsigned char>(F, WS_YAB);
    LAS unsigned char* lds = F.lds + RING_OFF;
    unsigned* head = F.ctl + CW_AQ;
    for (;;) {
        __syncthreads();
        if (F.tid == 0) F.MISC[100] = __hip_atomic_fetch_add(head, 1u, __ATOMIC_RELAXED, __HIP_MEMORY_SCOPE_AGENT);
        __syncthreads();
        const int u = (int)F.MISC[100];
        if (u >= 1024) break;
        if (u < 512) { const int bh = u & 63, qb = 7 - (u >> 6); attn_unit<1>(lds, QB, KB, VB, CUM + (size_t)bh * SEQ, YAB, bh >> 4, bh & 15, qb, 0.f, F.wave); }
        else { const int v = u - 512, bh = v >> 3, qb = v & 7; attn_unit<0>(lds, QA, KA, VA, nullptr, YAB, bh >> 4, bh & 15, qb, F.sinks[bh & 15] * LOG2E, F.wave); }
    }
}

template <int HH>
__device__ __forceinline__ void p6_half(Frame& F) {
    refresh(F);
    const int gw = F.vcu * NWAVES + F.wave, NGW = F.G * NWAVES, lane = F.lane;
    const float* mod = wsp<float>(F, WS_MOD); const float* H1 = wsp<float>(F, WS_H1); unsigned char* XN2 = wsp<unsigned char>(F, WS_XN2);
    int* TEID = wsp<int>(F, WS_TEID); int* TPOS = wsp<int>(F, WS_TPOS); float* TGATE = wsp<float>(F, WS_TGATE); int* TOKOF = wsp<int>(F, WS_TOKOF);
    LAS float* part = (LAS float*)(F.lds + TBL_OFF) + F.wave * 256 + lane;
    __syncthreads();
#pragma unroll 1
    for (int i0 = F.tid; i0 < 1024 * 8; i0 += 8 * NWAVES * 64) {
        f32x4 v[8];
#pragma unroll
        for (int u = 0; u < 8; ++u) { const int i = i0 + u * NWAVES * 64, kk = i >> 3, q = i & 7; v[u] = *(const f32x4*)(F.w_r + (size_t)(1024 * HH + kk) * 32 + 4 * q); }
#pragma unroll
        for (int u = 0; u < 8; ++u) { const int i = i0 + u * NWAVES * 64, kk = i >> 3, q = i & 7; const int jj = kk >> 8, l = (kk & 255) >> 2, c = kk & 3; *(LAS f32x4*)(F.lds + RING_OFF + ((((jj * 4 + c) * 8 + q) * 64 + l) << 4)) = v[u]; } }
    __syncthreads();
#pragma unroll 1
    for (int ri = 0; ri < 4; ++ri) {
        const int row = gw + ri * NGW; if (row >= NTOK) break;
        int lane4 = 4 * lane; asm volatile("" : "+v"(lane4));
        const int b = row >> 11; const float* xr = H1 + (size_t)row * DM + lane4; const float* sh = mod + b * MODW + 6144 + lane4, *sc = mod + b * MODW + 8192 + lane4; const float* gp = F.g_ffn + lane4;
        f32x4 v[4]; float ss = 0.f;
#pragma unroll
        for (int j = 0; j < 4; ++j) { v[j] = *(const f32x4*)(xr + 256 * (4 * HH + j)); const f32x4 o = *(const f32x4*)(xr + 256 * (4 * (1 - HH) + j));
            ss += v[j][0] * v[j][0] + v[j][1] * v[j][1] + v[j][2] * v[j][2] + v[j][3] * v[j][3] + o[0] * o[0] + o[1] * o[1] + o[2] * o[2] + o[3] * o[3]; }
        ss = wave_sum(ss); const float rstd = 1.0f / sqrtf(ss * (1.0f / DM) + 1e-5f);
        float a[32];
#pragma unroll
        for (int e = 0; e < 32; ++e) a[e] = 0.f;
        const LAS unsigned char* wl = F.lds + RING_OFF + 4 * lane4;
#pragma unroll
        for (int jj = 0; jj < 4; ++jj) { const int col = 256 * (4 * HH + jj); const f32x4 g = *(const f32x4*)(gp + col), s1 = *(const f32x4*)(sc + col), h1 = *(const f32x4*)(sh + col);
            const f32x4 y = v[jj] * rstd * g * (s1 + 1.0f) + h1;
            if constexpr (MOE_FP8) *(unsigned*)(XN2 + (size_t)row * DM + col + lane4) = pk4_fp8(y[0], y[1], y[2], y[3]);
            else { u32x2 w; w.x = pk2(y[0], y[1]); w.y = pk2(y[2], y[3]); *(u32x2*)((bf16_t*)XN2 + (size_t)row * DM + col + lane4) = w; }
#pragma unroll
            for (int c = 0; c < 4; ++c) {
#pragma unroll
                for (int q = 0; q < 8; ++q) { const f32x4 wv = *(const LAS f32x4*)(wl + ((((jj * 4 + c) * 8 + q) * 64) << 4));
#pragma unroll
                    for (int e = 0; e < 4; ++e) a[4 * q + e] += y[c] * wv[e]; }
                asm volatile("" ::: "memory"); } }
#define P6_RSTEP(XF, MASK, HALF) { const bool up = (lane & (MASK)) != 0; _Pragma("unroll") for (int i = 0; i < (HALF); ++i) { const float keep = up ? a[i + (HALF)] : a[i], give = up ? a[i] : a[i + (HALF)]; a[i] = keep + XF; } }
        P6_RSTEP(__shfl_xor(give, 32), 32, 16) P6_RSTEP(__shfl_xor(give, 16), 16, 8) P6_RSTEP(__shfl_xor(give, 8), 8, 4) P6_RSTEP(__shfl_xor(give, 4), 4, 2) P6_RSTEP(__shfl_xor(give, 2), 2, 1)
#undef P6_RSTEP
        float lg = a[0] + __shfl_xor(a[0], 1);
        if (HH == 0) { part[ri * 64] = lg; continue; }
        lg += part[ri * 64] + F.b_r[lane >> 1];
        float val[4]; int idx[4];
        float cur = lg;
#pragma unroll
        for (int k = 0; k < 4; ++k) { float bv = cur; int bi = lane >> 1;
#pragma unroll
            for (int o = 1; o < 64; o <<= 1) { const float ov = __shfl_xor(bv, o); const int oi = __shfl_xor(bi, o); if (ov > bv || (ov == bv && oi < bi)) { bv = ov; bi = oi; } }
            val[k] = bv; idx[k] = bi; if ((lane >> 1) == bi) cur = -INFINITY; }
        float ex[4], sm = 0.f;
#pragma unroll
        for (int k = 0; k < 4; ++k) { ex[k] = expf(val[k] - val[0]); sm += ex[k]; }
        if (lane < 4) { int e = idx[0]; float gt = ex[0];
#pragma unroll
            for (int k = 1; k < 4; ++k) if (lane == k) { e = idx[k]; gt = ex[k]; }
            const int p = (int)atomicAdd(F.ctl + CW_CNT + e, 1u);
            TOKOF[e * NTOK + p] = row; TEID[row * 4 + lane] = e; TPOS[row * 4 + lane] = p; TGATE[row * 4 + lane] = gt / sm; }
    }
}
__device__ __forceinline__ void p6_norm_router(Frame& F) { p6_half<0>(F); p6_half<1>(F); }
__device__ __forceinline__ void moe_tables(Frame& F) {
    refresh(F);
    __syncthreads();
    if (F.tid == 0) { unsigned s = 0, h = 0, nl = 0;
        for (int e = 0; e < 32; ++e) { const unsigned c = __hip_atomic_load(F.ctl + CW_CNT + e, __ATOMIC_RELAXED, __HIP_MEMORY_SCOPE_AGENT); F.MISC[48 + e] = c; F.MISC[8 + e] = s; s += (c + 255u) >> 8;
            const unsigned rem = c & 255u; F.MISC[112 + e] = h; h += (c >> 8) + (rem > 128u ? 1u : 0u); if (rem >= 1u && rem <= 128u) { F.MISC[152 + nl] = (unsigned)e; ++nl; } }
        F.MISC[8 + 32] = s; F.MISC[112 + 32] = h; F.MISC[190] = nl; }
    __syncthreads();
}
__device__ __forceinline__ void p7_gu(Frame& F) {
    moe_tables(F);
    MoeSched<true> S; S.tpre = F.MISC + 8; S.cnt = F.MISC + 48; S.hpre = F.MISC + 112; S.lexp = F.MISC + 152; S.nlight = (int)F.MISC[190]; S.tbl = (const LAS unsigned*)(F.lds + TBL_OFF); S.A = (const char*)wsp<bf16_t>(F, WS_XN2); S.Bt = (const char*)wsp<bf16_t>(F, WS_WGU); S.NN = 16; S.ldb2 = 2048 * MOE_EB; S.K = 2048;
    S.G = F.G; S.vcu = F.vcu; S.b_estride = (size_t)4096 * 2048 * MOE_EB;
    { const int* TOKOF = wsp<int>(F, WS_TOKOF); Unit u; LAS unsigned* tbl = (LAS unsigned*)(F.lds + TBL_OFF);
      for (int i = 0; i < 10 && S.next(i, u); ++i) { if (F.tid < 256) { const int e = u.aux, p = (u.pm - (int)F.MISC[8 + e]) * 256 + F.tid, cnt = (int)F.MISC[48 + e]; const int tok = TOKOF[e * NTOK + (p < cnt ? p : 0)]; tbl[i * 256 + F.tid] = (unsigned)tok * (2048u * MOE_EB); } }
      __syncthreads(); }
    EpiGU E{F.b_gu, wsp<unsigned char>(F, WS_ACT)};
    gemm_phase<EpiGU, MoeSched<true>, true, MOE_FP8>(F.lds + RING_OFF, S, E, F.wave);
}
__device__ __forceinline__ void p8_down(Frame& F) {
    moe_tables(F);
    MoeSched<false> S; S.tpre = F.MISC + 8; S.cnt = F.MISC + 48; S.hpre = F.MISC + 112; S.lexp = F.MISC + 152; S.nlight = (int)F.MISC[190]; S.tbl = nullptr; S.A = (const char*)wsp<bf16_t>(F, WS_ACT); S.Bt = (const char*)wsp<bf16_t>(F, WS_WD); S.NN = 8; S.ldb2 = 2048 * MOE_EB; S.K = 2048;
    S.G = F.G; S.vcu = F.vcu; S.b_estride = (size_t)2048 * 2048 * MOE_EB;
    EpiDown E{F.b_dn, wsp<bf16_t>(F, WS_YS)};
    gemm_phase<EpiDown, MoeSched<false>, true, MOE_FP8>(F.lds + RING_OFF, S, E, F.wave);
}
__device__ __forceinline__ void p9_final(Frame& F) {
    refresh(F);
    moe_tables(F);
    const int gw = F.vcu * NWAVES + F.wave, NGW = F.G * NWAVES, lane = F.lane;
    const float* mod = wsp<float>(F, WS_MOD); const float* H1 = wsp<float>(F, WS_H1); const bf16_t* YS = wsp<bf16_t>(F, WS_YS);
    const int* TEID = wsp<int>(F, WS_TEID); const int* TPOS = wsp<int>(F, WS_TPOS); const float* TGATE = wsp<float>(F, WS_TGATE);
    for (int row = gw; row < NTOK; row += NGW) {
        const int b = row >> 11; const float* gt = mod + b * MODW + 10240;
        const bf16_t* yr[4]; float gw4[4];
#pragma unroll
        for (int k = 0; k < 4; ++k) { const int e = TEID[row * 4 + k]; yr[k] = YS + ((size_t)F.MISC[8 + e] * 256 + TPOS[row * 4 + k]) * 2048; gw4[k] = TGATE[row * 4 + k]; }
        f32x4 v[8]; float ss = 0.f;
#pragma unroll
        for (int j = 0; j < 8; ++j) { const int col = 256 * j + 4 * lane; f32x4 y = {0.f, 0.f, 0.f, 0.f};
#pragma unroll
            for (int k = 0; k < 4; ++k) { const u32x2 w = *(const u32x2*)(yr[k] + col); y += (f32x4){bflo(w.x), bfhi(w.x), bflo(w.y), bfhi(w.y)} * gw4[k]; }
            v[j] = *(const f32x4*)(H1 + (size_t)row * DM + col) + *(const f32x4*)(gt + col) * y;
            ss += v[j][0] * v[j][0] + v[j][1] * v[j][1] + v[j][2] * v[j][2] + v[j][3] * v[j][3]; }
        ss = wave_sum(ss); const float rstd = 1.0f / sqrtf(ss * (1.0f / DM) + 1e-5f);
#pragma unroll
        for (int j = 0; j < 8; ++j) { const int col = 256 * j + 4 * lane; *(f32x4*)(F.out + (size_t)row * DM + col) = v[j] * rstd * *(const f32x4*)(F.g_fin + col); }
    }
}

constexpr int PER_PHASE = 10;
struct Args { const void* in[20]; float* out; unsigned char* ws; int ph_lo, ph_hi; };
__global__ void __launch_bounds__(NWAVES * 64, 2) mega_fwd(Args args) {
    extern __shared__ __attribute__((aligned(16))) unsigned char lds_raw[];
    Frame F;
    F.lds = (LAS unsigned char*)lds_raw; F.MISC = (volatile LAS unsigned*)(F.lds + MISC_OFF);
    F.tid = threadIdx.x; F.lane = F.tid & 63; F.wave = __builtin_amdgcn_readfirstlane(F.tid >> 6);
    F.G = gridDim.x; { const int bx = blockIdx.x; F.vcu = (F.G % 8 == 0) ? (bx % 8) * (F.G / 8) + bx / 8 : bx; }
    F.ws = args.ws; F.ctl = (unsigned*)(args.ws + WS_CTL); F.out = args.out;
    F.x = (const float*)args.in[0]; F.c = (const float*)args.in[1]; F.pos = (const int*)args.in[2]; F.w_ada = (const float*)args.in[3]; F.b_ada = (const float*)args.in[4]; F.g_mix = (const float*)args.in[5];
    F.w_in = (const float*)args.in[6]; F.b_in = (const float*)args.in[7]; F.sinks = (const float*)args.in[8]; F.w_a = (const float*)args.in[9]; F.w_b = (const float*)args.in[10]; F.w_out = (const float*)args.in[11];
    F.g_ffn = (const float*)args.in[12]; F.w_r = (const float*)args.in[13]; F.b_r = (const float*)args.in[14]; F.w_gu = (const float*)args.in[15]; F.b_gu = (const float*)args.in[16]; F.w_dn = (const float*)args.in[17];
    F.b_dn = (const float*)args.in[18]; F.g_fin = (const float*)args.in[19];
    for (int u = F.tid; u < 256; u += NWAVES * 64) F.MISC[u] = 0u;
    __syncthreads();
    refresh(F);
    const int lo = args.ph_lo, hi = args.ph_hi;
    const bool one_launch = true; (void)lo; (void)hi;
    XcdBarrier bar; bar.bar = (unsigned*)(F.ctl + CW_BAR); bar.x = 0; bar.st = nullptr; bar.total = 0;
    XcdBarrier bar2 = bar;
    const bool is_comp = (int)blockIdx.x < NCOMP || F.G <= NCOMP;
    const int ncomp = F.G <= NCOMP ? F.G : NCOMP;
    if (one_launch) { bar = xcd_barrier_post((unsigned*)(F.ctl + CW_BAR), F.MISC + 0, (unsigned)F.G);
        if (is_comp) bar2 = xcd_barrier_post((unsigned*)(F.ctl + CW_BAR2), F.MISC + 2, (unsigned)ncomp); }
#ifndef REPEAT_MASK
#define REPEAT_MASK 0
#endif
#define IN(k) true
#define REP(k, body) do { if ((REPEAT_MASK >> (k)) & 1) { body; xcd_barrier(bar); } } while (0)
#define REP2(k, body) do { if ((REPEAT_MASK >> (k)) & 1) { body; xcd_barrier(bar2); } } while (0)
#define SEAM(k) do { if (IN(k) && IN((k) + 1)) xcd_barrier(bar); } while (0)
    if (one_launch) {
        if (is_comp) {
            const int G0 = F.G, v0 = F.vcu; F.G = ncomp; { const int bx = blockIdx.x; F.vcu = (ncomp % 8 == 0) ? (bx % 8) * (ncomp / 8) + bx / 8 : bx; }
            const bool split0 = ncomp < G0;
            p0_prologue(F, 0, split0 ? P0_T_HEAD : P0_T_ALL, F.vcu * NWAVES + F.wave, F.G * NWAVES); xcd_barrier(bar2);
            REP2(1, p1_norm_fb(F)); p1_norm_fb(F); xcd_barrier(bar2);
            if (split0) {
                if (F.tid == 0) { unsigned* flag = F.ctl + CW_SFLAG; unsigned* tmo = (unsigned*)(F.ctl + CW_BAR) + XB_TMO; const unsigned want = (unsigned)(G0 - ncomp);
                    XB_SPIN(xb_ld(flag) < want, (unsigned*)(F.ctl + CW_BAR)); (void)tmo;
                    __builtin_amdgcn_fence(__ATOMIC_ACQUIRE, "agent"); asm volatile("s_waitcnt vmcnt(0)" ::: "memory"); }
                __syncthreads(); }
            { p2_cumsum(F);
              DenseSched S; S.init(wsp<bf16_t>(F, WS_XN), 2048 * MIX_EB, wsp<bf16_t>(F, WS_WIN), 2048 * MIX_EB, 2048, NTOK, 8704, ncomp, (int)blockIdx.x);
              EpiInProj E{wsp<bf16_t>(F, WS_QA), wsp<bf16_t>(F, WS_KA), wsp<bf16_t>(F, WS_VA), wsp<bf16_t>(F, WS_QB), wsp<bf16_t>(F, WS_KB), wsp<bf16_t>(F, WS_VB), wsp<bf16_t>(F, WS_SGA), wsp<bf16_t>(F, WS_SGB),
                          wsp<float>(F, WS_BINP), wsp<float>(F, WS_COS), wsp<float>(F, WS_SIN)};
              REP2(2, (gemm_phase<EpiInProj, DenseSched, true, MIX_FP8>(F.lds + RING_OFF, S, E, F.wave)));
              gemm_phase<EpiInProj, DenseSched, true, MIX_FP8>(F.lds + RING_OFF, S, E, F.wave); }
            xcd_barrier(bar2);
            p3_attention(F);
            xcd_barrier(bar2);
            {
                BranchSched S; S.d.init(wsp<bf16_t>(F, WS_YAB), 2048 * MIX_EB, wsp<bf16_t>(F, WS_WAB), 1024 * MIX_EB, 1024, NTOK, 2048, ncomp, (int)blockIdx.x); S.ldb2 = 1024 * MIX_EB; S.K = 1024;
                EpiBranch E{wsp<bf16_t>(F, WS_SGA), wsp<bf16_t>(F, WS_SGB), wsp<float>(F, WS_T1), wsp<unsigned char>(F, WS_MERGED)};
                gemm_phase<EpiBranch, BranchSched, true, MIX_FP8>(F.lds + RING_OFF, S, E, F.wave); }
            xcd_barrier(bar2);
            {
                DenseSched S; S.init(wsp<bf16_t>(F, WS_MERGED), 2048 * P5_EB, wsp<bf16_t>(F, WS_WOUT), 2048 * P5_EB, 2048, NTOK, 2048, ncomp, (int)blockIdx.x);
                EpiOut E{F.x, wsp<float>(F, WS_MOD), wsp<float>(F, WS_H1)};
                gemm_phase<EpiOut, DenseSched, true, P5_FP8>(F.lds + RING_OFF, S, E, F.wave); }
            F.G = G0; F.vcu = v0;
        }
#ifndef CONV_COOP
#define CONV_COOP 1
#endif
        if (!is_comp) {
            p0_prologue(F, P0_T_HEAD, P0_T_ALL, ((int)blockIdx.x - ncomp) * NWAVES + F.wave, (F.G - ncomp) * NWAVES);
            asm volatile("s_waitcnt vmcnt(0)" ::: "memory"); __syncthreads();
            if (F.tid == 0) { __builtin_amdgcn_fence(__ATOMIC_RELEASE, "agent"); asm volatile("s_waitcnt vmcnt(0)" ::: "memory"); (void)xb_add(F.ctl + CW_SFLAG, 1u); }
        }
        if (CONV_MODE == 0 || (CONV_MODE == 1 && !is_comp) || (CONV_MODE == 2 && is_comp)) { if (CONV_COOP && MOE_FP8) convert_coop(F); else convert_queue(F); }
        xcd_barrier(bar);
    }
    if (IN(6)) { p6_norm_router(F); } SEAM(6);
    if (IN(7)) { REP(7, p7_gu(F)); p7_gu(F); } SEAM(7);
    if (IN(8)) { REP(8, p8_down(F)); p8_down(F); } SEAM(8);
    if (IN(9)) { REP(9, p9_final(F)); p9_final(F); }
#undef IN
#undef SEAM
}

static void run_opt(void* const* d_in, float* out, unsigned char* ws, hipStream_t stream, int n_launches) {
    static int grid = 0;
    if (grid == 0) {
        int dev = 0, cus = 0;
        if (hipGetDevice(&dev) != hipSuccess || hipDeviceGetAttribute(&cus, hipDeviceAttributeMultiprocessorCount, dev) != hipSuccess) { grid = -1; return; }
        if (hipFuncSetAttribute((const void*)mega_fwd, hipFuncAttributeMaxDynamicSharedMemorySize, LDS_BYTES) != hipSuccess) { grid = -1; return; }
        int per_cu = 0; (void)hipOccupancyMaxActiveBlocksPerMultiprocessor(&per_cu, (const void*)mega_fwd, NWAVES * 64, LDS_BYTES); (void)hipGetLastError();
        grid = cus;
    }
    if (grid < 0) return;
    (void)hipMemsetAsync(ws + WS_CTL, 0, CTL_ZERO_BYTES, stream);
    Args a{};
    for (int i = 0; i < 20; ++i) a.in[i] = d_in[i];
    a.out = out; a.ws = ws;
    (void)n_launches; a.ph_lo = 0; a.ph_hi = PER_PHASE; hipLaunchKernelGGL(mega_fwd, dim3(grid), dim3(NWAVES * 64), LDS_BYTES, stream, a);
}
}

extern "C" void kernel_launch(void* const* d_in, const int* in_sizes, int n_in, void* d_out, int out_size, void* d_ws, size_t ws_size, hipStream_t stream) {
    mk::run_opt(d_in, (float*)d_out, (unsigned char*)d_ws, stream, 1);
}
```

```cpp
#include <hip/hip_runtime.h>
#include <stdint.h>
#include <math.h>
namespace mk {
#define LAS __attribute__((address_space(3)))
#define GAS __attribute__((address_space(1)))
typedef unsigned short bf16_t;
typedef short bf16x8 __attribute__((ext_vector_type(8)));
typedef float f32x4 __attribute__((ext_vector_type(4)));
typedef float f32x2 __attribute__((ext_vector_type(2)));
typedef float f32x16 __attribute__((ext_vector_type(16)));
typedef unsigned u32x4 __attribute__((ext_vector_type(4)));
typedef unsigned u32x2 __attribute__((ext_vector_type(2)));
typedef __bf16 bf16x2_t __attribute__((ext_vector_type(2)));
typedef int i32x4 __attribute__((ext_vector_type(4)));
typedef int i32x8 __attribute__((ext_vector_type(8)));

constexpr int NTOK = 8192, DM = 2048, SEQ = 2048, INW = 8720, NEXP = 32, MODW = 12288;
constexpr float LOG2E = 1.4426950408889634f;
constexpr float QSCALE = 0.125f * LOG2E;

__device__ __forceinline__ unsigned pk2(float lo, float hi) { f32x2 v = {lo, hi}; bf16x2_t b = __builtin_convertvector(v, bf16x2_t); return __builtin_bit_cast(unsigned, b); }
__device__ __forceinline__ float bflo(unsigned u) { return __builtin_bit_cast(float, u << 16); }
__device__ __forceinline__ float bfhi(unsigned u) { return __builtin_bit_cast(float, u & 0xffff0000u); }
__device__ __forceinline__ unsigned pk4_fp8_raw(float a, float b, float c, float d) { int w = 0; w = __builtin_amdgcn_cvt_pk_fp8_f32(a, b, w, false); w = __builtin_amdgcn_cvt_pk_fp8_f32(c, d, w, true); return (unsigned)w; }
__device__ __forceinline__ float sat448(float x) { return __builtin_amdgcn_fmed3f(x, -448.0f, 448.0f); }
__device__ __forceinline__ unsigned pk4_fp8(float a, float b, float c, float d) { return pk4_fp8_raw(a, b, c, d); }
__device__ __forceinline__ i32x8 cat8(bf16x8 lo, bf16x8 hi) { return __builtin_shufflevector(__builtin_bit_cast(i32x4, lo), __builtin_bit_cast(i32x4, hi), 0, 1, 2, 3, 4, 5, 6, 7); }
__device__ __forceinline__ int lane_id() { int l = (int)__builtin_amdgcn_mbcnt_hi(~0u, __builtin_amdgcn_mbcnt_lo(~0u, 0u)); asm volatile("" : "+v"(l)); return l; }
template <int CTRL> __device__ __forceinline__ float dpp_mov(float x) { return __builtin_bit_cast(float, __builtin_amdgcn_update_dpp(0, __builtin_bit_cast(int, x), CTRL, 0xF, 0xF, true)); }
__device__ __forceinline__ float lx1(float x) { return dpp_mov<0xB1>(x); }
__device__ __forceinline__ float lx2(float x) { return dpp_mov<0x4E>(x); }
__device__ __forceinline__ float lx4(float x) { return dpp_mov<0x1B>(dpp_mov<0x141>(x)); }
__device__ __forceinline__ float lx8(float x) { return dpp_mov<0x128>(x); }
__device__ __forceinline__ float lx16(float x, int lane) { const unsigned u = __builtin_bit_cast(unsigned, x); auto rr = __builtin_amdgcn_permlane16_swap(u, u, false, false); return __builtin_bit_cast(float, (lane & 16) ? rr[0] : rr[1]); }
__device__ __forceinline__ float lx32(float x, int lane) { const unsigned u = __builtin_bit_cast(unsigned, x); auto rr = __builtin_amdgcn_permlane32_swap(u, u, false, false); return __builtin_bit_cast(float, (lane & 32) ? rr[0] : rr[1]); }
__device__ __forceinline__ float wave_sum_v(float v) {
    v += lx1(v); v += lx2(v); v += lx4(v); v += lx8(v);
    { const unsigned u = __builtin_bit_cast(unsigned, v); auto rr = __builtin_amdgcn_permlane16_swap(u, u, false, false); v = __builtin_bit_cast(float, rr[0]) + __builtin_bit_cast(float, rr[1]); }
    { const unsigned u = __builtin_bit_cast(unsigned, v); auto rr = __builtin_amdgcn_permlane32_swap(u, u, false, false); v = __builtin_bit_cast(float, rr[0]) + __builtin_bit_cast(float, rr[1]); }
    return v;
}
__device__ __forceinline__ float fast_sigmoid(float x) { return __builtin_amdgcn_rcpf(1.0f + __builtin_amdgcn_exp2f(-x * LOG2E)); }

constexpr int BM = 256, BK = 64, HALF = 128, HTB = HALF * BK * 2, STAGE_BYTES = 8 * HTB, NXCD = 8, WGM = 8;
__host__ __device__ __forceinline__ int lds_byte(int r, int c) { const int st = (r >> 4) * 2 + (c >> 5), rr = r & 15, cc = c & 31, ob = rr * 64 + cc * 2; return st * 1024 + (ob ^ (((ob >> 9) & 1) << 5)); }
__host__ __device__ __forceinline__ void stage_rc(int b, int& R, int& C) { const int st = b / 1024, sb = b % 1024, swz = sb ^ (((sb >> 9) & 1) << 5); R = (st >> 1) * 16 + swz / 64; C = (st & 1) * 32 + (swz % 64) / 2; }
__host__ __device__ __forceinline__ int perm32(int rho) { const int n = rho >> 4, i = rho & 15; return 8 * (i >> 2) + 4 * n + (i & 3); }

struct Unit { int pm, pn, aux; };

template <class Epi, class Sched, bool ALIGN_EPI, bool FP8 = false>
__device__ __forceinline__ void gemm_phase(LAS unsigned char* lds, const Sched& S, const Epi& E, int wid  ) {
    const int lane = lane_id(), tid = wid * 64 + lane, wr = wid >> 2, wc = wid & 3, fr = lane & 15, fq = lane >> 4;
    const int K = S.K, nt = FP8 ? K / (2 * BK) : K / BK;
    int sR[2], sC[2]; unsigned voffB[2];
#pragma unroll
    for (int i = 0; i < 2; ++i) { stage_rc(tid * 16 + i * 8192, sR[i], sC[i]); const int Rb = Epi::PERM ? ((sR[i] & ~31) + perm32(sR[i] & 31)) : sR[i]; voffB[i] = (unsigned)Rb * S.ldb2 + (unsigned)sC[i] * 2u; }
    const size_t kstep = (size_t)(BK * 2);
    const size_t hstepB = (size_t)HALF * S.ldb2;
    const unsigned ldsw = (unsigned)wid * 1024u;
    const int aoff = lds_byte(wr * 64 + fr, fq * 8), boff = lds_byte(wc * 32 + fr, fq * 8);
#define PG8_SA(b, h) (((b) * 2 + (h)) * HTB)
#define PG8_SB(b, h) ((4 + (b) * 2 + (h)) * HTB)
#define PG8_STAGE(bufoff, gbase, voff) do { _Pragma("unroll") for (int _i = 0; _i < 2; ++_i) \
        __builtin_amdgcn_global_load_lds((const unsigned*)((const char*)(gbase) + (voff)[_i]), (LAS unsigned*)(lds + (bufoff) + ldsw + _i * 8192), 16, 0, 0); } while (0)
#define PG8_LDA(dst, b, h) do { _Pragma("unroll") for (int m = 0; m < 4; ++m) { if constexpr (FP8) dst##8[m] = cat8(*(const LAS bf16x8*)(lds + PG8_SA(b, h) + aoff + m * 2048), *(const LAS bf16x8*)(lds + PG8_SA(b, h) + aoff + m * 2048 + 1024)); \
        else { _Pragma("unroll") for (int k = 0; k < 2; ++k) dst[m][k] = *(const LAS bf16x8*)(lds + PG8_SA(b, h) + aoff + m * 2048 + k * 1024); } } } while (0)
#define PG8_LDB(dst, b, h) do { _Pragma("unroll") for (int n = 0; n < 2; ++n) { if constexpr (FP8) dst##8[n] = cat8(*(const LAS bf16x8*)(lds + PG8_SB(b, h) + boff + n * 2048), *(const LAS bf16x8*)(lds + PG8_SB(b, h) + boff + n * 2048 + 1024)); \
        else { _Pragma("unroll") for (int k = 0; k < 2; ++k) dst[n][k] = *(const LAS bf16x8*)(lds + PG8_SB(b, h) + boff + n * 2048 + k * 1024); } } } while (0)
#define PG8_MMA(ai, bj, At, Bt) do { __builtin_amdgcn_s_setprio(1); _Pragma("unroll") for (int m = 0; m < 4; ++m) _Pragma("unroll") for (int n = 0; n < 2; ++n) { \
        if constexpr (FP8) asm volatile("v_mfma_scale_f32_16x16x128_f8f6f4 %0, %1, %2, %0, %3, %3 op_sel_hi:[0,0,0]" : "+v"(acc[ai][bj][m][n]) : "v"(Bt##8[n]), "v"(At##8[m]), "v"(fp8_unit_scale)); \
        else { _Pragma("unroll") for (int k = 0; k < 2; ++k) acc[ai][bj][m][n] = __builtin_amdgcn_mfma_f32_16x16x32_bf16(Bt[n][k], At[m][k], acc[ai][bj][m][n], 0, 0, 0); } } __builtin_amdgcn_s_setprio(0); } while (0)
#define PG8_WAIT_V(n) asm volatile("s_waitcnt vmcnt(" #n ")" ::: "memory")
#define PG8_WAIT_L(n) asm volatile("s_waitcnt lgkmcnt(" #n ")" ::: "memory")
#define PG8_BAR __builtin_amdgcn_s_barrier()
#define PG8_SCHED __builtin_amdgcn_sched_barrier(0)
#define PG8_AOFFS(dst, u, ui) do { _Pragma("unroll") for (int _h = 0; _h < 2; ++_h) _Pragma("unroll") for (int _i = 0; _i < 2; ++_i) dst[_h][_i] = S.a_rowoff(u, ui, sR[_i] + _h * HALF) + (unsigned)sC[_i] * 2u; } while (0)
    Unit cur, nxt; int ui = 0;
    if (!S.next(0, cur)) return;
    int vrows = 256; if constexpr (Sched::RAGGED) vrows = S.rows(cur);
#define PG8_DO0 (!Sched::RAGGED || vrows > 64 || wr == 0)
#define PG8_DO1 (!Sched::RAGGED || vrows > 128)
    f32x4 acc[2][2][4][2];
#pragma unroll
    for (int a = 0; a < 2; ++a)
#pragma unroll
        for (int b = 0; b < 2; ++b)
#pragma unroll
            for (int m = 0; m < 4; ++m)
#pragma unroll
                for (int n = 0; n < 2; ++n) acc[a][b][m][n] = (f32x4){0.f, 0.f, 0.f, 0.f};
    bf16x8 At[4][2], B0[2][2], B1[2][2]; i32x8 At8[4], B08[2], B18[2];
    constexpr bool GA = Sched::GATHER;
    const unsigned fp8_unit_scale = 0x7f7f7f7fu;
    unsigned vAc[2][2], vAn[2][2];
    PG8_AOFFS(vAc, cur, 0);
    const size_t hstepA = GA ? 0 : (size_t)(vAc[1][0] - vAc[0][0]);
#define PG8_H1(v) (GA ? (v)[1] : (v)[0])
    const char* cA = S.a_base(cur); const char* cB = S.b_base(cur);
    PG8_STAGE(PG8_SB(0, 0), cB, voffB); PG8_STAGE(PG8_SB(0, 1), cB + hstepB, voffB); PG8_STAGE(PG8_SA(0, 0), cA, vAc[0]); PG8_STAGE(PG8_SA(0, 1), cA + hstepA, PG8_H1(vAc));
    if (wr == 1) PG8_BAR;
    PG8_WAIT_V(2); PG8_BAR;
    PG8_STAGE(PG8_SB(1, 0), cB + kstep, voffB); PG8_STAGE(PG8_SA(1, 0), cA + kstep, vAc[0]); PG8_STAGE(PG8_SB(1, 1), cB + hstepB + kstep, voffB);
    PG8_WAIT_V(6); PG8_BAR;
    for (;;) {
        const bool has_next = S.next(ui + 1, nxt);
        const char* nA = cA; const char* nB = cB;
        if (has_next) { nA = S.a_base(nxt); nB = S.b_base(nxt); if constexpr (GA) PG8_AOFFS(vAn, nxt, ui + 1); }
        else if constexpr (GA) {
#pragma unroll
            for (int _h = 0; _h < 2; ++_h)
#pragma unroll
                for (int _i = 0; _i < 2; ++_i) vAn[_h][_i] = vAc[_h][_i]; }
        for (int t = 0; t < nt; t += 2) {
            const bool last = (t == nt - 2);
            const char* a1 = cA + (size_t)(t + 1) * kstep;
            const char* a2 = last ? nA : cA + (size_t)(t + 2) * kstep; const char* b2 = last ? nB : cB + (size_t)(t + 2) * kstep;
            const char* a3 = a2 + kstep; const char* b3 = b2 + kstep;
            unsigned vS[2][2];
#pragma unroll
            for (int _h = 0; _h < 2; ++_h)
#pragma unroll
                for (int _i = 0; _i < 2; ++_i) vS[_h][_i] = (GA && last) ? vAn[_h][_i] : vAc[_h][_i];
            PG8_LDB(B0, 0, 0); PG8_LDB(B1, 0, 1); PG8_SCHED; PG8_LDA(At, 0, 0); PG8_STAGE(PG8_SA(1, 1), a1 + hstepA, PG8_H1(vAc));
            PG8_WAIT_V(8); PG8_WAIT_L(0); PG8_BAR; if (PG8_DO0) { PG8_MMA(0, 0, At, B0); PG8_MMA(0, 1, At, B1); } PG8_BAR; PG8_SCHED;
            PG8_LDA(At, 0, 1); PG8_STAGE(PG8_SB(0, 0), b2, voffB); PG8_STAGE(PG8_SB(0, 1), b2 + hstepB, voffB); PG8_STAGE(PG8_SA(0, 0), a2, vS[0]);
            PG8_WAIT_V(8); PG8_WAIT_L(0); PG8_BAR; if (PG8_DO1) { PG8_MMA(1, 0, At, B0); PG8_MMA(1, 1, At, B1); } PG8_BAR; PG8_SCHED;
            PG8_LDB(B0, 1, 0); PG8_LDB(B1, 1, 1); PG8_SCHED; PG8_LDA(At, 1, 0); PG8_STAGE(PG8_SA(0, 1), a2 + hstepA, PG8_H1(vS));
            PG8_WAIT_V(8); PG8_WAIT_L(0); PG8_BAR; if (PG8_DO0) { PG8_MMA(0, 0, At, B0); PG8_MMA(0, 1, At, B1); } PG8_BAR; PG8_SCHED;
            PG8_LDA(At, 1, 1); PG8_STAGE(PG8_SB(1, 0), b3, voffB); PG8_STAGE(PG8_SB(1, 1), b3 + hstepB, voffB); PG8_STAGE(PG8_SA(1, 0), a3, vS[0]);
            PG8_WAIT_V(8); PG8_WAIT_L(0); PG8_BAR; if (PG8_DO1) { PG8_MMA(1, 0, At, B0); PG8_MMA(1, 1, At, B1); } PG8_BAR; PG8_SCHED;
        }
        if constexpr (ALIGN_EPI) { if (wr == 0) PG8_BAR; }
        if constexpr (FP8) asm volatile("s_nop 15\n\ts_nop 15\n\ts_nop 15\n\ts_nop 15" ::: "memory");
        E(acc, cur, wr, wc, fr, fq);
        if (!has_next) break;
#pragma unroll
        for (int a = 0; a < 2; ++a)
#pragma unroll
            for (int b = 0; b < 2; ++b)
#pragma unroll
                for (int m = 0; m < 4; ++m)
#pragma unroll
                    for (int n = 0; n < 2; ++n) acc[a][b][m][n] = (f32x4){0.f, 0.f, 0.f, 0.f};
        cur = nxt; cA = nA; cB = nB; ++ui;
        if constexpr (Sched::RAGGED) vrows = S.rows(cur);
        if constexpr (GA) {
#pragma unroll
        for (int _h = 0; _h < 2; ++_h)
#pragma unroll
            for (int _i = 0; _i < 2; ++_i) vAc[_h][_i] = vAn[_h][_i]; }
        if constexpr (ALIGN_EPI) { if (wr == 1) PG8_BAR; }
    }
    PG8_WAIT_V(0);
    if constexpr (!ALIGN_EPI) { if (wr == 0) PG8_BAR; }
    PG8_BAR;
#undef PG8_SA
#undef PG8_SB
#undef PG8_STAGE
#undef PG8_LDA
#undef PG8_LDB
#undef PG8_MMA
#undef PG8_WAIT_V
#undef PG8_WAIT_L
#undef PG8_BAR
#undef PG8_SCHED
#undef PG8_AOFFS
#undef PG8_DO0
#undef PG8_DO1
#undef PG8_H1
}

#define XB_TMO      128
#define XB_XCNT(j)  (256  + 64 * (j))
#define XB_XSUB(j)  (1280 + 64 * (j))
#define XB_XGEN(j)  (2304 + 64 * (j))
#define XB_TOP      3328
#define XB_TOPGEN   3392
#define XCD_BAR_WORDS 3456
#define XB_SPIN_CAP (1u << 18)
__device__ __forceinline__ unsigned xb_ld(unsigned* p)              { return __hip_atomic_load(p, __ATOMIC_RELAXED, __HIP_MEMORY_SCOPE_AGENT); }
__device__ __forceinline__ unsigned xb_add(unsigned* p, unsigned v) { return __hip_atomic_fetch_add(p, v, __ATOMIC_RELAXED, __HIP_MEMORY_SCOPE_AGENT); }
__device__ __forceinline__ unsigned xb_xcc_id() { return (unsigned)__builtin_amdgcn_s_getreg((3 << 11) | 20) & 0xFu; }
#define XB_SPIN(cond, bar) do { unsigned _sp = 0; while (cond) { __builtin_amdgcn_s_sleep(1); \
    if ((++_sp & 255u) == 0u) { if (xb_ld(&(bar)[XB_TMO])) break; if (_sp > XB_SPIN_CAP) { atomicAdd(&(bar)[XB_TMO], 1u); break; } } } } while (0)
struct XcdBarrier { unsigned* bar; unsigned x; volatile LAS unsigned* st; unsigned total; };
__device__ __forceinline__ XcdBarrier xcd_barrier_post(unsigned* bar, volatile LAS unsigned* st, unsigned total) {
    XcdBarrier b; b.bar = bar; b.x = xb_xcc_id(); b.st = st; b.total = total;
    if (threadIdx.x == 0) (void)xb_add(&bar[XB_XCNT(b.x)], 1u);
    return b;
}
__device__ __forceinline__ void xcd_barrier_complete(unsigned* bar, unsigned x, unsigned G, unsigned& nloc, unsigned& nx) {
    unsigned sum, cnt, mine, sp = 0u;
    for (;;) {
        sum = 0u; cnt = 0u; mine = 0u;
#pragma unroll
        for (unsigned j = 0; j < 16; ++j) { const unsigned c = xb_ld(&bar[XB_XCNT(j)]); sum += c; cnt += (c > 0u) ? 1u : 0u; mine = (j == x) ? c : mine; }
        if (sum == G) break;
        __builtin_amdgcn_s_sleep(1);
        if ((++sp & 255u) == 0u) { if (xb_ld(&bar[XB_TMO])) break; if (sp > XB_SPIN_CAP) { atomicAdd(&bar[XB_TMO], 1u); break; } }
    }
    nloc = mine > 0u ? mine : 1u; nx = cnt > 0u ? cnt : 1u;
}
__device__ __forceinline__ void xcd_barrier(const XcdBarrier& b) {
    asm volatile("s_waitcnt vmcnt(0)" ::: "memory");
    __syncthreads();
    if (threadIdx.x == 0) {
        unsigned* bar = b.bar;
        __builtin_amdgcn_s_waitcnt(0);
        unsigned nloc = b.st[0], nx = b.st[1];
        if (nloc == 0u) { xcd_barrier_complete(bar, b.x, b.total, nloc, nx); b.st[0] = nloc; b.st[1] = nx; }
        const unsigned old = xb_add(&bar[XB_XSUB(b.x)], 1u);
        const unsigned gen = old / nloc;
        if (old + 1u == (gen + 1u) * nloc) {
            __builtin_amdgcn_fence(__ATOMIC_RELEASE, "agent");
            asm volatile("s_waitcnt vmcnt(0)" ::: "memory");
            const unsigned og = xb_add(&bar[XB_TOP], 1u);
            const unsigned tg = og / nx;
            if (og + 1u == (tg + 1u) * nx) xb_add(&bar[XB_TOPGEN], 1u);
            else XB_SPIN(xb_ld(&bar[XB_TOPGEN]) == tg, bar);
            __builtin_amdgcn_fence(__ATOMIC_ACQUIRE, "agent");
            xb_add(&bar[XB_XGEN(b.x)], 1u);
            asm volatile("s_waitcnt vmcnt(0)" ::: "memory");
        } else {
            XB_SPIN(xb_ld(&bar[XB_XGEN(b.x)]) == gen, bar);
            __builtin_amdgcn_fence(__ATOMIC_ACQUIRE, "agent");
            asm volatile("s_waitcnt vmcnt(0)" ::: "memory");
        }
    }
    __syncthreads();
}
}
namespace mk {
constexpr size_t MiB = 1ull << 20;
constexpr size_t WS_CTL = 0, CTL_ZERO_BYTES = 65536;
constexpr size_t WS_MOD = 1 * MiB, WS_COS = 2 * MiB, WS_SIN = 3 * MiB, WS_LOGF = 4 * MiB, WS_CUM = 5 * MiB, WS_TEID = 6 * MiB, WS_TPOS = 6 * MiB + 512 * 1024, WS_TGATE = 7 * MiB, WS_BINP = 7 * MiB + 512 * 1024,
                 WS_TOKOF = 8 * MiB  , WS_XN = 16 * MiB  , WS_WIN = 48 * MiB  , WS_WAB = 84 * MiB  , WS_WOUT = 92 * MiB  , WS_QA = 100 * MiB  , WS_KA = 116 * MiB  ,
                 WS_VA = 120 * MiB  , WS_QB = 124 * MiB  , WS_KB = 140 * MiB, WS_VB = 156 * MiB, WS_SGA = 172 * MiB  , WS_SGB = 204 * MiB  , WS_YAB = 236 * MiB  ,
                 WS_T1 = 268 * MiB  , WS_MERGED = 332 * MiB  , WS_H1 = 364 * MiB  , WS_XN2 = 428 * MiB  , WS_ACT = 460 * MiB  , WS_YS = 620 * MiB  ,
                 WS_WGU = 780 * MiB  , WS_WD = 1292 * MiB  , WS_JUNK = 1548 * MiB  , WS_END = 1580 * MiB;
constexpr int CW_CNT = 1024;
constexpr int CW_BAR = 4096;
constexpr int CW_BAR2 = 8192;
constexpr int CW_CQ = 2048;
constexpr int CW_AQ = 2112;
constexpr int CW_SFLAG = 2560;
#ifndef CONV_MODE
#define CONV_MODE 0
#endif
#ifndef NCOMP_DEF
#define NCOMP_DEF 156
#endif
constexpr int NCOMP = NCOMP_DEF;
constexpr int RING_OFF = 0, RING_BYTES = 131072;
constexpr int TBL_OFF = RING_BYTES;
constexpr int MISC_OFF = TBL_OFF + 10240;
constexpr int LDS_BYTES = 147456;
static_assert(MISC_OFF + 1024 <= LDS_BYTES, "LDS map");
constexpr int NWAVES = 8;
constexpr bool MOE_FP8 = true;
constexpr float WSCALE = 32.0f, WSCALE_INV = 1.0f / 32.0f;
constexpr bool MIX_FP8 = true;
constexpr int MIX_EB = MIX_FP8 ? 1 : 2;
#ifndef P5_FP8_DEF
#define P5_FP8_DEF 1
#endif
constexpr bool P5_FP8 = MIX_FP8 && P5_FP8_DEF;
constexpr int P5_EB = P5_FP8 ? 1 : 2;
constexpr int MOE_EB = MOE_FP8 ? 1 : 2;

struct Frame {
    LAS unsigned char* lds; volatile LAS unsigned* MISC; unsigned* ctl;
    int tid, lane, wave, vcu, G;
    const float *x, *c, *w_ada, *b_ada, *g_mix, *w_in, *b_in, *sinks, *w_a, *w_b, *w_out, *g_ffn, *w_r, *b_r, *w_gu, *b_gu, *w_dn, *b_dn, *g_fin; const int* pos;
    float* out; unsigned char* ws;
};
__device__ __forceinline__ void refresh(Frame& F) { F.lane = lane_id(); F.tid = F.wave * 64 + F.lane; }
template <class T> __device__ __forceinline__ T* wsp(const Frame& F, size_t off) { return (T*)(F.ws + off); }

__device__ __forceinline__ float wave_sum(float v) {
#pragma unroll
    for (int o = 1; o < 64; o <<= 1) v += __shfl_xor(v, o);
    return v;
}

struct DenseSched {
    static constexpr bool GATHER = false, RAGGED = false;
    const char* A; const char* Bt; unsigned lda2, ldb2; int K; int nM, nN, nwg, G, c;
    __device__ __forceinline__ void init(const void* A_, unsigned lda2_, const void* Bt_, unsigned ldb2_, int K_, int M, int N, int G_, int c_) {
        A = (const char*)A_; Bt = (const char*)Bt_; lda2 = lda2_; ldb2 = ldb2_; K = K_; nM = M / BM; nN = N / BM; nwg = nM * nN; G = G_; c = c_; }
    __device__ __forceinline__ bool tile(long L, Unit& u) const {
        if (L >= nwg) return false;
        int wgid = (int)L; { const int q = nwg / NXCD, r = nwg % NXCD, xcd = wgid % NXCD, off = wgid / NXCD; wgid = (xcd < r ? xcd * (q + 1) : r * (q + 1) + (xcd - r) * q) + off; }
        const int nig = WGM * nN, gid = wgid / nig, fm = gid * WGM, gsz = (nM - fm) < WGM ? (nM - fm) : WGM;
        u.pm = fm + ((wgid % nig) % gsz); u.pn = (wgid % nig) / gsz; u.aux = 0; return true; }
    __device__ __forceinline__ bool next(int i, Unit& u) const { return tile((long)i * G + c, u); }
    __device__ __forceinline__ const char* a_base(const Unit& u) const { return A + (size_t)u.pm * BM * lda2; }
    __device__ __forceinline__ unsigned a_rowoff(const Unit&, int, int R) const { return (unsigned)R * lda2; }
    __device__ __forceinline__ const char* b_base(const Unit& u) const { return Bt + (size_t)u.pn * BM * ldb2; }
};
struct BranchSched {
    static constexpr bool GATHER = false, RAGGED = false;
    DenseSched d; unsigned ldb2; int K;
    __device__ __forceinline__ bool next(int i, Unit& u) const { if (!d.tile((long)(i >> 1) * d.G + d.c, u)) return false; u.aux = i & 1; return true; }
    __device__ __forceinline__ const char* a_base(const Unit& u) const { return d.A + (size_t)u.pm * BM * (2048 * MIX_EB) + (size_t)u.aux * (1024 * MIX_EB); }
    __device__ __forceinline__ unsigned a_rowoff(const Unit&, int, int R) const { return (unsigned)R * (2048u * MIX_EB); }
    __device__ __forceinline__ const char* b_base(const Unit& u) const { return d.Bt + ((size_t)u.aux * 2048 + (size_t)u.pn * BM) * (1024 * MIX_EB); }
};
template <bool GATHER_>
struct MoeSched {
    static constexpr bool GATHER = GATHER_, gather = GATHER_, RAGGED = true;
    const volatile LAS unsigned* cnt;
    __device__ __forceinline__ int rows(const Unit& u) const { const int r = (int)cnt[u.aux] - (u.pm - (int)tpre[u.aux]) * 256; return r < 256 ? r : 256; }
    const volatile LAS unsigned* tpre; const LAS unsigned* tbl; const char* A; const char* Bt; int NN; unsigned ldb2; int K; int G, vcu;
    size_t b_estride;
    const volatile LAS unsigned* hpre; const volatile LAS unsigned* lexp; int nlight;
    __device__ __forceinline__ bool next(int i, Unit& u) const {
        const int L = i * G + vcu; const int NH = NN * (int)hpre[32];
        if (L < NH) {
            int e = 0;
            for (int j = 1; j < 32; ++j) if (NN * (int)hpre[j] <= L) e = j;
            const int l = L - NN * (int)hpre[e], T = (int)hpre[e + 1] - (int)hpre[e];
            u.pn = l / T; u.pm = (int)tpre[e] + (l - u.pn * T); u.aux = e; return true; }
        const int l2 = L - NH, j = l2 / NN; if (j >= nlight) return false;
        const int e = (int)lexp[j]; u.pn = l2 - j * NN; u.pm = (int)tpre[e + 1] - 1; u.aux = e; return true; }
    __device__ __forceinline__ const char* a_base(const Unit& u) const { return gather ? A : A + (size_t)u.pm * BM * (2048 * MOE_EB); }
    __device__ __forceinline__ unsigned a_rowoff(const Unit&, int ui, int R) const { return gather ? tbl[ui * 256 + R] : (unsigned)R * (2048u * MOE_EB); }
    __device__ __forceinline__ const char* b_base(const Unit& u) const { return Bt + (size_t)u.aux * b_estride + (size_t)u.pn * BM * ldb2; }
};

__device__ __forceinline__ void st8bf(bf16_t* p, f32x4 a, f32x4 b) { u32x4 w; w.x = pk2(a[0], a[1]); w.y = pk2(a[2], a[3]); w.z = pk2(b[0], b[1]); w.w = pk2(b[2], b[3]); *(u32x4*)p = w; }
struct EpiInProj {
    static constexpr bool PERM = true;
    bf16_t *QA, *KA, *VA, *QB, *KB, *VB, *SGA, *SGB; const float* bias; const float* cosT; const float* sinT;
    __device__ __forceinline__ void operator()(const f32x4 (&acc)[2][2][4][2], const Unit& u, int wr, int wc, int fr, int fq) const {
        const int pn = u.pn, row0 = u.pm * BM + wr * 64 + fr, cw = wc * 32 + 8 * fq;
        const float ws = MIX_FP8 ? WSCALE_INV : 1.0f;
        f32x4 bv[2][2];
#pragma unroll
        for (int bj = 0; bj < 2; ++bj)
#pragma unroll
            for (int n = 0; n < 2; ++n) bv[bj][n] = *(const f32x4*)(bias + pn * 256 + bj * 128 + cw + 4 * n);
        if (pn < 5) {
            bf16_t* O = pn < 4 ? QA : KA; const int ldo = pn < 4 ? 1024 : 256; const int hcol = (pn < 4 ? pn * 256 : 0) + wc * 64 + 8 * fq; const float qs = pn < 4 ? QSCALE : 1.0f;
#pragma unroll
            for (int ai = 0; ai < 2; ++ai)
#pragma unroll
                for (int m = 0; m < 4; ++m) { const int row = row0 + ai * HALF + m * 16;
                    f32x4 o1[2], o2[2];
#pragma unroll
                    for (int n = 0; n < 2; ++n) { const f32x4 cs = *(const f32x4*)(cosT + (size_t)row * 32 + 8 * fq + 4 * n), sn = *(const f32x4*)(sinT + (size_t)row * 32 + 8 * fq + 4 * n);
                        const f32x4 x1 = acc[ai][0][m][n] * ws + bv[0][n], x2 = acc[ai][1][m][n] * ws + bv[1][n];
                        o1[n] = (x1 * cs - x2 * sn) * qs; o2[n] = (x2 * cs + x1 * sn) * qs; }
                    bf16_t* rp = O + (size_t)row * ldo + hcol; st8bf(rp, o1[0], o1[1]); st8bf(rp + 32, o2[0], o2[1]); }
        } else if (pn < 18) {
            bf16_t* O; int ldo, col0; float sc = 1.0f;
            if (pn == 5) { O = VA; ldo = 256; col0 = 0; } else if (pn < 10) { O = QB; ldo = 1024; col0 = (pn - 6) * 256; sc = QSCALE; } else if (pn < 14) { O = KB; ldo = 1024; col0 = (pn - 10) * 256; } else { O = VB; ldo = 1024; col0 = (pn - 14) * 256; }
#pragma unroll
            for (int ai = 0; ai < 2; ++ai)
#pragma unroll
                for (int m = 0; m < 4; ++m) { bf16_t* rp = O + (size_t)(row0 + ai * HALF + m * 16) * ldo + col0 + cw;
#pragma unroll
                    for (int bj = 0; bj < 2; ++bj) st8bf(rp + bj * HALF, (acc[ai][bj][m][0] * ws + bv[bj][0]) * sc, (acc[ai][bj][m][1] * ws + bv[bj][1]) * sc); }
        } else {
            bf16_t* O = pn < 26 ? SGA : SGB; const int col0 = ((pn - 18) & 7) * 256;
#pragma unroll
            for (int ai = 0; ai < 2; ++ai)
#pragma unroll
                for (int m = 0; m < 4; ++m) { bf16_t* rp = O + (size_t)(row0 + ai * HALF + m * 16) * 2048 + col0 + cw;
#pragma unroll
                    for (int bj = 0; bj < 2; ++bj) { f32x4 a = acc[ai][bj][m][0] * ws + bv[bj][0], b = acc[ai][bj][m][1] * ws + bv[bj][1];
#pragma unroll
                        for (int j = 0; j < 4; ++j) { a[j] = fast_sigmoid(a[j]); b[j] = fast_sigmoid(b[j]); }
                        st8bf(rp + bj * HALF, a, b); } }
        }
    }
};
struct EpiBranch {
    static constexpr bool PERM = true;
    const bf16_t *SGA, *SGB; float* T1; unsigned char* MERGED;
    __device__ __forceinline__ void operator()(const f32x4 (&acc)[2][2][4][2], const Unit& u, int wr, int wc, int fr, int fq) const {
        const int row0 = u.pm * BM + wr * 64 + fr, col0 = u.pn * BM + wc * 32 + 8 * fq;
        const bf16_t* SG = u.aux ? SGB : SGA;
#pragma unroll
        for (int ai = 0; ai < 2; ++ai)
#pragma unroll
            for (int m = 0; m < 4; ++m) { const size_t off = (size_t)(row0 + ai * HALF + m * 16) * 2048 + col0;
#pragma unroll
                for (int bj = 0; bj < 2; ++bj) { const u32x4 g = *(const u32x4*)(SG + off + bj * HALF);
                    const f32x4 g0 = {bflo(g.x), bfhi(g.x), bflo(g.y), bfhi(g.y)}, g1 = {bflo(g.z), bfhi(g.z), bflo(g.w), bfhi(g.w)};
                    const float ws = MIX_FP8 ? WSCALE_INV : 1.0f;
                    f32x4 a = acc[ai][bj][m][0] * g0 * ws, b = acc[ai][bj][m][1] * g1 * ws;
                    bf16_t* tp = (bf16_t*)T1 + off + bj * HALF;
                    if (u.aux == 0) { st8bf(tp, a, b); }
                    else { const u32x4 t = *(const u32x4*)tp; a += (f32x4){bflo(t.x), bfhi(t.x), bflo(t.y), bfhi(t.y)}; b += (f32x4){bflo(t.z), bfhi(t.z), bflo(t.w), bfhi(t.w)};
                        if constexpr (P5_FP8) { u32x2 w; w.x = pk4_fp8(a[0], a[1], a[2], a[3]); w.y = pk4_fp8(b[0], b[1], b[2], b[3]); *(u32x2*)(MERGED + off + bj * HALF) = w; }
                        else st8bf((bf16_t*)MERGED + off + bj * HALF, a, b); } } }
    }
};
struct EpiOut {
    static constexpr bool PERM = false;
    const float* x; const float* mod; float* H1;
    __device__ __forceinline__ void operator()(const f32x4 (&acc)[2][2][4][2], const Unit& u, int wr, int wc, int fr, int fq) const {
        const int row0 = u.pm * BM + wr * 64 + fr, col0 = u.pn * BM + wc * 32 + 4 * fq; const float* gt = mod + (size_t)(u.pm >> 3) * MODW + 4096;
#pragma unroll
        for (int bj = 0; bj < 2; ++bj)
#pragma unroll
            for (int n = 0; n < 2; ++n) { const int col = col0 + bj * HALF + n * 16; const f32x4 g = *(const f32x4*)(gt + col);
#pragma unroll
                for (int ai = 0; ai < 2; ++ai)
#pragma unroll
                    for (int m = 0; m < 4; ++m) { const size_t off = (size_t)(row0 + ai * HALF + m * 16) * 2048 + col; *(f32x4*)(H1 + off) = *(const f32x4*)(x + off) + g * (acc[ai][bj][m][n] * (P5_FP8 ? WSCALE_INV : 1.0f)); } }
    }
};
struct EpiGU {
    static constexpr bool PERM = true;
    const float* b_gu; unsigned char* ACT;
    __device__ __forceinline__ void operator()(const f32x4 (&acc)[2][2][4][2], const Unit& u, int wr, int wc, int fr, int fq) const {
        const int row0 = u.pm * BM + wr * 64 + fr, cw = wc * 32 + 8 * fq; const float* bg = b_gu + (size_t)u.aux * 4096 + u.pn * 128 + cw;
        const float ws = MOE_FP8 ? WSCALE_INV : 1.0f;
        f32x4 bv[2][2];
#pragma unroll
        for (int bj = 0; bj < 2; ++bj)
#pragma unroll
            for (int n = 0; n < 2; ++n) bv[bj][n] = *(const f32x4*)(bg + bj * 2048 + 4 * n);
#pragma unroll
        for (int ai = 0; ai < 2; ++ai)
#pragma unroll
            for (int m = 0; m < 4; ++m) { f32x4 o[2];
#pragma unroll
                for (int n = 0; n < 2; ++n) { const f32x4 g = acc[ai][0][m][n] * ws + bv[0][n], l = acc[ai][1][m][n] * ws + bv[1][n];
#pragma unroll
                    for (int j = 0; j < 4; ++j) { const float gg = fminf(g[j], 7.0f), ll = fminf(fmaxf(l[j], -7.0f), 7.0f);
                        o[n][j] = gg * (ll + 1.0f) * __builtin_amdgcn_rcpf(1.0f + __builtin_amdgcn_exp2f(-1.702f * LOG2E * gg)); } }
                const size_t eo = (size_t)(row0 + ai * HALF + m * 16) * 2048 + u.pn * 128 + cw;
                if constexpr (MOE_FP8) { u32x2 w; w.x = pk4_fp8(o[0][0], o[0][1], o[0][2], o[0][3]); w.y = pk4_fp8(o[1][0], o[1][1], o[1][2], o[1][3]); *(u32x2*)(ACT + eo) = w; }
                else st8bf((bf16_t*)ACT + eo, o[0], o[1]); }
    }
};
struct EpiDown {
    static constexpr bool PERM = true;
    const float* b_dn; bf16_t* YS;
    __device__ __forceinline__ void operator()(const f32x4 (&acc)[2][2][4][2], const Unit& u, int wr, int wc, int fr, int fq) const {
        const int row0 = u.pm * BM + wr * 64 + fr, col0 = u.pn * BM + wc * 32 + 8 * fq; const float* bd = b_dn + (size_t)u.aux * 2048 + col0;
        const float ws = MOE_FP8 ? WSCALE_INV : 1.0f;
        f32x4 bv[2][2];
#pragma unroll
        for (int bj = 0; bj < 2; ++bj)
#pragma unroll
            for (int n = 0; n < 2; ++n) bv[bj][n] = *(const f32x4*)(bd + bj * HALF + 4 * n);
#pragma unroll
        for (int ai = 0; ai < 2; ++ai)
#pragma unroll
            for (int m = 0; m < 4; ++m) { bf16_t* rp = YS + (size_t)(row0 + ai * HALF + m * 16) * 2048 + col0;
#pragma unroll
                for (int bj = 0; bj < 2; ++bj) st8bf(rp + bj * HALF, acc[ai][bj][m][0] * ws + bv[bj][0], acc[ai][bj][m][1] * ws + bv[bj][1]); }
    }
};

__device__ __forceinline__ int in_src(int r) { const int pn = r >> 8, c = r & 255; if (pn < 5) return pn * 256 + ((c & 127) >> 5) * 64 + (c >> 7) * 32 + (c & 31); return pn < 18 ? r : r + 16; }
__device__ __forceinline__ void transpose_item(const float* __restrict__ W, size_t ldw, int k0, int src0, int src1, bf16_t* __restrict__ WT, size_t ldk, int dst0, LAS unsigned* scr, int lane) {
    const int lg = lane >> 4, lc = lane & 15;
    const int scol = (lc < 8 ? src0 : src1 - 32) + 4 * lc;
    f32x4 v[8][2];
#pragma unroll
    for (int i = 0; i < 8; ++i)
#pragma unroll
        for (int p = 0; p < 2; ++p) v[i][p] = *(const f32x4*)(W + (size_t)(k0 + 8 * i + 2 * lg + p) * ldw + scol);
#pragma unroll
    for (int i = 0; i < 8; ++i)
#pragma unroll
        for (int c = 0; c < 4; ++c) scr[(4 * lc + c) * 33 + 4 * i + lg] = pk2(v[i][0][c], v[i][1][c]);
    asm volatile("s_waitcnt lgkmcnt(0)" ::: "memory");
    const int rn = lane >> 3, ch = lane & 7;
#pragma unroll
    for (int j = 0; j < 8; ++j) { const int n = rn + 8 * j; const LAS unsigned* s = scr + n * 33 + 4 * ch; u32x4 o; o.x = s[0]; o.y = s[1]; o.z = s[2]; o.w = s[3];
        *(u32x4*)(WT + (size_t)(dst0 + n) * ldk + k0 + 8 * ch) = o; }
    asm volatile("s_waitcnt lgkmcnt(0)" ::: "memory");
}
__device__ __forceinline__ void transpose_item_f8(const float* __restrict__ W, size_t ldw, int k0, int src0, int src1, unsigned char* __restrict__ WT, size_t ldk, int dst0, LAS unsigned* scr, int lane, float scale) {
    const int lg = lane >> 4, lc = lane & 15;
    const float* wp = W + (size_t)(k0 + 4 * lg) * ldw + (lc < 8 ? src0 : src1 - 32) + 4 * lc;
#pragma unroll
    for (int hf = 0; hf < 2; ++hf) {
        f32x4 v[4][4];
#pragma unroll
        for (int i = 0; i < 4; ++i)
#pragma unroll
            for (int p = 0; p < 4; ++p) v[i][p] = *(const f32x4*)(wp + (size_t)(64 * hf + 16 * i + p) * ldw);
#pragma unroll
        for (int i = 0; i < 4; ++i)
#pragma unroll
            for (int c = 0; c < 4; ++c) scr[(4 * lc + c) * 33 + 16 * hf + 4 * i + lg] = pk4_fp8_raw(v[i][0][c] * scale, v[i][1][c] * scale, v[i][2][c] * scale, v[i][3][c] * scale);
    }
    asm volatile("s_waitcnt lgkmcnt(0)" ::: "memory");
    const int rn = lane >> 3, ch = lane & 7;
#pragma unroll
    for (int j = 0; j < 8; ++j) { const int n = rn + 8 * j; const LAS unsigned* s = scr + n * 33 + 4 * ch; u32x4 o; o.x = s[0]; o.y = s[1]; o.z = s[2]; o.w = s[3];
        *(u32x4*)(WT + (size_t)(dst0 + n) * ldk + k0 + 16 * ch) = o; }
    asm volatile("s_waitcnt lgkmcnt(0)" ::: "memory");
}
constexpr int P0_KD = MIX_FP8 ? 128 : 64;
constexpr int P0_T_HEAD = 768 + 256 + 1, P0_T_ALL = P0_T_HEAD + (2048 / P0_KD) * 136 + 2 * (1024 / P0_KD) * 32 + (2048 / P0_KD) * 32;
__device__ __forceinline__ void p0_prologue(Frame& F, const int t_lo, const int t_hi, const int gw_, const int NGW_) {
    refresh(F);
    LAS unsigned* scr = (LAS unsigned*)(F.lds + RING_OFF + F.wave * 8448);
    LAS f32x4* ca = (LAS f32x4*)(F.lds + RING_OFF + 69632);
    for (int k = F.tid; k < 2048; k += NWAVES * 64) { f32x4 v;
#pragma unroll
        for (int b = 0; b < 4; ++b) { const float cv = F.c[b * 2048 + k]; v[b] = cv / (1.0f + expf(-cv)); }
        ca[k] = v; }
    __syncthreads();
    const int gw = gw_, NGW = NGW_, lane = F.lane;
    constexpr int KD = P0_KD;
    constexpr int T_ADA = 768, T_ROPE = 256, T_BIAS = 1, T_WIN = (2048 / KD) * 136, T_WA = (1024 / KD) * 32, T_WB = (1024 / KD) * 32, T_WOUT = (2048 / KD) * 32;
    constexpr int NT = T_ADA + T_ROPE + T_BIAS + T_WIN + T_WA + T_WB + T_WOUT;
    static_assert(NT == P0_T_ALL && T_ADA + T_ROPE + T_BIAS == P0_T_HEAD, "prologue task list");
    float* mod = wsp<float>(F, WS_MOD); float* cosT = wsp<float>(F, WS_COS); float* sinT = wsp<float>(F, WS_SIN); float* binp = wsp<float>(F, WS_BINP);
    for (int it = t_lo + gw; it < t_hi; it += NGW) {
        int r = it;
        if (r < T_ADA) {
            const int j0 = 16 * r, cl = lane & 3, kr = lane >> 2;
            f32x4 a[4];
#pragma unroll
            for (int b = 0; b < 4; ++b) a[b] = (f32x4){0.f, 0.f, 0.f, 0.f};
            const float* wp = F.w_ada + (size_t)kr * MODW + j0 + 4 * cl;
#pragma unroll 8
            for (int s = 0; s < 128; ++s) { const f32x4 w4 = *(const f32x4*)(wp + (size_t)s * 16 * MODW); const f32x4 c4 = ca[16 * s + kr];
#pragma unroll
                for (int b = 0; b < 4; ++b) a[b] += w4 * c4[b]; }
#pragma unroll
            for (int b = 0; b < 4; ++b)
#pragma unroll
                for (int c = 0; c < 4; ++c) { float v = a[b][c]; v += __shfl_xor(v, 4); v += __shfl_xor(v, 8); v += __shfl_xor(v, 16); v += __shfl_xor(v, 32); a[b][c] = v; }
            if (kr == 0) { const f32x4 bb = *(const f32x4*)(F.b_ada + j0 + 4 * cl);
#pragma unroll
                for (int b = 0; b < 4; ++b) *(f32x4*)(mod + b * MODW + j0 + 4 * cl) = a[b] + bb; }
            continue; } r -= T_ADA;
        if (r < T_ROPE) {
            const int i = lane & 31, ts = lane >> 5; const float inv = 1.0f / powf(10000.0f, (float)(2 * i) / 64.0f);
            for (int j = 0; j < 16; ++j) { const int t = 32 * r + 2 * j + ts; const float ang = (float)F.pos[t] * inv; cosT[t * 32 + i] = cosf(ang); sinT[t * 32 + i] = sinf(ang); }
            continue; } r -= T_ROPE;
        if (r < T_BIAS) { for (int q = lane; q < 8704; q += 64) binp[q] = F.b_in[in_src(q)]; continue; } r -= T_BIAS;
        const float* W; size_t ldw; int kb, nb, s0, s1; unsigned char* WT; size_t ldk;
        if (r < T_WIN) { kb = r / 136; nb = r % 136; W = F.w_in; ldw = INW; s0 = in_src(64 * nb); s1 = in_src(64 * nb + 32); WT = wsp<unsigned char>(F, WS_WIN); ldk = 2048; }
        else if ((r -= T_WIN) < T_WA) { kb = r / 32; nb = r % 32; W = F.w_a; ldw = 2048; s0 = 64 * nb; s1 = s0 + 32; WT = wsp<unsigned char>(F, WS_WAB); ldk = 1024; }
        else if ((r -= T_WA) < T_WB) { kb = r / 32; nb = r % 32; W = F.w_b; ldw = 2048; s0 = 64 * nb; s1 = s0 + 32; WT = wsp<unsigned char>(F, WS_WAB) + (size_t)2048 * 1024 * MIX_EB; ldk = 1024; }
        else { r -= T_WB; W = F.w_out; ldw = 2048; WT = wsp<unsigned char>(F, WS_WOUT); ldk = 2048;
            if constexpr (MIX_FP8 && !P5_FP8) { kb = r / 32; nb = r % 32; s0 = 64 * nb; s1 = s0 + 32;
                transpose_item(W, ldw, 128 * kb, s0, s1, (bf16_t*)WT, ldk, 64 * nb, scr, lane); transpose_item(W, ldw, 128 * kb + 64, s0, s1, (bf16_t*)WT, ldk, 64 * nb, scr, lane); continue; }
            kb = r / 32; nb = r % 32; s0 = 64 * nb; s1 = s0 + 32; }
        if constexpr (MIX_FP8) transpose_item_f8(W, ldw, 128 * kb, s0, s1, WT, ldk, 64 * nb, scr, lane, WSCALE);
        else transpose_item(W, ldw, 64 * kb, s0, s1, (bf16_t*)WT, ldk, 64 * nb, scr, lane);
    }
}
constexpr int T_WGU = MOE_FP8 ? 32 * 16 * 64 : 32 * 32 * 64, T_WD = MOE_FP8 ? 32 * 16 * 32 : 32 * 32 * 32;
__device__ __forceinline__ void convert_item(Frame& F, int r, LAS unsigned* scr, int lane) {
    if (r < T_WGU) {
        if constexpr (MOE_FP8) { const int e = r >> 10, q = r & 1023, kb = q >> 6, nb = q & 63; const int r0 = 64 * nb, src = ((r0 & 255) >> 7) * 2048 + (r0 >> 8) * 128 + (r0 & 127);
            transpose_item_f8(F.w_gu + (size_t)e * 2048 * 4096, 4096, 128 * kb, src, src + 32, wsp<unsigned char>(F, WS_WGU) + (size_t)e * 4096 * 2048, 2048, r0, scr, lane, WSCALE); }
        else { const int e = r >> 11, q = r & 2047, kb = q >> 6, nb = q & 63; const int r0 = 64 * nb, src = ((r0 & 255) >> 7) * 2048 + (r0 >> 8) * 128 + (r0 & 127);
            transpose_item(F.w_gu + (size_t)e * 2048 * 4096, 4096, 64 * kb, src, src + 32, wsp<bf16_t>(F, WS_WGU) + (size_t)e * 4096 * 2048, 2048, r0, scr, lane); }
        return; }
    r -= T_WGU;
    if constexpr (MOE_FP8) { const int e = r >> 9, q = r & 511, kb = q >> 5, nb = q & 31;
        transpose_item_f8(F.w_dn + (size_t)e * 2048 * 2048, 2048, 128 * kb, 64 * nb, 64 * nb + 32, wsp<unsigned char>(F, WS_WD) + (size_t)e * 2048 * 2048, 2048, 64 * nb, scr, lane, WSCALE); }
    else { const int e = r >> 10, q = r & 1023, kb = q >> 5, nb = q & 31;
        transpose_item(F.w_dn + (size_t)e * 2048 * 2048, 2048, 64 * kb, 64 * nb, 64 * nb + 32, wsp<bf16_t>(F, WS_WD) + (size_t)e * 2048 * 2048, 2048, 64 * nb, scr, lane); }
}
struct CvItem { const char* src; unsigned char* dst; };
template <bool GU> __device__ __forceinline__ CvItem cv_decode(Frame& F, int r) {
    constexpr int N = GU ? T_WGU : T_WD; constexpr size_t ldw = GU ? 4096 : 2048;
    r = r < N ? r : 0;
    const int e = r >> (GU ? 10 : 9), q = r & (GU ? 1023 : 511), kb = q >> (GU ? 6 : 5), nb = q & (GU ? 63 : 31), r0 = 64 * nb;
    const int srcc = GU ? ((r0 & 255) >> 7) * 2048 + (r0 >> 8) * 128 + (r0 & 127) : r0;
    CvItem P;
    P.src = (const char*)((GU ? F.w_gu : F.w_dn) + (size_t)e * 2048 * ldw + (size_t)(128 * kb) * ldw + srcc);
    P.dst = (GU ? wsp<unsigned char>(F, WS_WGU) : wsp<unsigned char>(F, WS_WD)) + (size_t)e * ldw * 2048 + (size_t)r0 * 2048 + 128 * kb;
    return P;
}
template <bool GU> __device__ __forceinline__ void convert_loop(Frame& F, unsigned* head) {
    constexpr int N = GU ? T_WGU : T_WD, NP = (N + 2) / 3 * 3; constexpr unsigned ldwb = (GU ? 4096u : 2048u) * 4u;
    LAS unsigned* scr = (LAS unsigned*)(F.lds + RING_OFF + F.wave * 8448);
    const int lane = F.lane, lg = lane >> 4, lc = lane & 15, rn = lane >> 3, ch = lane & 7;
    const unsigned lo = (unsigned)(4 * lg) * ldwb + 16u * (unsigned)lc;
    f32x4 A[4][4], B[4][4], C[4][4];
#define CV_LOAD(buf, P, h) do { _Pragma("unroll") for (int i = 0; i < 4; ++i) _Pragma("unroll") for (int p = 0; p < 4; ++p) { const char* rb_ = (P).src + (size_t)(64 * (h) + 16 * i + p) * ldwb; \
        asm volatile("global_load_dwordx4 %0, %1, %2 nt" : "=v"(buf[i][p]) : "v"(lo), "s"(rb_) : "memory"); } } while (0)
#define CV_WAIT(N, buf) do { asm volatile("s_waitcnt vmcnt(" #N ")" ::: "memory"); _Pragma("unroll") for (int i = 0; i < 4; ++i) asm volatile("" : "+v"(buf[i][0]), "+v"(buf[i][1]), "+v"(buf[i][2]), "+v"(buf[i][3])); } while (0)
#define CV_PROC(buf, h) do { _Pragma("unroll") for (int i = 0; i < 4; ++i) _Pragma("unroll") for (int c = 0; c < 4; ++c) \
        scr[(4 * lc + c) * 33 + 16 * (h) + 4 * i + lg] = pk4_fp8_raw(buf[i][0][c] * WSCALE, buf[i][1][c] * WSCALE, buf[i][2][c] * WSCALE, buf[i][3][c] * WSCALE); } while (0)
#define CV_STORE(P) do { _Pragma("unroll") for (int j = 0; j < 8; ++j) { const LAS unsigned* s_ = scr + (rn + 8 * j) * 33 + 4 * ch; u32x4 o_; o_.x = s_[0]; o_.y = s_[1]; o_.z = s_[2]; o_.w = s_[3]; \
        const unsigned so_ = (unsigned)(rn + 8 * j) * 2048u + 16u * (unsigned)ch; asm volatile("global_store_dwordx4 %0, %1, %2 nt" :: "v"(so_), "v"(o_), "s"((P).dst) : "memory"); } } while (0)
    const unsigned claim_add = 3u, claim_off = 0u; unsigned long long ex_save;
#define CV_CLAIM() asm volatile("s_mov_b64 %1, exec\n\ts_mov_b64 exec, 1\n\tglobal_atomic_add %0, %2, %3, %4 sc0\n\ts_mov_b64 exec, %1" : "+v"(raw), "=&s"(ex_save) : "v"(claim_off), "v"(claim_add), "s"(head) : "memory")
    unsigned raw = 0u;
    CV_CLAIM();
    asm volatile("s_waitcnt vmcnt(0)" : "+v"(raw) :: "memory");
    int base = (int)__builtin_amdgcn_readfirstlane(raw);
    CV_CLAIM();
    CvItem P0 = cv_decode<GU>(F, base), P1, P2;
    CV_LOAD(A, P0, 0); CV_LOAD(B, P0, 1);
    {
      unsigned char* junk = wsp<unsigned char>(F, WS_JUNK) + (size_t)(blockIdx.x * NWAVES + F.wave) * 16384; const u32x4 zz_ = {0u, 0u, 0u, 0u};
#pragma unroll
      for (int j = 0; j < 8; ++j) { const unsigned so_ = (unsigned)(rn + 8 * j) * 128u + 16u * (unsigned)ch; asm volatile("global_store_dwordx4 %0, %1, %2 nt" :: "v"(so_), "v"(zz_), "s"(junk) : "memory"); } }
    while (base < NP) {
        P1 = cv_decode<GU>(F, base + 1); P2 = cv_decode<GU>(F, base + 2);
        CV_LOAD(C, P1, 0); CV_WAIT(40, A); CV_PROC(A, 0);
        CV_LOAD(A, P1, 1); CV_WAIT(40, B); CV_PROC(B, 1); CV_STORE(P0);
        CV_LOAD(B, P2, 0); CV_WAIT(40, C); CV_PROC(C, 0);
        CV_LOAD(C, P2, 1); CV_WAIT(40, A); CV_PROC(A, 1); CV_STORE(P1);
        asm volatile("s_waitcnt vmcnt(48)" : "+v"(raw) :: "memory");
        base = (int)__builtin_amdgcn_readfirstlane(raw);
        CV_CLAIM();
        P0 = cv_decode<GU>(F, base);
        CV_LOAD(A, P0, 0); CV_WAIT(41, B); CV_PROC(B, 0);
        CV_LOAD(B, P0, 1); CV_WAIT(41, C); CV_PROC(C, 1); CV_STORE(P2);
    }
#undef CV_WAIT
    asm volatile("s_waitcnt vmcnt(0)" ::: "memory");
#undef CV_CLAIM
#undef CV_LOAD
#undef CV_PROC
#undef CV_STORE
}
__device__ __forceinline__ void convert_queue(Frame& F) {
    refresh(F);
    __syncthreads();
    if constexpr (!MOE_FP8) {
        LAS unsigned* scr0 = (LAS unsigned*)(F.lds + RING_OFF + F.wave * 8448); unsigned* head0 = F.ctl + CW_CQ; constexpr int NQ0 = T_WGU + T_WD;
        for (;;) { unsigned raw0 = 0u; if (F.lane == 0) raw0 = __hip_atomic_fetch_add(head0, 1u, __ATOMIC_RELAXED, __HIP_MEMORY_SCOPE_AGENT); const int it = (int)__builtin_amdgcn_readfirstlane(raw0); if (it >= NQ0) break; convert_item(F, it, scr0, F.lane); }
        __syncthreads(); return; }
    convert_loop<true>(F, F.ctl + CW_CQ);
    convert_loop<false>(F, F.ctl + CW_CQ + 128);
    __syncthreads();
}


constexpr int CS_GU = 32 * 8 * 16, CS_DN = 32 * 8 * 8, CS_N = CS_GU + CS_DN, CS_PITCH = 65;
constexpr int CW_CQ1 = CW_CQ + 256, CW_CQ2 = CW_CQ + 320, CW_START2 = CW_CQ + 384; constexpr unsigned CONV_BUMP = 1u << 20;
__device__ __forceinline__ void convert_coop(Frame& F, unsigned* head, const int base) {
    refresh(F);
    __syncthreads();
    LAS unsigned* tile0 = (LAS unsigned*)(F.lds + RING_OFF);
    const int lane = F.lane, w = F.wave;
    if (F.tid == 0) F.MISC[104] = __hip_atomic_fetch_add(head, 1u, __ATOMIC_RELAXED, __HIP_MEMORY_SCOPE_AGENT);
    __syncthreads();
    int slot = 0, p = 0;
    for (;;) {
        const unsigned rawit = F.MISC[104 + slot];
        if (rawit >= (unsigned)CS_N) break;
        const int it = base + (int)rawit;
        if (it >= CS_N) break;
        if (F.tid == 0) F.MISC[104 + (slot ^ 1)] = __hip_atomic_fetch_add(head, 1u, __ATOMIC_RELAXED, __HIP_MEMORY_SCOPE_AGENT);
        const bool gu = it < CS_GU; const int r = gu ? it : it - CS_GU;
        const int e = gu ? (r >> 7) : (r >> 6), q = gu ? (r & 127) : (r & 63), kb = gu ? (q >> 4) : (q >> 3), nb = gu ? (q & 15) : (q & 7);
        const size_t ldw = gu ? 4096 : 2048;
        const float* W = (gu ? F.w_gu : F.w_dn) + (size_t)e * 2048 * ldw + (size_t)(256 * kb + 32 * w) * ldw;
        const int scol = gu ? ((lane >> 5) * 2048 + nb * 128 + 4 * (lane & 31)) : (nb * 256 + 4 * lane);
        unsigned char* O = (gu ? wsp<unsigned char>(F, WS_WGU) : wsp<unsigned char>(F, WS_WD)) + (size_t)e * ldw * 2048 + (size_t)(256 * nb) * 2048 + 256 * kb;
        LAS unsigned* T = tile0 + p * (256 * CS_PITCH);
        f32x4 v[32];
#pragma unroll
        for (int i = 0; i < 32; ++i) v[i] = __builtin_nontemporal_load((const f32x4*)(W + (size_t)i * ldw + scol));
#pragma unroll
        for (int kk = 0; kk < 8; ++kk)
#pragma unroll
            for (int c = 0; c < 4; ++c) T[(4 * lane + c) * CS_PITCH + 8 * w + kk] = pk4_fp8_raw(v[4 * kk][c] * WSCALE, v[4 * kk + 1][c] * WSCALE, v[4 * kk + 2][c] * WSCALE, v[4 * kk + 3][c] * WSCALE);
        __syncthreads();
#pragma unroll
        for (int i = 0; i < 8; ++i) { const int n = 32 * w + 4 * i + (lane >> 4), ch = lane & 15; const LAS unsigned* s_ = T + n * CS_PITCH + 4 * ch; u32x4 o; o.x = s_[0]; o.y = s_[1]; o.z = s_[2]; o.w = s_[3];
            __builtin_nontemporal_store(o, (u32x4*)(O + (size_t)n * 2048 + 16 * ch)); }
        slot ^= 1; p ^= 1;
    }
    __syncthreads();
}

__device__ __forceinline__ void p1_norm_fb(Frame& F) {
    refresh(F);
#pragma unroll 1
    for (int i0 = F.tid; i0 < 2048 * 4; i0 += 8 * NWAVES * 64) {
        f32x4 v[8];
#pragma unroll
        for (int u = 0; u < 8; ++u) { const int i = i0 + u * NWAVES * 64, k = i >> 2, q = i & 3; v[u] = *(const f32x4*)(F.w_in + (size_t)k * INW + 4608 + 4 * q); }
#pragma unroll
        for (int u = 0; u < 8; ++u) { const int i = i0 + u * NWAVES * 64, k = i >> 2, q = i & 3; const int j = k >> 8, l = (k & 255) >> 2, c = k & 3; *(LAS f32x4*)(F.lds + RING_OFF + ((((j * 4 + c) * 4 + q) * 64 + l) << 4)) = v[u]; } }
    __syncthreads();
    const int gw = F.vcu * NWAVES + F.wave, NGW = F.G * NWAVES, lane = F.lane;
    const float* mod = wsp<float>(F, WS_MOD); unsigned char* XN = wsp<unsigned char>(F, WS_XN); float* LOGF = wsp<float>(F, WS_LOGF);
    for (int row = gw; row < NTOK; row += NGW) {
        const int b = row >> 11; const float* xr = F.x + (size_t)row * DM; const float* sh = mod + b * MODW, *sc = mod + b * MODW + 2048;
        f32x4 v[8]; float ss = 0.f;
#pragma unroll
        for (int j = 0; j < 8; ++j) { v[j] = *(const f32x4*)(xr + 256 * j + 4 * lane); ss += v[j][0] * v[j][0] + v[j][1] * v[j][1] + v[j][2] * v[j][2] + v[j][3] * v[j][3]; }
        ss = wave_sum(ss); const float rstd = 1.0f / sqrtf(ss * (1.0f / DM) + 1e-5f);
        float fa[16];
#pragma unroll
        for (int h = 0; h < 16; ++h) fa[h] = 0.f;
#pragma unroll
        for (int j = 0; j < 8; ++j) { const int col = 256 * j + 4 * lane; const f32x4 g = *(const f32x4*)(F.g_mix + col), s1 = *(const f32x4*)(sc + col), h1 = *(const f32x4*)(sh + col);
            const f32x4 y = v[j] * rstd * g * (s1 + 1.0f) + h1;
            if constexpr (MIX_FP8) *(unsigned*)(XN + (size_t)row * DM + col) = pk4_fp8(y[0], y[1], y[2], y[3]);
            else { u32x2 w; w.x = pk2(y[0], y[1]); w.y = pk2(y[2], y[3]); *(u32x2*)((bf16_t*)XN + (size_t)row * DM + col) = w; }
#pragma unroll
            for (int c = 0; c < 4; ++c) {
#pragma unroll
                for (int q = 0; q < 4; ++q) { const f32x4 wv = *(const LAS f32x4*)(F.lds + RING_OFF + ((((j * 4 + c) * 4 + q) * 64 + lane) << 4));
#pragma unroll
                    for (int e = 0; e < 4; ++e) fa[4 * q + e] += y[c] * wv[e]; }
                if (c & 1) asm volatile("" ::: "memory"); } }
#pragma unroll
        for (int h = 0; h < 16; ++h) fa[h] = wave_sum(fa[h]);
        float mine = 0.f;
#pragma unroll
        for (int h = 0; h < 16; ++h) mine = (lane == h) ? fa[h] : mine;
        if (lane < 16) { const float f = mine + F.b_in[4608 + lane]; LOGF[row * 16 + lane] = fminf(f, 0.f) - log1pf(expf(-fabsf(f))); }
    }
}
__device__ __forceinline__ void p2_cumsum(Frame& F) {
    refresh(F);
    volatile LAS float* wsum_s = (volatile LAS float*)(F.MISC + 96);
    const float* LOGF = wsp<float>(F, WS_LOGF); float* CUM = wsp<float>(F, WS_CUM);
    for (int bh = F.vcu; bh < 64; bh += F.G) {
        const int b = bh >> 4, h = bh & 15, t0 = 4 * F.tid;
        float a[4];
#pragma unroll
        for (int i = 0; i < 4; ++i) a[i] = LOGF[(size_t)(b * SEQ + t0 + i) * 16 + h];
        a[1] += a[0]; a[2] += a[1]; a[3] += a[2];
        float s = a[3];
#pragma unroll
        for (int o = 1; o < 64; o <<= 1) { const float t = __shfl_up(s, o); if (F.lane >= o) s += t; }
        if (F.lane == 63) wsum_s[F.wave] = s;
        __syncthreads();
        float base = 0.f;
        for (int w = 0; w < F.wave; ++w) base += wsum_s[w];
        const float excl = base + s - a[3];
#pragma unroll
        for (int i = 0; i < 4; ++i) CUM[(size_t)bh * SEQ + t0 + i] = excl + a[i];
        __syncthreads();
    }
}

constexpr int AT_KOFF = 0, AT_VOFF = 9216, AT_COFF = 17920, AT_BUF = 18432;
template <int MODE>
__device__ __forceinline__ void attn_unit(LAS unsigned char* lds, const bf16_t* __restrict__ Q, const bf16_t* __restrict__ Kt, const bf16_t* __restrict__ Vt, const float* __restrict__ cum, unsigned char* __restrict__ O,
                                          int b, int h, int qb, float sink2, int wid) {
    const int lane = lane_id(), tid = wid * 64 + lane, r32 = lane & 31, hi = lane >> 5;
    constexpr int KP = MODE ? 1024 : 256;
    const int kvh = MODE ? h : (h >> 2);
    const int q0 = qb * 256, w0 = q0 + 32 * wid;
    const size_t rowbase = (size_t)b * SEQ;
    bf16x8 qf[4];
    { const bf16_t* qp = Q + (rowbase + w0 + r32) * 1024 + h * 64 + hi * 8;
#pragma unroll
      for (int d0 = 0; d0 < 4; ++d0) qf[d0] = *(const bf16x8*)(qp + d0 * 16); }
    const int kt_lo = MODE ? 0 : (q0 >= 128 ? ((q0 - 128) >> 6) : 0), kt_hi = (q0 + 255) >> 6;
    const int skey = tid >> 3, sch = tid & 7, vp = (tid & 255) >> 3;
    const bf16_t* kg = Kt + (rowbase + skey) * KP + kvh * 64 + sch * 8;
    const bf16_t* vg = Vt + (rowbase + 2 * vp) * KP + kvh * 64 + sch * 8;
    u32x4 kreg, vr0, vr1; float ckreg = 0.f;
#define AT_LOAD(kt) do { kreg = *(const u32x4*)(kg + (size_t)(kt) * 64 * KP); if (tid >= 256) { vr0 = *(const u32x4*)(vg + (size_t)(kt) * 64 * KP); vr1 = *(const u32x4*)(vg + (size_t)(kt) * 64 * KP + KP); } \
        if (MODE && tid < 64) ckreg = cum[(kt) * 64 + tid] * LOG2E; } while (0)
    AT_LOAD(kt_lo);
    float m = MODE ? -1e30f : sink2, l = (MODE == 0 && hi == 0) ? 1.0f : 0.0f;
    const float cq2 = MODE ? cum[w0 + r32] * LOG2E : 0.f;
    f32x16 o0 = {}, o1 = {};
    for (int kt = kt_lo; kt <= kt_hi; ++kt) {
        LAS unsigned char* buf = lds + ((kt - kt_lo) & 1) * AT_BUF;
        *(LAS u32x4*)(buf + AT_KOFF + skey * 144 + sch * 16) = kreg;
        if (tid >= 256) {
#pragma unroll
            for (int i = 0; i < 8; ++i) { const unsigned a = vr0[i >> 1], c = vr1[i >> 1];
                *(LAS unsigned*)(buf + AT_VOFF + (8 * sch + i) * 136 + vp * 4) = __builtin_amdgcn_perm(c, a, (i & 1) ? 0x07060302u : 0x05040100u); } }
        if (MODE && tid < 64) *(LAS float*)(buf + AT_COFF + tid * 4) = ckreg;
        __syncthreads();
        if (kt < kt_hi) AT_LOAD(kt + 1);
        const int k0 = kt * 64;
        const bool active = (k0 <= w0 + 31) && (MODE || (k0 + 63 >= w0 - 127));
        if (active) {
            f32x16 p0 = {}, p1 = {};
            { const LAS unsigned char* kb = buf + AT_KOFF + r32 * 144 + hi * 16;
#pragma unroll
              for (int d0 = 0; d0 < 4; ++d0) { const bf16x8 ka = *(const LAS bf16x8*)(kb + d0 * 32), kc = *(const LAS bf16x8*)(kb + 32 * 144 + d0 * 32);
                  p0 = __builtin_amdgcn_mfma_f32_32x32x16_bf16(ka, qf[d0], p0, 0, 0, 0); p1 = __builtin_amdgcn_mfma_f32_32x32x16_bf16(kc, qf[d0], p1, 0, 0, 0); } }
            if (MODE) {
#pragma unroll
                for (int g = 0; g < 4; ++g) { const f32x4 c0 = *(const LAS f32x4*)(buf + AT_COFF + (8 * g + 4 * hi) * 4), c1 = *(const LAS f32x4*)(buf + AT_COFF + (32 + 8 * g + 4 * hi) * 4);
#pragma unroll
                    for (int j = 0; j < 4; ++j) { p0[4 * g + j] += cq2 - c0[j]; p1[4 * g + j] += cq2 - c1[j]; } } }
            const bool need_mask = MODE ? (k0 + 63 > w0) : true;
            if (need_mask) { const int q = w0 + r32;
#pragma unroll
                for (int r = 0; r < 16; ++r) { const int key = k0 + (r & 3) + 8 * (r >> 2) + 4 * hi;
                    const bool v0 = (key <= q) && (MODE || key + 127 >= q), v1 = (key + 32 <= q) && (MODE || key + 32 + 127 >= q);
                    p0[r] = v0 ? p0[r] : -INFINITY; p1[r] = v1 ? p1[r] : -INFINITY; } }
            float rm = __builtin_fmaxf(p0[0], p1[0]);
#pragma unroll
            for (int r = 1; r < 16; ++r) rm = __builtin_fmaxf(__builtin_fmaxf(rm, p0[r]), p1[r]);
            { const unsigned ru = __builtin_bit_cast(unsigned, rm); auto rr = __builtin_amdgcn_permlane32_swap(ru, ru, false, false);
              rm = __builtin_fmaxf(__builtin_bit_cast(float, rr[0]), __builtin_bit_cast(float, rr[1])); }
            const float mn = fmaxf(m, rm), alpha = __builtin_amdgcn_exp2f(m - mn);
            const bool grew = mn > m; m = mn;
            float ps = 0.f;
#pragma unroll
            for (int r = 0; r < 16; ++r) { p0[r] = __builtin_amdgcn_exp2f(p0[r] - mn); p1[r] = __builtin_amdgcn_exp2f(p1[r] - mn); ps += p0[r] + p1[r]; }
            l = l * alpha + ps;
            if (__any(grew)) {
#pragma unroll
                for (int r = 0; r < 16; ++r) { o0[r] *= alpha; o1[r] *= alpha; } }
            bf16x8 pf[4];
            { u32x4 w;
              w.x = pk2(p0[0], p0[1]); w.y = pk2(p0[2], p0[3]); w.z = pk2(p0[4], p0[5]); w.w = pk2(p0[6], p0[7]); pf[0] = __builtin_bit_cast(bf16x8, w);
              w.x = pk2(p0[8], p0[9]); w.y = pk2(p0[10], p0[11]); w.z = pk2(p0[12], p0[13]); w.w = pk2(p0[14], p0[15]); pf[1] = __builtin_bit_cast(bf16x8, w);
              w.x = pk2(p1[0], p1[1]); w.y = pk2(p1[2], p1[3]); w.z = pk2(p1[4], p1[5]); w.w = pk2(p1[6], p1[7]); pf[2] = __builtin_bit_cast(bf16x8, w);
              w.x = pk2(p1[8], p1[9]); w.y = pk2(p1[10], p1[11]); w.z = pk2(p1[12], p1[13]); w.w = pk2(p1[14], p1[15]); pf[3] = __builtin_bit_cast(bf16x8, w); }
            const LAS unsigned char* vb = buf + AT_VOFF + r32 * 136 + hi * 8;
#pragma unroll
            for (int ks = 0; ks < 4; ++ks) {
                { const u32x2 lo = *(const LAS u32x2*)(vb + ks * 32), hh = *(const LAS u32x2*)(vb + ks * 32 + 16); const u32x4 w = {lo.x, lo.y, hh.x, hh.y};
                  o0 = __builtin_amdgcn_mfma_f32_32x32x16_bf16(__builtin_bit_cast(bf16x8, w), pf[ks], o0, 0, 0, 0); }
                { const u32x2 lo = *(const LAS u32x2*)(vb + 32 * 136 + ks * 32), hh = *(const LAS u32x2*)(vb + 32 * 136 + ks * 32 + 16); const u32x4 w = {lo.x, lo.y, hh.x, hh.y};
                  o1 = __builtin_amdgcn_mfma_f32_32x32x16_bf16(__builtin_bit_cast(bf16x8, w), pf[ks], o1, 0, 0, 0); } }
        }
    }
#undef AT_LOAD
    l += __shfl_xor(l, 32);
    const float inv = 1.0f / l;
    const size_t oe = (rowbase + w0 + r32) * 2048 + MODE * 1024 + h * 64 + 4 * hi;
#pragma unroll
    for (int g = 0; g < 4; ++g) {
        if constexpr (MIX_FP8) { *(unsigned*)(O + oe + 8 * g) = pk4_fp8(o0[4 * g] * inv, o0[4 * g + 1] * inv, o0[4 * g + 2] * inv, o0[4 * g + 3] * inv);
            *(unsigned*)(O + oe + 32 + 8 * g) = pk4_fp8(o1[4 * g] * inv, o1[4 * g + 1] * inv, o1[4 * g + 2] * inv, o1[4 * g + 3] * inv); }
        else { bf16_t* op = (bf16_t*)O + oe; u32x2 w; w.x = pk2(o0[4 * g] * inv, o0[4 * g + 1] * inv); w.y = pk2(o0[4 * g + 2] * inv, o0[4 * g + 3] * inv); *(u32x2*)(op + 8 * g) = w;
            w.x = pk2(o1[4 * g] * inv, o1[4 * g + 1] * inv); w.y = pk2(o1[4 * g + 2] * inv, o1[4 * g + 3] * inv); *(u32x2*)(op + 32 + 8 * g) = w; } }
    __syncthreads();
}
#ifndef ATT_SIGNAL_DEF
#define ATT_SIGNAL_DEF 960
#endif
constexpr int ATT_SIGNAL = ATT_SIGNAL_DEF;
__device__ __forceinline__ void p3_attention(Frame& F) {
    refresh(F);
    const bf16_t *QA = wsp<bf16_t>(F, WS_QA), *KA = wsp<bf16_t>(F, WS_KA), *VA = wsp<bf16_t>(F, WS_VA), *QB = wsp<bf16_t>(F, WS_QB), *KB = wsp<bf16_t>(F, WS_KB), *VB = wsp<bf16_t>(F, WS_VB);
    const float* CUM = wsp<float>(F, WS_CUM); unsigned char* YAB = wsp<unsigned char>(F, WS_YAB);
    LAS unsigned char* lds = F.lds + RING_OFF;
    unsigned* head = F.ctl + CW_AQ;
    for (;;) {
        __syncthreads();
        if (F.tid == 0) F.MISC[100] = __hip_atomic_fetch_add(head, 1u, __ATOMIC_RELAXED, __HIP_MEMORY_SCOPE_AGENT);
        __syncthreads();
        const int u = (int)F.MISC[100];
        if (u >= 1024) break;
        if (u == ATT_SIGNAL && F.tid == 0 && F.G < (int)gridDim.x) {
            const unsigned old = __hip_atomic_fetch_add(F.ctl + CW_CQ1, CONV_BUMP, __ATOMIC_RELAXED, __HIP_MEMORY_SCOPE_AGENT);
            __hip_atomic_store(F.ctl + CW_START2, old < (unsigned)CS_N ? old : (unsigned)CS_N, __ATOMIC_RELAXED, __HIP_MEMORY_SCOPE_AGENT); }
        if (u < 512) { const int bh = u & 63, qb = 7 - (u >> 6); attn_unit<1>(lds, QB, KB, VB, CUM + (size_t)bh * SEQ, YAB, bh >> 4, bh & 15, qb, 0.f, F.wave); }
        else { const int v = u - 512, bh = v >> 3, qb = v & 7; attn_unit<0>(lds, QA, KA, VA, nullptr, YAB, bh >> 4, bh & 15, qb, F.sinks[bh & 15] * LOG2E, F.wave); }
    }
}

template <int HH>
__device__ __forceinline__ void p6_half(Frame& F) {
    refresh(F);
    const int gw = F.vcu * NWAVES + F.wave, NGW = F.G * NWAVES, lane = F.lane;
    const float* mod = wsp<float>(F, WS_MOD); const float* H1 = wsp<float>(F, WS_H1); unsigned char* XN2 = wsp<unsigned char>(F, WS_XN2);
    int* TEID = wsp<int>(F, WS_TEID); int* TPOS = wsp<int>(F, WS_TPOS); float* TGATE = wsp<float>(F, WS_TGATE); int* TOKOF = wsp<int>(F, WS_TOKOF);
    LAS float* part = (LAS float*)(F.lds + TBL_OFF) + F.wave * 256 + lane;
    __syncthreads();
#pragma unroll 1
    for (int i0 = F.tid; i0 < 1024 * 8; i0 += 8 * NWAVES * 64) {
        f32x4 v[8];
#pragma unroll
        for (int u = 0; u < 8; ++u) { const int i = i0 + u * NWAVES * 64, kk = i >> 3, q = i & 7; v[u] = *(const f32x4*)(F.w_r + (size_t)(1024 * HH + kk) * 32 + 4 * q); }
#pragma unroll
        for (int u = 0; u < 8; ++u) { const int i = i0 + u * NWAVES * 64, kk = i >> 3, q = i & 7; const int jj = kk >> 8, l = (kk & 255) >> 2, c = kk & 3; *(LAS f32x4*)(F.lds + RING_OFF + ((((jj * 4 + c) * 8 + q) * 64 + l) << 4)) = v[u]; } }
    __syncthreads();
#pragma unroll 1
    for (int ri = 0; ri < 4; ++ri) {
        const int row = gw + ri * NGW; if (row >= NTOK) break;
        int lane4 = 4 * lane; asm volatile("" : "+v"(lane4));
        const int b = row >> 11; const float* xr = H1 + (size_t)row * DM + lane4; const float* sh = mod + b * MODW + 6144 + lane4, *sc = mod + b * MODW + 8192 + lane4; const float* gp = F.g_ffn + lane4;
        f32x4 v[4]; float ss = 0.f;
#pragma unroll
        for (int j = 0; j < 4; ++j) { v[j] = *(const f32x4*)(xr + 256 * (4 * HH + j)); const f32x4 o = *(const f32x4*)(xr + 256 * (4 * (1 - HH) + j));
            ss += v[j][0] * v[j][0] + v[j][1] * v[j][1] + v[j][2] * v[j][2] + v[j][3] * v[j][3] + o[0] * o[0] + o[1] * o[1] + o[2] * o[2] + o[3] * o[3]; }
        ss = wave_sum(ss); const float rstd = 1.0f / sqrtf(ss * (1.0f / DM) + 1e-5f);
        float a[32];
#pragma unroll
        for (int e = 0; e < 32; ++e) a[e] = 0.f;
        const LAS unsigned char* wl = F.lds + RING_OFF + 4 * lane4;
#pragma unroll
        for (int jj = 0; jj < 4; ++jj) { const int col = 256 * (4 * HH + jj); const f32x4 g = *(const f32x4*)(gp + col), s1 = *(const f32x4*)(sc + col), h1 = *(const f32x4*)(sh + col);
            const f32x4 y = v[jj] * rstd * g * (s1 + 1.0f) + h1;
            if constexpr (MOE_FP8) *(unsigned*)(XN2 + (size_t)row * DM + col + lane4) = pk4_fp8(y[0], y[1], y[2], y[3]);
            else { u32x2 w; w.x = pk2(y[0], y[1]); w.y = pk2(y[2], y[3]); *(u32x2*)((bf16_t*)XN2 + (size_t)row * DM + col + lane4) = w; }
#pragma unroll
            for (int c = 0; c < 4; ++c) {
#pragma unroll
                for (int q = 0; q < 8; ++q) { const f32x4 wv = *(const LAS f32x4*)(wl + ((((jj * 4 + c) * 8 + q) * 64) << 4));
#pragma unroll
                    for (int e = 0; e < 4; ++e) a[4 * q + e] += y[c] * wv[e]; }
                asm volatile("" ::: "memory"); } }
#define P6_RSTEP(XF, MASK, HALF) { const bool up = (lane & (MASK)) != 0; _Pragma("unroll") for (int i = 0; i < (HALF); ++i) { const float keep = up ? a[i + (HALF)] : a[i], give = up ? a[i] : a[i + (HALF)]; a[i] = keep + XF; } }
        P6_RSTEP(__shfl_xor(give, 32), 32, 16) P6_RSTEP(__shfl_xor(give, 16), 16, 8) P6_RSTEP(__shfl_xor(give, 8), 8, 4) P6_RSTEP(__shfl_xor(give, 4), 4, 2) P6_RSTEP(__shfl_xor(give, 2), 2, 1)
#undef P6_RSTEP
        float lg = a[0] + __shfl_xor(a[0], 1);
        if (HH == 0) { part[ri * 64] = lg; continue; }
        lg += part[ri * 64] + F.b_r[lane >> 1];
        float val[4]; int idx[4];
        float cur = lg;
#pragma unroll
        for (int k = 0; k < 4; ++k) { float bv = cur; int bi = lane >> 1;
#pragma unroll
            for (int o = 1; o < 64; o <<= 1) { const float ov = __shfl_xor(bv, o); const int oi = __shfl_xor(bi, o); if (ov > bv || (ov == bv && oi < bi)) { bv = ov; bi = oi; } }
            val[k] = bv; idx[k] = bi; if ((lane >> 1) == bi) cur = -INFINITY; }
        float ex[4], sm = 0.f;
#pragma unroll
        for (int k = 0; k < 4; ++k) { ex[k] = expf(val[k] - val[0]); sm += ex[k]; }
        if (lane < 4) { int e = idx[0]; float gt = ex[0];
#pragma unroll
            for (int k = 1; k < 4; ++k) if (lane == k) { e = idx[k]; gt = ex[k]; }
            const int p = (int)atomicAdd(F.ctl + CW_CNT + e, 1u);
            TOKOF[e * NTOK + p] = row; TEID[row * 4 + lane] = e; TPOS[row * 4 + lane] = p; TGATE[row * 4 + lane] = gt / sm; }
    }
}
__device__ __forceinline__ void p6_norm_router(Frame& F) { p6_half<0>(F); p6_half<1>(F); }
__device__ __forceinline__ void moe_tables(Frame& F) {
    refresh(F);
    __syncthreads();
    if (F.tid == 0) { unsigned s = 0, h = 0, nl = 0;
        for (int e = 0; e < 32; ++e) { const unsigned c = __hip_atomic_load(F.ctl + CW_CNT + e, __ATOMIC_RELAXED, __HIP_MEMORY_SCOPE_AGENT); F.MISC[48 + e] = c; F.MISC[8 + e] = s; s += (c + 255u) >> 8;
            const unsigned rem = c & 255u; F.MISC[112 + e] = h; h += (c >> 8) + (rem > 128u ? 1u : 0u); if (rem >= 1u && rem <= 128u) { F.MISC[152 + nl] = (unsigned)e; ++nl; } }
        F.MISC[8 + 32] = s; F.MISC[112 + 32] = h; F.MISC[190] = nl; }
    __syncthreads();
}
__device__ __forceinline__ void p7_gu(Frame& F) {
    moe_tables(F);
    MoeSched<true> S; S.tpre = F.MISC + 8; S.cnt = F.MISC + 48; S.hpre = F.MISC + 112; S.lexp = F.MISC + 152; S.nlight = (int)F.MISC[190]; S.tbl = (const LAS unsigned*)(F.lds + TBL_OFF); S.A = (const char*)wsp<bf16_t>(F, WS_XN2); S.Bt = (const char*)wsp<bf16_t>(F, WS_WGU); S.NN = 16; S.ldb2 = 2048 * MOE_EB; S.K = 2048;
    S.G = F.G; S.vcu = F.vcu; S.b_estride = (size_t)4096 * 2048 * MOE_EB;
    { const int* TOKOF = wsp<int>(F, WS_TOKOF); Unit u; LAS unsigned* tbl = (LAS unsigned*)(F.lds + TBL_OFF);
      for (int i = 0; i < 10 && S.next(i, u); ++i) { if (F.tid < 256) { const int e = u.aux, p = (u.pm - (int)F.MISC[8 + e]) * 256 + F.tid, cnt = (int)F.MISC[48 + e]; const int tok = TOKOF[e * NTOK + (p < cnt ? p : 0)]; tbl[i * 256 + F.tid] = (unsigned)tok * (2048u * MOE_EB); } }
      __syncthreads(); }
    EpiGU E{F.b_gu, wsp<unsigned char>(F, WS_ACT)};
    gemm_phase<EpiGU, MoeSched<true>, true, MOE_FP8>(F.lds + RING_OFF, S, E, F.wave);
}
__device__ __forceinline__ void p8_down(Frame& F) {
    moe_tables(F);
    MoeSched<false> S; S.tpre = F.MISC + 8; S.cnt = F.MISC + 48; S.hpre = F.MISC + 112; S.lexp = F.MISC + 152; S.nlight = (int)F.MISC[190]; S.tbl = nullptr; S.A = (const char*)wsp<bf16_t>(F, WS_ACT); S.Bt = (const char*)wsp<bf16_t>(F, WS_WD); S.NN = 8; S.ldb2 = 2048 * MOE_EB; S.K = 2048;
    S.G = F.G; S.vcu = F.vcu; S.b_estride = (size_t)2048 * 2048 * MOE_EB;
    EpiDown E{F.b_dn, wsp<bf16_t>(F, WS_YS)};
    gemm_phase<EpiDown, MoeSched<false>, true, MOE_FP8>(F.lds + RING_OFF, S, E, F.wave);
}
__device__ __forceinline__ void p9_final(Frame& F) {
    refresh(F);
    moe_tables(F);
    const int gw = F.vcu * NWAVES + F.wave, NGW = F.G * NWAVES, lane = F.lane;
    const float* mod = wsp<float>(F, WS_MOD); const float* H1 = wsp<float>(F, WS_H1); const bf16_t* YS = wsp<bf16_t>(F, WS_YS);
    const int* TEID = wsp<int>(F, WS_TEID); const int* TPOS = wsp<int>(F, WS_TPOS); const float* TGATE = wsp<float>(F, WS_TGATE);
    for (int row = gw; row < NTOK; row += NGW) {
        const int b = row >> 11; const float* gt = mod + b * MODW + 10240;
        const bf16_t* yr[4]; float gw4[4];
#pragma unroll
        for (int k = 0; k < 4; ++k) { const int e = TEID[row * 4 + k]; yr[k] = YS + ((size_t)F.MISC[8 + e] * 256 + TPOS[row * 4 + k]) * 2048; gw4[k] = TGATE[row * 4 + k]; }
        f32x4 v[8]; float ss = 0.f;
#pragma unroll
        for (int j = 0; j < 8; ++j) { const int col = 256 * j + 4 * lane; f32x4 y = {0.f, 0.f, 0.f, 0.f};
#pragma unroll
            for (int k = 0; k < 4; ++k) { const u32x2 w = *(const u32x2*)(yr[k] + col); y += (f32x4){bflo(w.x), bfhi(w.x), bflo(w.y), bfhi(w.y)} * gw4[k]; }
            v[j] = *(const f32x4*)(H1 + (size_t)row * DM + col) + *(const f32x4*)(gt + col) * y;
            ss += v[j][0] * v[j][0] + v[j][1] * v[j][1] + v[j][2] * v[j][2] + v[j][3] * v[j][3]; }
        ss = wave_sum(ss); const float rstd = 1.0f / sqrtf(ss * (1.0f / DM) + 1e-5f);
#pragma unroll
        for (int j = 0; j < 8; ++j) { const int col = 256 * j + 4 * lane; *(f32x4*)(F.out + (size_t)row * DM + col) = v[j] * rstd * *(const f32x4*)(F.g_fin + col); }
    }
}

constexpr int PER_PHASE = 10;
struct Args { const void* in[20]; float* out; unsigned char* ws; int ph_lo, ph_hi; };
__global__ void __launch_bounds__(NWAVES * 64, 2) mega_fwd(Args args) {
    extern __shared__ __attribute__((aligned(16))) unsigned char lds_raw[];
    Frame F;
    F.lds = (LAS unsigned char*)lds_raw; F.MISC = (volatile LAS unsigned*)(F.lds + MISC_OFF);
    F.tid = threadIdx.x; F.lane = F.tid & 63; F.wave = __builtin_amdgcn_readfirstlane(F.tid >> 6);
    F.G = gridDim.x; { const int bx = blockIdx.x; F.vcu = (F.G % 8 == 0) ? (bx % 8) * (F.G / 8) + bx / 8 : bx; }
    F.ws = args.ws; F.ctl = (unsigned*)(args.ws + WS_CTL); F.out = args.out;
    F.x = (const float*)args.in[0]; F.c = (const float*)args.in[1]; F.pos = (const int*)args.in[2]; F.w_ada = (const float*)args.in[3]; F.b_ada = (const float*)args.in[4]; F.g_mix = (const float*)args.in[5];
    F.w_in = (const float*)args.in[6]; F.b_in = (const float*)args.in[7]; F.sinks = (const float*)args.in[8]; F.w_a = (const float*)args.in[9]; F.w_b = (const float*)args.in[10]; F.w_out = (const float*)args.in[11];
    F.g_ffn = (const float*)args.in[12]; F.w_r = (const float*)args.in[13]; F.b_r = (const float*)args.in[14]; F.w_gu = (const float*)args.in[15]; F.b_gu = (const float*)args.in[16]; F.w_dn = (const float*)args.in[17];
    F.b_dn = (const float*)args.in[18]; F.g_fin = (const float*)args.in[19];
    for (int u = F.tid; u < 256; u += NWAVES * 64) F.MISC[u] = 0u;
    __syncthreads();
    refresh(F);
    const int lo = args.ph_lo, hi = args.ph_hi;
    const bool one_launch = true; (void)lo; (void)hi;
    XcdBarrier bar; bar.bar = (unsigned*)(F.ctl + CW_BAR); bar.x = 0; bar.st = nullptr; bar.total = 0;
    XcdBarrier bar2 = bar;
    const bool is_comp = (int)blockIdx.x < NCOMP || F.G <= NCOMP;
    const int ncomp = F.G <= NCOMP ? F.G : NCOMP;
    if (one_launch) { bar = xcd_barrier_post((unsigned*)(F.ctl + CW_BAR), F.MISC + 0, (unsigned)F.G);
        if (is_comp) bar2 = xcd_barrier_post((unsigned*)(F.ctl + CW_BAR2), F.MISC + 2, (unsigned)ncomp); }
#ifndef REPEAT_MASK
#define REPEAT_MASK 0
#endif
#define IN(k) true
#define REP(k, body) do { if ((REPEAT_MASK >> (k)) & 1) { body; xcd_barrier(bar); } } while (0)
#define REP2(k, body) do { if ((REPEAT_MASK >> (k)) & 1) { body; xcd_barrier(bar2); } } while (0)
#define SEAM(k) do { if (IN(k) && IN((k) + 1)) xcd_barrier(bar); } while (0)
    if (one_launch) {
        if (is_comp) {
            const int G0 = F.G, v0 = F.vcu; F.G = ncomp; { const int bx = blockIdx.x; F.vcu = (ncomp % 8 == 0) ? (bx % 8) * (ncomp / 8) + bx / 8 : bx; }
            const bool split0 = ncomp < G0;
            p0_prologue(F, 0, split0 ? P0_T_HEAD : P0_T_ALL, F.vcu * NWAVES + F.wave, F.G * NWAVES); xcd_barrier(bar2);
            REP2(1, p1_norm_fb(F)); p1_norm_fb(F); xcd_barrier(bar2);
            if (split0) {
                if (F.tid == 0) { unsigned* flag = F.ctl + CW_SFLAG; unsigned* tmo = (unsigned*)(F.ctl + CW_BAR) + XB_TMO; const unsigned want = (unsigned)(G0 - ncomp);
                    XB_SPIN(xb_ld(flag) < want, (unsigned*)(F.ctl + CW_BAR)); (void)tmo;
                    __builtin_amdgcn_fence(__ATOMIC_ACQUIRE, "agent"); asm volatile("s_waitcnt vmcnt(0)" ::: "memory"); }
                __syncthreads(); }
            { p2_cumsum(F);
              DenseSched S; S.init(wsp<bf16_t>(F, WS_XN), 2048 * MIX_EB, wsp<bf16_t>(F, WS_WIN), 2048 * MIX_EB, 2048, NTOK, 8704, ncomp, (int)blockIdx.x);
              EpiInProj E{wsp<bf16_t>(F, WS_QA), wsp<bf16_t>(F, WS_KA), wsp<bf16_t>(F, WS_VA), wsp<bf16_t>(F, WS_QB), wsp<bf16_t>(F, WS_KB), wsp<bf16_t>(F, WS_VB), wsp<bf16_t>(F, WS_SGA), wsp<bf16_t>(F, WS_SGB),
                          wsp<float>(F, WS_BINP), wsp<float>(F, WS_COS), wsp<float>(F, WS_SIN)};
              REP2(2, (gemm_phase<EpiInProj, DenseSched, true, MIX_FP8>(F.lds + RING_OFF, S, E, F.wave)));
              gemm_phase<EpiInProj, DenseSched, true, MIX_FP8>(F.lds + RING_OFF, S, E, F.wave); }
            xcd_barrier(bar2);
            p3_attention(F);
            F.G = G0; F.vcu = v0;
        }
#ifndef CONV_COOP
#define CONV_COOP 1
#endif
        if (!is_comp) {
            p0_prologue(F, P0_T_HEAD, P0_T_ALL, ((int)blockIdx.x - ncomp) * NWAVES + F.wave, (F.G - ncomp) * NWAVES);
            asm volatile("s_waitcnt vmcnt(0)" ::: "memory"); __syncthreads();
            if (F.tid == 0) { __builtin_amdgcn_fence(__ATOMIC_RELEASE, "agent"); asm volatile("s_waitcnt vmcnt(0)" ::: "memory"); (void)xb_add(F.ctl + CW_SFLAG, 1u); }
            convert_coop(F, F.ctl + CW_CQ1, 0);
        }
        xcd_barrier(bar);
        {
            BranchSched S; S.d.init(wsp<bf16_t>(F, WS_YAB), 2048 * MIX_EB, wsp<bf16_t>(F, WS_WAB), 1024 * MIX_EB, 1024, NTOK, 2048, F.G, (int)blockIdx.x); S.ldb2 = 1024 * MIX_EB; S.K = 1024;
            EpiBranch E{wsp<bf16_t>(F, WS_SGA), wsp<bf16_t>(F, WS_SGB), wsp<float>(F, WS_T1), wsp<unsigned char>(F, WS_MERGED)};
            gemm_phase<EpiBranch, BranchSched, true, MIX_FP8>(F.lds + RING_OFF, S, E, F.wave); }
        xcd_barrier(bar);
        {
            DenseSched S; S.init(wsp<bf16_t>(F, WS_MERGED), 2048 * P5_EB, wsp<bf16_t>(F, WS_WOUT), 2048 * P5_EB, 2048, NTOK, 2048, F.G, (int)blockIdx.x);
            EpiOut E{F.x, wsp<float>(F, WS_MOD), wsp<float>(F, WS_H1)};
            gemm_phase<EpiOut, DenseSched, true, P5_FP8>(F.lds + RING_OFF, S, E, F.wave); }
        convert_coop(F, F.ctl + CW_CQ2, (int)__hip_atomic_load(F.ctl + CW_START2, __ATOMIC_RELAXED, __HIP_MEMORY_SCOPE_AGENT));
        xcd_barrier(bar);
    }
    if (IN(6)) { p6_norm_router(F); } SEAM(6);
    if (IN(7)) { REP(7, p7_gu(F)); p7_gu(F); } SEAM(7);
    if (IN(8)) { REP(8, p8_down(F)); p8_down(F); } SEAM(8);
    if (IN(9)) { REP(9, p9_final(F)); p9_final(F); }
#undef IN
#undef SEAM
}

static void run_opt(void* const* d_in, float* out, unsigned char* ws, hipStream_t stream, int n_launches) {
    static int grid = 0;
    if (grid == 0) {
        int dev = 0, cus = 0;
        if (hipGetDevice(&dev) != hipSuccess || hipDeviceGetAttribute(&cus, hipDeviceAttributeMultiprocessorCount, dev) != hipSuccess) { grid = -1; return; }
        if (hipFuncSetAttribute((const void*)mega_fwd, hipFuncAttributeMaxDynamicSharedMemorySize, LDS_BYTES) != hipSuccess) { grid = -1; return; }
        int per_cu = 0; (void)hipOccupancyMaxActiveBlocksPerMultiprocessor(&per_cu, (const void*)mega_fwd, NWAVES * 64, LDS_BYTES); (void)hipGetLastError();
        grid = cus;
    }
    if (grid < 0) return;
    (void)hipMemsetAsync(ws + WS_CTL, 0, CTL_ZERO_BYTES, stream);
    Args a{};
    for (int i = 0; i < 20; ++i) a.in[i] = d_in[i];
    a.out = out; a.ws = ws;
    (void)n_launches; a.ph_lo = 0; a.ph_hi = PER_PHASE; hipLaunchKernelGGL(mega_fwd, dim3(grid), dim3(NWAVES * 64), LDS_BYTES, stream, a);
}
}

extern "C" void kernel_launch(void* const* d_in, const int* in_sizes, int n_in, void* d_out, int out_size, void* d_ws, size_t ws_size, hipStream_t stream) {
    mk::run_opt(d_in, (float*)d_out, (unsigned char*)d_ws, stream, 1);
}
```

```cpp
#include <hip/hip_runtime.h>
#include <stdint.h>
#include <math.h>
namespace mk {
#define LAS __attribute__((address_space(3)))
#define GAS __attribute__((address_space(1)))
typedef unsigned short bf16_t;
typedef short bf16x8 __attribute__((ext_vector_type(8)));
typedef float f32x4 __attribute__((ext_vector_type(4)));
typedef float f32x2 __attribute__((ext_vector_type(2)));
typedef float f32x16 __attribute__((ext_vector_type(16)));
typedef unsigned u32x4 __attribute__((ext_vector_type(4)));
typedef unsigned u32x2 __attribute__((ext_vector_type(2)));
typedef __bf16 bf16x2_t __attribute__((ext_vector_type(2)));
typedef int i32x4 __attribute__((ext_vector_type(4)));
typedef int i32x8 __attribute__((ext_vector_type(8)));

constexpr int NTOK = 8192, DM = 2048, SEQ = 2048, INW = 8720, NEXP = 32, MODW = 12288;
constexpr float LOG2E = 1.4426950408889634f;
constexpr float QSCALE = 0.125f * LOG2E;

__device__ __forceinline__ unsigned pk2(float lo, float hi) { f32x2 v = {lo, hi}; bf16x2_t b = __builtin_convertvector(v, bf16x2_t); return __builtin_bit_cast(unsigned, b); }
__device__ __forceinline__ float bflo(unsigned u) { return __builtin_bit_cast(float, u << 16); }
__device__ __forceinline__ float bfhi(unsigned u) { return __builtin_bit_cast(float, u & 0xffff0000u); }
__device__ __forceinline__ unsigned pk4_fp8_raw(float a, float b, float c, float d) { int w = 0; w = __builtin_amdgcn_cvt_pk_fp8_f32(a, b, w, false); w = __builtin_amdgcn_cvt_pk_fp8_f32(c, d, w, true); return (unsigned)w; }
__device__ __forceinline__ float sat448(float x) { return __builtin_amdgcn_fmed3f(x, -448.0f, 448.0f); }
__device__ __forceinline__ unsigned pk4_fp8(float a, float b, float c, float d) { return pk4_fp8_raw(a, b, c, d); }
__device__ __forceinline__ i32x8 cat8(bf16x8 lo, bf16x8 hi) { return __builtin_shufflevector(__builtin_bit_cast(i32x4, lo), __builtin_bit_cast(i32x4, hi), 0, 1, 2, 3, 4, 5, 6, 7); }
__device__ __forceinline__ int lane_id() { int l = (int)__builtin_amdgcn_mbcnt_hi(~0u, __builtin_amdgcn_mbcnt_lo(~0u, 0u)); asm volatile("" : "+v"(l)); return l; }
template <int CTRL> __device__ __forceinline__ float dpp_mov(float x) { return __builtin_bit_cast(float, __builtin_amdgcn_update_dpp(0, __builtin_bit_cast(int, x), CTRL, 0xF, 0xF, true)); }
__device__ __forceinline__ float lx1(float x) { return dpp_mov<0xB1>(x); }
__device__ __forceinline__ float lx2(float x) { return dpp_mov<0x4E>(x); }
__device__ __forceinline__ float lx4(float x) { return dpp_mov<0x1B>(dpp_mov<0x141>(x)); }
__device__ __forceinline__ float lx8(float x) { return dpp_mov<0x128>(x); }
__device__ __forceinline__ float lx16(float x, int lane) { const unsigned u = __builtin_bit_cast(unsigned, x); auto rr = __builtin_amdgcn_permlane16_swap(u, u, false, false); return __builtin_bit_cast(float, (lane & 16) ? rr[0] : rr[1]); }
__device__ __forceinline__ float lx32(float x, int lane) { const unsigned u = __builtin_bit_cast(unsigned, x); auto rr = __builtin_amdgcn_permlane32_swap(u, u, false, false); return __builtin_bit_cast(float, (lane & 32) ? rr[0] : rr[1]); }
__device__ __forceinline__ float wave_sum_v(float v) {
    v += lx1(v); v += lx2(v); v += lx4(v); v += lx8(v);
    { const unsigned u = __builtin_bit_cast(unsigned, v); auto rr = __builtin_amdgcn_permlane16_swap(u, u, false, false); v = __builtin_bit_cast(float, rr[0]) + __builtin_bit_cast(float, rr[1]); }
    { const unsigned u = __builtin_bit_cast(unsigned, v); auto rr = __builtin_amdgcn_permlane32_swap(u, u, false, false); v = __builtin_bit_cast(float, rr[0]) + __builtin_bit_cast(float, rr[1]); }
    return v;
}
__device__ __forceinline__ float fast_sigmoid(float x) { return __builtin_amdgcn_rcpf(1.0f + __builtin_amdgcn_exp2f(-x * LOG2E)); }

constexpr int BM = 256, BK = 64, HALF = 128, HTB = HALF * BK * 2, STAGE_BYTES = 8 * HTB, NXCD = 8, WGM = 8;
__host__ __device__ __forceinline__ int lds_byte(int r, int c) { const int st = (r >> 4) * 2 + (c >> 5), rr = r & 15, cc = c & 31, ob = rr * 64 + cc * 2; return st * 1024 + (ob ^ (((ob >> 9) & 1) << 5)); }
__host__ __device__ __forceinline__ void stage_rc(int b, int& R, int& C) { const int st = b / 1024, sb = b % 1024, swz = sb ^ (((sb >> 9) & 1) << 5); R = (st >> 1) * 16 + swz / 64; C = (st & 1) * 32 + (swz % 64) / 2; }
__host__ __device__ __forceinline__ int perm32(int rho) { const int n = rho >> 4, i = rho & 15; return 8 * (i >> 2) + 4 * n + (i & 3); }

struct Unit { int pm, pn, aux; };

template <class Epi, class Sched, bool ALIGN_EPI, bool FP8 = false>
__device__ __forceinline__ void gemm_phase(LAS unsigned char* lds, const Sched& S, const Epi& E, int wid  ) {
    const int lane = lane_id(), tid = wid * 64 + lane, wr = wid >> 2, wc = wid & 3, fr = lane & 15, fq = lane >> 4;
    const int K = S.K, nt = FP8 ? K / (2 * BK) : K / BK;
    int sR[2], sC[2]; unsigned voffB[2];
#pragma unroll
    for (int i = 0; i < 2; ++i) { stage_rc(tid * 16 + i * 8192, sR[i], sC[i]); const int Rb = Epi::PERM ? ((sR[i] & ~31) + perm32(sR[i] & 31)) : sR[i]; voffB[i] = (unsigned)Rb * S.ldb2 + (unsigned)sC[i] * 2u; }
    const size_t kstep = (size_t)(BK * 2);
    const size_t hstepB = (size_t)HALF * S.ldb2;
    const unsigned ldsw = (unsigned)wid * 1024u;
    const int aoff = lds_byte(wr * 64 + fr, fq * 8), boff = lds_byte(wc * 32 + fr, fq * 8);
#define PG8_SA(b, h) (((b) * 2 + (h)) * HTB)
#define PG8_SB(b, h) ((4 + (b) * 2 + (h)) * HTB)
#define PG8_STAGE(bufoff, gbase, voff) do { _Pragma("unroll") for (int _i = 0; _i < 2; ++_i) \
        __builtin_amdgcn_global_load_lds((const unsigned*)((const char*)(gbase) + (voff)[_i]), (LAS unsigned*)(lds + (bufoff) + ldsw + _i * 8192), 16, 0, 0); } while (0)
#define PG8_LDA(dst, b, h) do { _Pragma("unroll") for (int m = 0; m < 4; ++m) { if constexpr (FP8) dst##8[m] = cat8(*(const LAS bf16x8*)(lds + PG8_SA(b, h) + aoff + m * 2048), *(const LAS bf16x8*)(lds + PG8_SA(b, h) + aoff + m * 2048 + 1024)); \
        else { _Pragma("unroll") for (int k = 0; k < 2; ++k) dst[m][k] = *(const LAS bf16x8*)(lds + PG8_SA(b, h) + aoff + m * 2048 + k * 1024); } } } while (0)
#define PG8_LDB(dst, b, h) do { _Pragma("unroll") for (int n = 0; n < 2; ++n) { if constexpr (FP8) dst##8[n] = cat8(*(const LAS bf16x8*)(lds + PG8_SB(b, h) + boff + n * 2048), *(const LAS bf16x8*)(lds + PG8_SB(b, h) + boff + n * 2048 + 1024)); \
        else { _Pragma("unroll") for (int k = 0; k < 2; ++k) dst[n][k] = *(const LAS bf16x8*)(lds + PG8_SB(b, h) + boff + n * 2048 + k * 1024); } } } while (0)
#define PG8_MMA(ai, bj, At, Bt) do { __builtin_amdgcn_s_setprio(1); _Pragma("unroll") for (int m = 0; m < 4; ++m) _Pragma("unroll") for (int n = 0; n < 2; ++n) { \
        if constexpr (FP8) asm volatile("v_mfma_scale_f32_16x16x128_f8f6f4 %0, %1, %2, %0, %3, %3 op_sel_hi:[0,0,0]" : "+v"(acc[ai][bj][m][n]) : "v"(Bt##8[n]), "v"(At##8[m]), "v"(fp8_unit_scale)); \
        else { _Pragma("unroll") for (int k = 0; k < 2; ++k) acc[ai][bj][m][n] = __builtin_amdgcn_mfma_f32_16x16x32_bf16(Bt[n][k], At[m][k], acc[ai][bj][m][n], 0, 0, 0); } } __builtin_amdgcn_s_setprio(0); } while (0)
#define PG8_WAIT_V(n) asm volatile("s_waitcnt vmcnt(" #n ")" ::: "memory")
#define PG8_WAIT_L(n) asm volatile("s_waitcnt lgkmcnt(" #n ")" ::: "memory")
#define PG8_BAR __builtin_amdgcn_s_barrier()
#define PG8_SCHED __builtin_amdgcn_sched_barrier(0)
#define PG8_AOFFS(dst, u, ui) do { _Pragma("unroll") for (int _h = 0; _h < 2; ++_h) _Pragma("unroll") for (int _i = 0; _i < 2; ++_i) dst[_h][_i] = S.a_rowoff(u, ui, sR[_i] + _h * HALF) + (unsigned)sC[_i] * 2u; } while (0)
    Unit cur, nxt; int ui = 0;
    if (!S.next(0, cur)) return;
    int vrows = 256; if constexpr (Sched::RAGGED) vrows = S.rows(cur);
#define PG8_DO0 (!Sched::RAGGED || vrows > 64 || wr == 0)
#define PG8_DO1 (!Sched::RAGGED || vrows > 128)
    f32x4 acc[2][2][4][2];
#pragma unroll
    for (int a = 0; a < 2; ++a)
#pragma unroll
        for (int b = 0; b < 2; ++b)
#pragma unroll
            for (int m = 0; m < 4; ++m)
#pragma unroll
                for (int n = 0; n < 2; ++n) acc[a][b][m][n] = (f32x4){0.f, 0.f, 0.f, 0.f};
    bf16x8 At[4][2], B0[2][2], B1[2][2]; i32x8 At8[4], B08[2], B18[2];
    constexpr bool GA = Sched::GATHER;
    const unsigned fp8_unit_scale = 0x7f7f7f7fu;
    unsigned vAc[2][2], vAn[2][2];
    PG8_AOFFS(vAc, cur, 0);
    const size_t hstepA = GA ? 0 : (size_t)(vAc[1][0] - vAc[0][0]);
#define PG8_H1(v) (GA ? (v)[1] : (v)[0])
    const char* cA = S.a_base(cur); const char* cB = S.b_base(cur);
    PG8_STAGE(PG8_SB(0, 0), cB, voffB); PG8_STAGE(PG8_SB(0, 1), cB + hstepB, voffB); PG8_STAGE(PG8_SA(0, 0), cA, vAc[0]); PG8_STAGE(PG8_SA(0, 1), cA + hstepA, PG8_H1(vAc));
    if (wr == 1) PG8_BAR;
    PG8_WAIT_V(2); PG8_BAR;
    PG8_STAGE(PG8_SB(1, 0), cB + kstep, voffB); PG8_STAGE(PG8_SA(1, 0), cA + kstep, vAc[0]); PG8_STAGE(PG8_SB(1, 1), cB + hstepB + kstep, voffB);
    PG8_WAIT_V(6); PG8_BAR;
    for (;;) {
        const bool has_next = S.next(ui + 1, nxt);
        const char* nA = cA; const char* nB = cB;
        if (has_next) { nA = S.a_base(nxt); nB = S.b_base(nxt); if constexpr (GA) PG8_AOFFS(vAn, nxt, ui + 1); }
        else if constexpr (GA) {
#pragma unroll
            for (int _h = 0; _h < 2; ++_h)
#pragma unroll
                for (int _i = 0; _i < 2; ++_i) vAn[_h][_i] = vAc[_h][_i]; }
        for (int t = 0; t < nt; t += 2) {
            const bool last = (t == nt - 2);
            const char* a1 = cA + (size_t)(t + 1) * kstep;
            const char* a2 = last ? nA : cA + (size_t)(t + 2) * kstep; const char* b2 = last ? nB : cB + (size_t)(t + 2) * kstep;
            const char* a3 = a2 + kstep; const char* b3 = b2 + kstep;
            unsigned vS[2][2];
#pragma unroll
            for (int _h = 0; _h < 2; ++_h)
#pragma unroll
                for (int _i = 0; _i < 2; ++_i) vS[_h][_i] = (GA && last) ? vAn[_h][_i] : vAc[_h][_i];
            PG8_LDB(B0, 0, 0); PG8_LDB(B1, 0, 1); PG8_SCHED; PG8_LDA(At, 0, 0); PG8_STAGE(PG8_SA(1, 1), a1 + hstepA, PG8_H1(vAc));
            PG8_WAIT_V(8); PG8_WAIT_L(0); PG8_BAR; if (PG8_DO0) { PG8_MMA(0, 0, At, B0); PG8_MMA(0, 1, At, B1); } PG8_BAR; PG8_SCHED;
            PG8_LDA(At, 0, 1); PG8_STAGE(PG8_SB(0, 0), b2, voffB); PG8_STAGE(PG8_SB(0, 1), b2 + hstepB, voffB); PG8_STAGE(PG8_SA(0, 0), a2, vS[0]);
            PG8_WAIT_V(8); PG8_WAIT_L(0); PG8_BAR; if (PG8_DO1) { PG8_MMA(1, 0, At, B0); PG8_MMA(1, 1, At, B1); } PG8_BAR; PG8_SCHED;
            PG8_LDB(B0, 1, 0); PG8_LDB(B1, 1, 1); PG8_SCHED; PG8_LDA(At, 1, 0); PG8_STAGE(PG8_SA(0, 1), a2 + hstepA, PG8_H1(vS));
            PG8_WAIT_V(8); PG8_WAIT_L(0); PG8_BAR; if (PG8_DO0) { PG8_MMA(0, 0, At, B0); PG8_MMA(0, 1, At, B1); } PG8_BAR; PG8_SCHED;
            PG8_LDA(At, 1, 1); PG8_STAGE(PG8_SB(1, 0), b3, voffB); PG8_STAGE(PG8_SB(1, 1), b3 + hstepB, voffB); PG8_STAGE(PG8_SA(1, 0), a3, vS[0]);
            PG8_WAIT_V(8); PG8_WAIT_L(0); PG8_BAR; if (PG8_DO1) { PG8_MMA(1, 0, At, B0); PG8_MMA(1, 1, At, B1); } PG8_BAR; PG8_SCHED;
        }
        if constexpr (ALIGN_EPI) { if (wr == 0) PG8_BAR; }
        if constexpr (FP8) asm volatile("s_nop 15\n\ts_nop 15\n\ts_nop 15\n\ts_nop 15" ::: "memory");
        E(acc, cur, wr, wc, fr, fq);
        if (!has_next) break;
#pragma unroll
        for (int a = 0; a < 2; ++a)
#pragma unroll
            for (int b = 0; b < 2; ++b)
#pragma unroll
                for (int m = 0; m < 4; ++m)
#pragma unroll
                    for (int n = 0; n < 2; ++n) acc[a][b][m][n] = (f32x4){0.f, 0.f, 0.f, 0.f};
        cur = nxt; cA = nA; cB = nB; ++ui;
        if constexpr (Sched::RAGGED) vrows = S.rows(cur);
        if constexpr (GA) {
#pragma unroll
        for (int _h = 0; _h < 2; ++_h)
#pragma unroll
            for (int _i = 0; _i < 2; ++_i) vAc[_h][_i] = vAn[_h][_i]; }
        if constexpr (ALIGN_EPI) { if (wr == 1) PG8_BAR; }
    }
    PG8_WAIT_V(0);
    if constexpr (!ALIGN_EPI) { if (wr == 0) PG8_BAR; }
    PG8_BAR;
#undef PG8_SA
#undef PG8_SB
#undef PG8_STAGE
#undef PG8_LDA
#undef PG8_LDB
#undef PG8_MMA
#undef PG8_WAIT_V
#undef PG8_WAIT_L
#undef PG8_BAR
#undef PG8_SCHED
#undef PG8_AOFFS
#undef PG8_DO0
#undef PG8_DO1
#undef PG8_H1
}

#define XB_TMO      128
#define XB_XCNT(j)  (256  + 64 * (j))
#define XB_XSUB(j)  (1280 + 64 * (j))
#define XB_XGEN(j)  (2304 + 64 * (j))
#define XB_TOP      3328
#define XB_TOPGEN   3392
#define XCD_BAR_WORDS 3456
#define XB_SPIN_CAP (1u << 18)
__device__ __forceinline__ unsigned xb_ld(unsigned* p)              { return __hip_atomic_load(p, __ATOMIC_RELAXED, __HIP_MEMORY_SCOPE_AGENT); }
__device__ __forceinline__ unsigned xb_add(unsigned* p, unsigned v) { return __hip_atomic_fetch_add(p, v, __ATOMIC_RELAXED, __HIP_MEMORY_SCOPE_AGENT); }
__device__ __forceinline__ unsigned xb_xcc_id() { return (unsigned)__builtin_amdgcn_s_getreg((3 << 11) | 20) & 0xFu; }
#define XB_SPIN(cond, bar) do { unsigned _sp = 0; while (cond) { __builtin_amdgcn_s_sleep(1); \
    if ((++_sp & 255u) == 0u) { if (xb_ld(&(bar)[XB_TMO])) break; if (_sp > XB_SPIN_CAP) { atomicAdd(&(bar)[XB_TMO], 1u); break; } } } } while (0)
struct XcdBarrier { unsigned* bar; unsigned x; volatile LAS unsigned* st; unsigned total; };
__device__ __forceinline__ XcdBarrier xcd_barrier_post(unsigned* bar, volatile LAS unsigned* st, unsigned total) {
    XcdBarrier b; b.bar = bar; b.x = xb_xcc_id(); b.st = st; b.total = total;
    if (threadIdx.x == 0) (void)xb_add(&bar[XB_XCNT(b.x)], 1u);
    return b;
}
__device__ __forceinline__ void xcd_barrier_complete(unsigned* bar, unsigned x, unsigned G, unsigned& nloc, unsigned& nx) {
    unsigned sum, cnt, mine, sp = 0u;
    for (;;) {
        sum = 0u; cnt = 0u; mine = 0u;
#pragma unroll
        for (unsigned j = 0; j < 16; ++j) { const unsigned c = xb_ld(&bar[XB_XCNT(j)]); sum += c; cnt += (c > 0u) ? 1u : 0u; mine = (j == x) ? c : mine; }
        if (sum == G) break;
        __builtin_amdgcn_s_sleep(1);
        if ((++sp & 255u) == 0u) { if (xb_ld(&bar[XB_TMO])) break; if (sp > XB_SPIN_CAP) { atomicAdd(&bar[XB_TMO], 1u); break; } }
    }
    nloc = mine > 0u ? mine : 1u; nx = cnt > 0u ? cnt : 1u;
}
__device__ __forceinline__ void xcd_barrier(const XcdBarrier& b) {
    asm volatile("s_waitcnt vmcnt(0)" ::: "memory");
    __syncthreads();
    if (threadIdx.x == 0) {
        unsigned* bar = b.bar;
        __builtin_amdgcn_s_waitcnt(0);
        unsigned nloc = b.st[0], nx = b.st[1];
        if (nloc == 0u) { xcd_barrier_complete(bar, b.x, b.total, nloc, nx); b.st[0] = nloc; b.st[1] = nx; }
        const unsigned old = xb_add(&bar[XB_XSUB(b.x)], 1u);
        const unsigned gen = old / nloc;
        if (old + 1u == (gen + 1u) * nloc) {
            __builtin_amdgcn_fence(__ATOMIC_RELEASE, "agent");
            asm volatile("s_waitcnt vmcnt(0)" ::: "memory");
            const unsigned og = xb_add(&bar[XB_TOP], 1u);
            const unsigned tg = og / nx;
            if (og + 1u == (tg + 1u) * nx) xb_add(&bar[XB_TOPGEN], 1u);
            else XB_SPIN(xb_ld(&bar[XB_TOPGEN]) == tg, bar);
            __builtin_amdgcn_fence(__ATOMIC_ACQUIRE, "agent");
            xb_add(&bar[XB_XGEN(b.x)], 1u);
            asm volatile("s_waitcnt vmcnt(0)" ::: "memory");
        } else {
            XB_SPIN(xb_ld(&bar[XB_XGEN(b.x)]) == gen, bar);
            __builtin_amdgcn_fence(__ATOMIC_ACQUIRE, "agent");
            asm volatile("s_waitcnt vmcnt(0)" ::: "memory");
        }
    }
    __syncthreads();
}
}
namespace mk {
constexpr size_t MiB = 1ull << 20;
constexpr size_t WS_CTL = 0, CTL_ZERO_BYTES = 65536;
constexpr size_t WS_MOD = 1 * MiB, WS_COS = 2 * MiB, WS_SIN = 3 * MiB, WS_LOGF = 4 * MiB, WS_CUM = 5 * MiB, WS_TEID = 6 * MiB, WS_TPOS = 6 * MiB + 512 * 1024, WS_TGATE = 7 * MiB, WS_BINP = 7 * MiB + 512 * 1024,
                 WS_TOKOF = 8 * MiB  , WS_XN = 16 * MiB  , WS_WIN = 48 * MiB  , WS_WAB = 84 * MiB  , WS_WOUT = 92 * MiB  , WS_QA = 100 * MiB  , WS_KA = 116 * MiB  ,
                 WS_VA = 120 * MiB  , WS_QB = 124 * MiB  , WS_KB = 140 * MiB, WS_VB = 156 * MiB, WS_SGA = 172 * MiB  , WS_SGB = 204 * MiB  , WS_YAB = 236 * MiB  ,
                 WS_T1 = 268 * MiB  , WS_MERGED = 332 * MiB  , WS_H1 = 364 * MiB  , WS_XN2 = 428 * MiB  , WS_ACT = 460 * MiB  , WS_YS = 620 * MiB  ,
                 WS_WGU = 780 * MiB  , WS_WD = 1292 * MiB  , WS_JUNK = 1548 * MiB  , WS_END = 1580 * MiB;
constexpr int CW_CNT = 1024;
constexpr int CW_BAR = 4096;
constexpr int CW_BAR2 = 8192;
constexpr int CW_CQ = 2048;
constexpr int CW_AQ = 2112;
constexpr int CW_SFLAG = 2560;
#ifndef CONV_MODE
#define CONV_MODE 0
#endif
#ifndef NCOMP_DEF
#define NCOMP_DEF 156
#endif
constexpr int NCOMP = NCOMP_DEF;
constexpr int RING_OFF = 0, RING_BYTES = 131072;
constexpr int TBL_OFF = RING_BYTES;
constexpr int MISC_OFF = TBL_OFF + 10240;
constexpr int LDS_BYTES = 147456;
static_assert(MISC_OFF + 1024 <= LDS_BYTES, "LDS map");
constexpr int NWAVES = 8;
constexpr bool MOE_FP8 = true;
constexpr float WSCALE = 32.0f, WSCALE_INV = 1.0f / 32.0f;
constexpr bool MIX_FP8 = true;
constexpr int MIX_EB = MIX_FP8 ? 1 : 2;
#ifndef P5_FP8_DEF
#define P5_FP8_DEF 1
#endif
constexpr bool P5_FP8 = MIX_FP8 && P5_FP8_DEF;
constexpr int P5_EB = P5_FP8 ? 1 : 2;
constexpr int MOE_EB = MOE_FP8 ? 1 : 2;

struct Frame {
    LAS unsigned char* lds; volatile LAS unsigned* MISC; unsigned* ctl;
    int tid, lane, wave, vcu, G;
    const float *x, *c, *w_ada, *b_ada, *g_mix, *w_in, *b_in, *sinks, *w_a, *w_b, *w_out, *g_ffn, *w_r, *b_r, *w_gu, *b_gu, *w_dn, *b_dn, *g_fin; const int* pos;
    float* out; unsigned char* ws;
};
__device__ __forceinline__ void refresh(Frame& F) { F.lane = lane_id(); F.tid = F.wave * 64 + F.lane; }
template <class T> __device__ __forceinline__ T* wsp(const Frame& F, size_t off) { return (T*)(F.ws + off); }

__device__ __forceinline__ float wave_sum(float v) {
#pragma unroll
    for (int o = 1; o < 64; o <<= 1) v += __shfl_xor(v, o);
    return v;
}

struct DenseSched {
    static constexpr bool GATHER = false, RAGGED = false;
    const char* A; const char* Bt; unsigned lda2, ldb2; int K; int nM, nN, nwg, G, c;
    __device__ __forceinline__ void init(const void* A_, unsigned lda2_, const void* Bt_, unsigned ldb2_, int K_, int M, int N, int G_, int c_) {
        A = (const char*)A_; Bt = (const char*)Bt_; lda2 = lda2_; ldb2 = ldb2_; K = K_; nM = M / BM; nN = N / BM; nwg = nM * nN; G = G_; c = c_; }
    __device__ __forceinline__ bool tile(long L, Unit& u) const {
        if (L >= nwg) return false;
        int wgid = (int)L; { const int q = nwg / NXCD, r = nwg % NXCD, xcd = wgid % NXCD, off = wgid / NXCD; wgid = (xcd < r ? xcd * (q + 1) : r * (q + 1) + (xcd - r) * q) + off; }
        const int nig = WGM * nN, gid = wgid / nig, fm = gid * WGM, gsz = (nM - fm) < WGM ? (nM - fm) : WGM;
        u.pm = fm + ((wgid % nig) % gsz); u.pn = (wgid % nig) / gsz; u.aux = 0; return true; }
    __device__ __forceinline__ bool next(int i, Unit& u) const { return tile((long)i * G + c, u); }
    __device__ __forceinline__ const char* a_base(const Unit& u) const { return A + (size_t)u.pm * BM * lda2; }
    __device__ __forceinline__ unsigned a_rowoff(const Unit&, int, int R) const { return (unsigned)R * lda2; }
    __device__ __forceinline__ const char* b_base(const Unit& u) const { return Bt + (size_t)u.pn * BM * ldb2; }
};
struct BranchSched {
    static constexpr bool GATHER = false, RAGGED = false;
    DenseSched d; unsigned ldb2; int K;
    __device__ __forceinline__ bool next(int i, Unit& u) const { if (!d.tile((long)(i >> 1) * d.G + d.c, u)) return false; u.aux = i & 1; return true; }
    __device__ __forceinline__ const char* a_base(const Unit& u) const { return d.A + (size_t)u.pm * BM * (2048 * MIX_EB) + (size_t)u.aux * (1024 * MIX_EB); }
    __device__ __forceinline__ unsigned a_rowoff(const Unit&, int, int R) const { return (unsigned)R * (2048u * MIX_EB); }
    __device__ __forceinline__ const char* b_base(const Unit& u) const { return d.Bt + ((size_t)u.aux * 2048 + (size_t)u.pn * BM) * (1024 * MIX_EB); }
};
template <bool GATHER_>
struct MoeSched {
    static constexpr bool GATHER = GATHER_, gather = GATHER_, RAGGED = true;
    const volatile LAS unsigned* cnt;
    __device__ __forceinline__ int rows(const Unit& u) const { const int r = (int)cnt[u.aux] - (u.pm - (int)tpre[u.aux]) * 256; return r < 256 ? r : 256; }
    const volatile LAS unsigned* tpre; const LAS unsigned* tbl; const char* A; const char* Bt; int NN; unsigned ldb2; int K; int G, vcu;
    size_t b_estride;
    const volatile LAS unsigned* hpre; const volatile LAS unsigned* lexp; int nlight;
    __device__ __forceinline__ bool next(int i, Unit& u) const {
        const int L = i * G + vcu; const int NH = NN * (int)hpre[32];
        if (L < NH) {
            int e = 0;
            for (int j = 1; j < 32; ++j) if (NN * (int)hpre[j] <= L) e = j;
            const int l = L - NN * (int)hpre[e], T = (int)hpre[e + 1] - (int)hpre[e];
            u.pn = l / T; u.pm = (int)tpre[e] + (l - u.pn * T); u.aux = e; return true; }
        const int l2 = L - NH, j = l2 / NN; if (j >= nlight) return false;
        const int e = (int)lexp[j]; u.pn = l2 - j * NN; u.pm = (int)tpre[e + 1] - 1; u.aux = e; return true; }
    __device__ __forceinline__ const char* a_base(const Unit& u) const { return gather ? A : A + (size_t)u.pm * BM * (2048 * MOE_EB); }
    __device__ __forceinline__ unsigned a_rowoff(const Unit&, int ui, int R) const { return gather ? tbl[ui * 256 + R] : (unsigned)R * (2048u * MOE_EB); }
    __device__ __forceinline__ const char* b_base(const Unit& u) const { return Bt + (size_t)u.aux * b_estride + (size_t)u.pn * BM * ldb2; }
};

__device__ __forceinline__ void st8bf(bf16_t* p, f32x4 a, f32x4 b) { u32x4 w; w.x = pk2(a[0], a[1]); w.y = pk2(a[2], a[3]); w.z = pk2(b[0], b[1]); w.w = pk2(b[2], b[3]); *(u32x4*)p = w; }
struct EpiInProj {
    static constexpr bool PERM = true;
    bf16_t *QA, *KA, *VA, *QB, *KB, *VB, *SGA, *SGB; const float* bias; const float* cosT; const float* sinT;
    __device__ __forceinline__ void operator()(const f32x4 (&acc)[2][2][4][2], const Unit& u, int wr, int wc, int fr, int fq) const {
        const int pn = u.pn, row0 = u.pm * BM + wr * 64 + fr, cw = wc * 32 + 8 * fq;
        const float ws = MIX_FP8 ? WSCALE_INV : 1.0f;
        f32x4 bv[2][2];
#pragma unroll
        for (int bj = 0; bj < 2; ++bj)
#pragma unroll
            for (int n = 0; n < 2; ++n) bv[bj][n] = *(const f32x4*)(bias + pn * 256 + bj * 128 + cw + 4 * n);
        if (pn < 5) {
            bf16_t* O = pn < 4 ? QA : KA; const int ldo = pn < 4 ? 1024 : 256; const int hcol = (pn < 4 ? pn * 256 : 0) + wc * 64 + 8 * fq; const float qs = pn < 4 ? QSCALE : 1.0f;
#pragma unroll
            for (int ai = 0; ai < 2; ++ai)
#pragma unroll
                for (int m = 0; m < 4; ++m) { const int row = row0 + ai * HALF + m * 16;
                    f32x4 o1[2], o2[2];
#pragma unroll
                    for (int n = 0; n < 2; ++n) { const f32x4 cs = *(const f32x4*)(cosT + (size_t)row * 32 + 8 * fq + 4 * n), sn = *(const f32x4*)(sinT + (size_t)row * 32 + 8 * fq + 4 * n);
                        const f32x4 x1 = acc[ai][0][m][n] * ws + bv[0][n], x2 = acc[ai][1][m][n] * ws + bv[1][n];
                        o1[n] = (x1 * cs - x2 * sn) * qs; o2[n] = (x2 * cs + x1 * sn) * qs; }
                    bf16_t* rp = O + (size_t)row * ldo + hcol; st8bf(rp, o1[0], o1[1]); st8bf(rp + 32, o2[0], o2[1]); }
        } else if (pn < 18) {
            bf16_t* O; int ldo, col0; float sc = 1.0f;
            if (pn == 5) { O = VA; ldo = 256; col0 = 0; } else if (pn < 10) { O = QB; ldo = 1024; col0 = (pn - 6) * 256; sc = QSCALE; } else if (pn < 14) { O = KB; ldo = 1024; col0 = (pn - 10) * 256; } else { O = VB; ldo = 1024; col0 = (pn - 14) * 256; }
#pragma unroll
            for (int ai = 0; ai < 2; ++ai)
#pragma unroll
                for (int m = 0; m < 4; ++m) { bf16_t* rp = O + (size_t)(row0 + ai * HALF + m * 16) * ldo + col0 + cw;
#pragma unroll
                    for (int bj = 0; bj < 2; ++bj) st8bf(rp + bj * HALF, (acc[ai][bj][m][0] * ws + bv[bj][0]) * sc, (acc[ai][bj][m][1] * ws + bv[bj][1]) * sc); }
        } else {
            bf16_t* O = pn < 26 ? SGA : SGB; const int col0 = ((pn - 18) & 7) * 256;
#pragma unroll
            for (int ai = 0; ai < 2; ++ai)
#pragma unroll
                for (int m = 0; m < 4; ++m) { bf16_t* rp = O + (size_t)(row0 + ai * HALF + m * 16) * 2048 + col0 + cw;
#pragma unroll
                    for (int bj = 0; bj < 2; ++bj) { f32x4 a = acc[ai][bj][m][0] * ws + bv[bj][0], b = acc[ai][bj][m][1] * ws + bv[bj][1];
#pragma unroll
                        for (int j = 0; j < 4; ++j) { a[j] = fast_sigmoid(a[j]); b[j] = fast_sigmoid(b[j]); }
                        st8bf(rp + bj * HALF, a, b); } }
        }
    }
};
struct EpiBranch {
    static constexpr bool PERM = true;
    const bf16_t *SGA, *SGB; float* T1; unsigned char* MERGED;
    __device__ __forceinline__ void operator()(const f32x4 (&acc)[2][2][4][2], const Unit& u, int wr, int wc, int fr, int fq) const {
        const int row0 = u.pm * BM + wr * 64 + fr, col0 = u.pn * BM + wc * 32 + 8 * fq;
        const bf16_t* SG = u.aux ? SGB : SGA;
#pragma unroll
        for (int ai = 0; ai < 2; ++ai)
#pragma unroll
            for (int m = 0; m < 4; ++m) { const size_t off = (size_t)(row0 + ai * HALF + m * 16) * 2048 + col0;
#pragma unroll
                for (int bj = 0; bj < 2; ++bj) { const u32x4 g = *(const u32x4*)(SG + off + bj * HALF);
                    const f32x4 g0 = {bflo(g.x), bfhi(g.x), bflo(g.y), bfhi(g.y)}, g1 = {bflo(g.z), bfhi(g.z), bflo(g.w), bfhi(g.w)};
                    const float ws = MIX_FP8 ? WSCALE_INV : 1.0f;
                    f32x4 a = acc[ai][bj][m][0] * g0 * ws, b = acc[ai][bj][m][1] * g1 * ws;
                    bf16_t* tp = (bf16_t*)T1 + off + bj * HALF;
                    if (u.aux == 0) { st8bf(tp, a, b); }
                    else { const u32x4 t = *(const u32x4*)tp; a += (f32x4){bflo(t.x), bfhi(t.x), bflo(t.y), bfhi(t.y)}; b += (f32x4){bflo(t.z), bfhi(t.z), bflo(t.w), bfhi(t.w)};
                        if constexpr (P5_FP8) { u32x2 w; w.x = pk4_fp8(a[0], a[1], a[2], a[3]); w.y = pk4_fp8(b[0], b[1], b[2], b[3]); *(u32x2*)(MERGED + off + bj * HALF) = w; }
                        else st8bf((bf16_t*)MERGED + off + bj * HALF, a, b); } } }
    }
};
struct EpiOut {
    static constexpr bool PERM = false;
    const float* x; const float* mod; float* H1;
    __device__ __forceinline__ void operator()(const f32x4 (&acc)[2][2][4][2], const Unit& u, int wr, int wc, int fr, int fq) const {
        const int row0 = u.pm * BM + wr * 64 + fr, col0 = u.pn * BM + wc * 32 + 4 * fq; const float* gt = mod + (size_t)(u.pm >> 3) * MODW + 4096;
#pragma unroll
        for (int bj = 0; bj < 2; ++bj)
#pragma unroll
            for (int n = 0; n < 2; ++n) { const int col = col0 + bj * HALF + n * 16; const f32x4 g = *(const f32x4*)(gt + col);
#pragma unroll
                for (int ai = 0; ai < 2; ++ai)
#pragma unroll
                    for (int m = 0; m < 4; ++m) { const size_t off = (size_t)(row0 + ai * HALF + m * 16) * 2048 + col; *(f32x4*)(H1 + off) = *(const f32x4*)(x + off) + g * (acc[ai][bj][m][n] * (P5_FP8 ? WSCALE_INV : 1.0f)); } }
    }
};
struct EpiGU {
    static constexpr bool PERM = true;
    const float* b_gu; unsigned char* ACT;
    __device__ __forceinline__ void operator()(const f32x4 (&acc)[2][2][4][2], const Unit& u, int wr, int wc, int fr, int fq) const {
        const int row0 = u.pm * BM + wr * 64 + fr, cw = wc * 32 + 8 * fq; const float* bg = b_gu + (size_t)u.aux * 4096 + u.pn * 128 + cw;
        const float ws = MOE_FP8 ? WSCALE_INV : 1.0f;
        f32x4 bv[2][2];
#pragma unroll
        for (int bj = 0; bj < 2; ++bj)
#pragma unroll
            for (int n = 0; n < 2; ++n) bv[bj][n] = *(const f32x4*)(bg + bj * 2048 + 4 * n);
#pragma unroll
        for (int ai = 0; ai < 2; ++ai)
#pragma unroll
            for (int m = 0; m < 4; ++m) { f32x4 o[2];
#pragma unroll
                for (int n = 0; n < 2; ++n) { const f32x4 g = acc[ai][0][m][n] * ws + bv[0][n], l = acc[ai][1][m][n] * ws + bv[1][n];
#pragma unroll
                    for (int j = 0; j < 4; ++j) { const float gg = fminf(g[j], 7.0f), ll = fminf(fmaxf(l[j], -7.0f), 7.0f);
                        o[n][j] = gg * (ll + 1.0f) * __builtin_amdgcn_rcpf(1.0f + __builtin_amdgcn_exp2f(-1.702f * LOG2E * gg)); } }
                const size_t eo = (size_t)(row0 + ai * HALF + m * 16) * 2048 + u.pn * 128 + cw;
                if constexpr (MOE_FP8) { u32x2 w; w.x = pk4_fp8(o[0][0], o[0][1], o[0][2], o[0][3]); w.y = pk4_fp8(o[1][0], o[1][1], o[1][2], o[1][3]); *(u32x2*)(ACT + eo) = w; }
                else st8bf((bf16_t*)ACT + eo, o[0], o[1]); }
    }
};
struct EpiDown {
    static constexpr bool PERM = true;
    const float* b_dn; bf16_t* YS;
    __device__ __forceinline__ void operator()(const f32x4 (&acc)[2][2][4][2], const Unit& u, int wr, int wc, int fr, int fq) const {
        const int row0 = u.pm * BM + wr * 64 + fr, col0 = u.pn * BM + wc * 32 + 8 * fq; const float* bd = b_dn + (size_t)u.aux * 2048 + col0;
        const float ws = MOE_FP8 ? WSCALE_INV : 1.0f;
        f32x4 bv[2][2];
#pragma unroll
        for (int bj = 0; bj < 2; ++bj)
#pragma unroll
            for (int n = 0; n < 2; ++n) bv[bj][n] = *(const f32x4*)(bd + bj * HALF + 4 * n);
#pragma unroll
        for (int ai = 0; ai < 2; ++ai)
#pragma unroll
            for (int m = 0; m < 4; ++m) { bf16_t* rp = YS + (size_t)(row0 + ai * HALF + m * 16) * 2048 + col0;
#pragma unroll
                for (int bj = 0; bj < 2; ++bj) st8bf(rp + bj * HALF, acc[ai][bj][m][0] * ws + bv[bj][0], acc[ai][bj][m][1] * ws + bv[bj][1]); }
    }
};

__device__ __forceinline__ int in_src(int r) { const int pn = r >> 8, c = r & 255; if (pn < 5) return pn * 256 + ((c & 127) >> 5) * 64 + (c >> 7) * 32 + (c & 31); return pn < 18 ? r : r + 16; }
__device__ __forceinline__ void transpose_item(const float* __restrict__ W, size_t ldw, int k0, int src0, int src1, bf16_t* __restrict__ WT, size_t ldk, int dst0, LAS unsigned* scr, int lane) {
    const int lg = lane >> 4, lc = lane & 15;
    const int scol = (lc < 8 ? src0 : src1 - 32) + 4 * lc;
    f32x4 v[8][2];
#pragma unroll
    for (int i = 0; i < 8; ++i)
#pragma unroll
        for (int p = 0; p < 2; ++p) v[i][p] = *(const f32x4*)(W + (size_t)(k0 + 8 * i + 2 * lg + p) * ldw + scol);
#pragma unroll
    for (int i = 0; i < 8; ++i)
#pragma unroll
        for (int c = 0; c < 4; ++c) scr[(4 * lc + c) * 33 + 4 * i + lg] = pk2(v[i][0][c], v[i][1][c]);
    asm volatile("s_waitcnt lgkmcnt(0)" ::: "memory");
    const int rn = lane >> 3, ch = lane & 7;
#pragma unroll
    for (int j = 0; j < 8; ++j) { const int n = rn + 8 * j; const LAS unsigned* s = scr + n * 33 + 4 * ch; u32x4 o; o.x = s[0]; o.y = s[1]; o.z = s[2]; o.w = s[3];
        *(u32x4*)(WT + (size_t)(dst0 + n) * ldk + k0 + 8 * ch) = o; }
    asm volatile("s_waitcnt lgkmcnt(0)" ::: "memory");
}
__device__ __forceinline__ void transpose_item_f8(const float* __restrict__ W, size_t ldw, int k0, int src0, int src1, unsigned char* __restrict__ WT, size_t ldk, int dst0, LAS unsigned* scr, int lane, float scale) {
    const int lg = lane >> 4, lc = lane & 15;
    const float* wp = W + (size_t)(k0 + 4 * lg) * ldw + (lc < 8 ? src0 : src1 - 32) + 4 * lc;
#pragma unroll
    for (int hf = 0; hf < 2; ++hf) {
        f32x4 v[4][4];
#pragma unroll
        for (int i = 0; i < 4; ++i)
#pragma unroll
            for (int p = 0; p < 4; ++p) v[i][p] = *(const f32x4*)(wp + (size_t)(64 * hf + 16 * i + p) * ldw);
#pragma unroll
        for (int i = 0; i < 4; ++i)
#pragma unroll
            for (int c = 0; c < 4; ++c) scr[(4 * lc + c) * 33 + 16 * hf + 4 * i + lg] = pk4_fp8_raw(v[i][0][c] * scale, v[i][1][c] * scale, v[i][2][c] * scale, v[i][3][c] * scale);
    }
    asm volatile("s_waitcnt lgkmcnt(0)" ::: "memory");
    const int rn = lane >> 3, ch = lane & 7;
#pragma unroll
    for (int j = 0; j < 8; ++j) { const int n = rn + 8 * j; const LAS unsigned* s = scr + n * 33 + 4 * ch; u32x4 o; o.x = s[0]; o.y = s[1]; o.z = s[2]; o.w = s[3];
        *(u32x4*)(WT + (size_t)(dst0 + n) * ldk + k0 + 16 * ch) = o; }
    asm volatile("s_waitcnt lgkmcnt(0)" ::: "memory");
}
constexpr int P0_KD = MIX_FP8 ? 128 : 64;
constexpr int P0_T_HEAD = 768 + 256 + 1, P0_T_ALL = P0_T_HEAD + (2048 / P0_KD) * 136 + 2 * (1024 / P0_KD) * 32 + (2048 / P0_KD) * 32;
__device__ __forceinline__ void p0_prologue(Frame& F, const int t_lo, const int t_hi, const int gw_, const int NGW_) {
    refresh(F);
    LAS unsigned* scr = (LAS unsigned*)(F.lds + RING_OFF + F.wave * 8448);
    LAS f32x4* ca = (LAS f32x4*)(F.lds + RING_OFF + 69632);
    for (int k = F.tid; k < 2048; k += NWAVES * 64) { f32x4 v;
#pragma unroll
        for (int b = 0; b < 4; ++b) { const float cv = F.c[b * 2048 + k]; v[b] = cv / (1.0f + expf(-cv)); }
        ca[k] = v; }
    __syncthreads();
    const int gw = gw_, NGW = NGW_, lane = F.lane;
    constexpr int KD = P0_KD;
    constexpr int T_ADA = 768, T_ROPE = 256, T_BIAS = 1, T_WIN = (2048 / KD) * 136, T_WA = (1024 / KD) * 32, T_WB = (1024 / KD) * 32, T_WOUT = (2048 / KD) * 32;
    constexpr int NT = T_ADA + T_ROPE + T_BIAS + T_WIN + T_WA + T_WB + T_WOUT;
    static_assert(NT == P0_T_ALL && T_ADA + T_ROPE + T_BIAS == P0_T_HEAD, "prologue task list");
    float* mod = wsp<float>(F, WS_MOD); float* cosT = wsp<float>(F, WS_COS); float* sinT = wsp<float>(F, WS_SIN); float* binp = wsp<float>(F, WS_BINP);
    for (int it = t_lo + gw; it < t_hi; it += NGW) {
        int r = it;
        if (r < T_ADA) {
            const int j0 = 16 * r, cl = lane & 3, kr = lane >> 2;
            f32x4 a[4];
#pragma unroll
            for (int b = 0; b < 4; ++b) a[b] = (f32x4){0.f, 0.f, 0.f, 0.f};
            const float* wp = F.w_ada + (size_t)kr * MODW + j0 + 4 * cl;
#pragma unroll 8
            for (int s = 0; s < 128; ++s) { const f32x4 w4 = *(const f32x4*)(wp + (size_t)s * 16 * MODW); const f32x4 c4 = ca[16 * s + kr];
#pragma unroll
                for (int b = 0; b < 4; ++b) a[b] += w4 * c4[b]; }
#pragma unroll
            for (int b = 0; b < 4; ++b)
#pragma unroll
                for (int c = 0; c < 4; ++c) { float v = a[b][c]; v += __shfl_xor(v, 4); v += __shfl_xor(v, 8); v += __shfl_xor(v, 16); v += __shfl_xor(v, 32); a[b][c] = v; }
            if (kr == 0) { const f32x4 bb = *(const f32x4*)(F.b_ada + j0 + 4 * cl);
#pragma unroll
                for (int b = 0; b < 4; ++b) *(f32x4*)(mod + b * MODW + j0 + 4 * cl) = a[b] + bb; }
            continue; } r -= T_ADA;
        if (r < T_ROPE) {
            const int i = lane & 31, ts = lane >> 5; const float inv = 1.0f / powf(10000.0f, (float)(2 * i) / 64.0f);
            for (int j = 0; j < 16; ++j) { const int t = 32 * r + 2 * j + ts; const float ang = (float)F.pos[t] * inv; cosT[t * 32 + i] = cosf(ang); sinT[t * 32 + i] = sinf(ang); }
            continue; } r -= T_ROPE;
        if (r < T_BIAS) { for (int q = lane; q < 8704; q += 64) binp[q] = F.b_in[in_src(q)]; continue; } r -= T_BIAS;
        const float* W; size_t ldw; int kb, nb, s0, s1; unsigned char* WT; size_t ldk;
        if (r < T_WIN) { kb = r / 136; nb = r % 136; W = F.w_in; ldw = INW; s0 = in_src(64 * nb); s1 = in_src(64 * nb + 32); WT = wsp<unsigned char>(F, WS_WIN); ldk = 2048; }
        else if ((r -= T_WIN) < T_WA) { kb = r / 32; nb = r % 32; W = F.w_a; ldw = 2048; s0 = 64 * nb; s1 = s0 + 32; WT = wsp<unsigned char>(F, WS_WAB); ldk = 1024; }
        else if ((r -= T_WA) < T_WB) { kb = r / 32; nb = r % 32; W = F.w_b; ldw = 2048; s0 = 64 * nb; s1 = s0 + 32; WT = wsp<unsigned char>(F, WS_WAB) + (size_t)2048 * 1024 * MIX_EB; ldk = 1024; }
        else { r -= T_WB; W = F.w_out; ldw = 2048; WT = wsp<unsigned char>(F, WS_WOUT); ldk = 2048;
            if constexpr (MIX_FP8 && !P5_FP8) { kb = r / 32; nb = r % 32; s0 = 64 * nb; s1 = s0 + 32;
                transpose_item(W, ldw, 128 * kb, s0, s1, (bf16_t*)WT, ldk, 64 * nb, scr, lane); transpose_item(W, ldw, 128 * kb + 64, s0, s1, (bf16_t*)WT, ldk, 64 * nb, scr, lane); continue; }
            kb = r / 32; nb = r % 32; s0 = 64 * nb; s1 = s0 + 32; }
        if constexpr (MIX_FP8) transpose_item_f8(W, ldw, 128 * kb, s0, s1, WT, ldk, 64 * nb, scr, lane, WSCALE);
        else transpose_item(W, ldw, 64 * kb, s0, s1, (bf16_t*)WT, ldk, 64 * nb, scr, lane);
    }
}
constexpr int T_WGU = MOE_FP8 ? 32 * 16 * 64 : 32 * 32 * 64, T_WD = MOE_FP8 ? 32 * 16 * 32 : 32 * 32 * 32;
__device__ __forceinline__ void convert_item(Frame& F, int r, LAS unsigned* scr, int lane) {
    if (r < T_WGU) {
        if constexpr (MOE_FP8) { const int e = r >> 10, q = r & 1023, kb = q >> 6, nb = q & 63; const int r0 = 64 * nb, src = ((r0 & 255) >> 7) * 2048 + (r0 >> 8) * 128 + (r0 & 127);
            transpose_item_f8(F.w_gu + (size_t)e * 2048 * 4096, 4096, 128 * kb, src, src + 32, wsp<unsigned char>(F, WS_WGU) + (size_t)e * 4096 * 2048, 2048, r0, scr, lane, WSCALE); }
        else { const int e = r >> 11, q = r & 2047, kb = q >> 6, nb = q & 63; const int r0 = 64 * nb, src = ((r0 & 255) >> 7) * 2048 + (r0 >> 8) * 128 + (r0 & 127);
            transpose_item(F.w_gu + (size_t)e * 2048 * 4096, 4096, 64 * kb, src, src + 32, wsp<bf16_t>(F, WS_WGU) + (size_t)e * 4096 * 2048, 2048, r0, scr, lane); }
        return; }
    r -= T_WGU;
    if constexpr (MOE_FP8) { const int e = r >> 9, q = r & 511, kb = q >> 5, nb = q & 31;
        transpose_item_f8(F.w_dn + (size_t)e * 2048 * 2048, 2048, 128 * kb, 64 * nb, 64 * nb + 32, wsp<unsigned char>(F, WS_WD) + (size_t)e * 2048 * 2048, 2048, 64 * nb, scr, lane, WSCALE); }
    else { const int e = r >> 10, q = r & 1023, kb = q >> 5, nb = q & 31;
        transpose_item(F.w_dn + (size_t)e * 2048 * 2048, 2048, 64 * kb, 64 * nb, 64 * nb + 32, wsp<bf16_t>(F, WS_WD) + (size_t)e * 2048 * 2048, 2048, 64 * nb, scr, lane); }
}
struct CvItem { const char* src; unsigned char* dst; };
template <bool GU> __device__ __forceinline__ CvItem cv_decode(Frame& F, int r) {
    constexpr int N = GU ? T_WGU : T_WD; constexpr size_t ldw = GU ? 4096 : 2048;
    r = r < N ? r : 0;
    const int e = r >> (GU ? 10 : 9), q = r & (GU ? 1023 : 511), kb = q >> (GU ? 6 : 5), nb = q & (GU ? 63 : 31), r0 = 64 * nb;
    const int srcc = GU ? ((r0 & 255) >> 7) * 2048 + (r0 >> 8) * 128 + (r0 & 127) : r0;
    CvItem P;
    P.src = (const char*)((GU ? F.w_gu : F.w_dn) + (size_t)e * 2048 * ldw + (size_t)(128 * kb) * ldw + srcc);
    P.dst = (GU ? wsp<unsigned char>(F, WS_WGU) : wsp<unsigned char>(F, WS_WD)) + (size_t)e * ldw * 2048 + (size_t)r0 * 2048 + 128 * kb;
    return P;
}
template <bool GU> __device__ __forceinline__ void convert_loop(Frame& F, unsigned* head) {
    constexpr int N = GU ? T_WGU : T_WD, NP = (N + 2) / 3 * 3; constexpr unsigned ldwb = (GU ? 4096u : 2048u) * 4u;
    LAS unsigned* scr = (LAS unsigned*)(F.lds + RING_OFF + F.wave * 8448);
    const int lane = F.lane, lg = lane >> 4, lc = lane & 15, rn = lane >> 3, ch = lane & 7;
    const unsigned lo = (unsigned)(4 * lg) * ldwb + 16u * (unsigned)lc;
    f32x4 A[4][4], B[4][4], C[4][4];
#define CV_LOAD(buf, P, h) do { _Pragma("unroll") for (int i = 0; i < 4; ++i) _Pragma("unroll") for (int p = 0; p < 4; ++p) { const char* rb_ = (P).src + (size_t)(64 * (h) + 16 * i + p) * ldwb; \
        asm volatile("global_load_dwordx4 %0, %1, %2 nt" : "=v"(buf[i][p]) : "v"(lo), "s"(rb_) : "memory"); } } while (0)
#define CV_WAIT(N, buf) do { asm volatile("s_waitcnt vmcnt(" #N ")" ::: "memory"); _Pragma("unroll") for (int i = 0; i < 4; ++i) asm volatile("" : "+v"(buf[i][0]), "+v"(buf[i][1]), "+v"(buf[i][2]), "+v"(buf[i][3])); } while (0)
#define CV_PROC(buf, h) do { _Pragma("unroll") for (int i = 0; i < 4; ++i) _Pragma("unroll") for (int c = 0; c < 4; ++c) \
        scr[(4 * lc + c) * 33 + 16 * (h) + 4 * i + lg] = pk4_fp8_raw(buf[i][0][c] * WSCALE, buf[i][1][c] * WSCALE, buf[i][2][c] * WSCALE, buf[i][3][c] * WSCALE); } while (0)
#define CV_STORE(P) do { _Pragma("unroll") for (int j = 0; j < 8; ++j) { const LAS unsigned* s_ = scr + (rn + 8 * j) * 33 + 4 * ch; u32x4 o_; o_.x = s_[0]; o_.y = s_[1]; o_.z = s_[2]; o_.w = s_[3]; \
        const unsigned so_ = (unsigned)(rn + 8 * j) * 2048u + 16u * (unsigned)ch; asm volatile("global_store_dwordx4 %0, %1, %2 nt" :: "v"(so_), "v"(o_), "s"((P).dst) : "memory"); } } while (0)
    const unsigned claim_add = 3u, claim_off = 0u; unsigned long long ex_save;
#define CV_CLAIM() asm volatile("s_mov_b64 %1, exec\n\ts_mov_b64 exec, 1\n\tglobal_atomic_add %0, %2, %3, %4 sc0\n\ts_mov_b64 exec, %1" : "+v"(raw), "=&s"(ex_save) : "v"(claim_off), "v"(claim_add), "s"(head) : "memory")
    unsigned raw = 0u;
    CV_CLAIM();
    asm volatile("s_waitcnt vmcnt(0)" : "+v"(raw) :: "memory");
    int base = (int)__builtin_amdgcn_readfirstlane(raw);
    CV_CLAIM();
    CvItem P0 = cv_decode<GU>(F, base), P1, P2;
    CV_LOAD(A, P0, 0); CV_LOAD(B, P0, 1);
    {
      unsigned char* junk = wsp<unsigned char>(F, WS_JUNK) + (size_t)(blockIdx.x * NWAVES + F.wave) * 16384; const u32x4 zz_ = {0u, 0u, 0u, 0u};
#pragma unroll
      for (int j = 0; j < 8; ++j) { const unsigned so_ = (unsigned)(rn + 8 * j) * 128u + 16u * (unsigned)ch; asm volatile("global_store_dwordx4 %0, %1, %2 nt" :: "v"(so_), "v"(zz_), "s"(junk) : "memory"); } }
    while (base < NP) {
        P1 = cv_decode<GU>(F, base + 1); P2 = cv_decode<GU>(F, base + 2);
        CV_LOAD(C, P1, 0); CV_WAIT(40, A); CV_PROC(A, 0);
        CV_LOAD(A, P1, 1); CV_WAIT(40, B); CV_PROC(B, 1); CV_STORE(P0);
        CV_LOAD(B, P2, 0); CV_WAIT(40, C); CV_PROC(C, 0);
        CV_LOAD(C, P2, 1); CV_WAIT(40, A); CV_PROC(A, 1); CV_STORE(P1);
        asm volatile("s_waitcnt vmcnt(48)" : "+v"(raw) :: "memory");
        base = (int)__builtin_amdgcn_readfirstlane(raw);
        CV_CLAIM();
        P0 = cv_decode<GU>(F, base);
        CV_LOAD(A, P0, 0); CV_WAIT(41, B); CV_PROC(B, 0);
        CV_LOAD(B, P0, 1); CV_WAIT(41, C); CV_PROC(C, 1); CV_STORE(P2);
    }
#undef CV_WAIT
    asm volatile("s_waitcnt vmcnt(0)" ::: "memory");
#undef CV_CLAIM
#undef CV_LOAD
#undef CV_PROC
#undef CV_STORE
}
__device__ __forceinline__ void convert_queue(Frame& F) {
    refresh(F);
    __syncthreads();
    if constexpr (!MOE_FP8) {
        LAS unsigned* scr0 = (LAS unsigned*)(F.lds + RING_OFF + F.wave * 8448); unsigned* head0 = F.ctl + CW_CQ; constexpr int NQ0 = T_WGU + T_WD;
        for (;;) { unsigned raw0 = 0u; if (F.lane == 0) raw0 = __hip_atomic_fetch_add(head0, 1u, __ATOMIC_RELAXED, __HIP_MEMORY_SCOPE_AGENT); const int it = (int)__builtin_amdgcn_readfirstlane(raw0); if (it >= NQ0) break; convert_item(F, it, scr0, F.lane); }
        __syncthreads(); return; }
    convert_loop<true>(F, F.ctl + CW_CQ);
    convert_loop<false>(F, F.ctl + CW_CQ + 128);
    __syncthreads();
}


constexpr int CS_GU = 32 * 8 * 16, CS_DN = 32 * 8 * 8, CS_N = CS_GU + CS_DN, CS_PITCH = 65;
constexpr int CW_CQ1 = CW_CQ + 256, CW_CQ2 = CW_CQ + 320, CW_START2 = CW_CQ + 384; constexpr unsigned CONV_BUMP = 1u << 20;
__device__ __forceinline__ void convert_coop(Frame& F, unsigned* head, const int base) {
    refresh(F);
    __syncthreads();
    LAS unsigned* tile0 = (LAS unsigned*)(F.lds + RING_OFF);
    const int lane = F.lane, w = F.wave;
    if (F.tid == 0) F.MISC[104] = __hip_atomic_fetch_add(head, 1u, __ATOMIC_RELAXED, __HIP_MEMORY_SCOPE_AGENT);
    __syncthreads();
    int slot = 0, p = 0;
    for (;;) {
        const unsigned rawit = F.MISC[104 + slot];
        if (rawit >= (unsigned)CS_N) break;
        const int it = base + (int)rawit;
        if (it >= CS_N) break;
        if (F.tid == 0) F.MISC[104 + (slot ^ 1)] = __hip_atomic_fetch_add(head, 1u, __ATOMIC_RELAXED, __HIP_MEMORY_SCOPE_AGENT);
        const bool gu = it < CS_GU; const int r = gu ? it : it - CS_GU;
        const int e = gu ? (r >> 7) : (r >> 6), q = gu ? (r & 127) : (r & 63), kb = gu ? (q >> 4) : (q >> 3), nb = gu ? (q & 15) : (q & 7);
        const size_t ldw = gu ? 4096 : 2048;
        const float* W = (gu ? F.w_gu : F.w_dn) + (size_t)e * 2048 * ldw + (size_t)(256 * kb + 32 * w) * ldw;
        const int scol = gu ? ((lane >> 5) * 2048 + nb * 128 + 4 * (lane & 31)) : (nb * 256 + 4 * lane);
        unsigned char* O = (gu ? wsp<unsigned char>(F, WS_WGU) : wsp<unsigned char>(F, WS_WD)) + (size_t)e * ldw * 2048 + (size_t)(256 * nb) * 2048 + 256 * kb;
        LAS unsigned* T = tile0 + p * (256 * CS_PITCH);
        f32x4 v[32];
#pragma unroll
        for (int i = 0; i < 32; ++i) v[i] = __builtin_nontemporal_load((const f32x4*)(W + (size_t)i * ldw + scol));
#pragma unroll
        for (int kk = 0; kk < 8; ++kk)
#pragma unroll
            for (int c = 0; c < 4; ++c) T[(4 * lane + c) * CS_PITCH + 8 * w + kk] = pk4_fp8_raw(v[4 * kk][c] * WSCALE, v[4 * kk + 1][c] * WSCALE, v[4 * kk + 2][c] * WSCALE, v[4 * kk + 3][c] * WSCALE);
        __syncthreads();
#pragma unroll
        for (int i = 0; i < 8; ++i) { const int n = 32 * w + 4 * i + (lane >> 4), ch = lane & 15; const LAS unsigned* s_ = T + n * CS_PITCH + 4 * ch; u32x4 o; o.x = s_[0]; o.y = s_[1]; o.z = s_[2]; o.w = s_[3];
            __builtin_nontemporal_store(o, (u32x4*)(O + (size_t)n * 2048 + 16 * ch)); }
        slot ^= 1; p ^= 1;
    }
    __syncthreads();
}

__device__ __forceinline__ void p1_norm_fb(Frame& F) {
    refresh(F);
#pragma unroll 1
    for (int i0 = F.tid; i0 < 2048 * 4; i0 += 8 * NWAVES * 64) {
        f32x4 v[8];
#pragma unroll
        for (int u = 0; u < 8; ++u) { const int i = i0 + u * NWAVES * 64, k = i >> 2, q = i & 3; v[u] = *(const f32x4*)(F.w_in + (size_t)k * INW + 4608 + 4 * q); }
#pragma unroll
        for (int u = 0; u < 8; ++u) { const int i = i0 + u * NWAVES * 64, k = i >> 2, q = i & 3; const int j = k >> 8, l = (k & 255) >> 2, c = k & 3; *(LAS f32x4*)(F.lds + RING_OFF + ((((j * 4 + c) * 4 + q) * 64 + l) << 4)) = v[u]; } }
    __syncthreads();
    const int gw = F.vcu * NWAVES + F.wave, NGW = F.G * NWAVES, lane = F.lane;
    const float* mod = wsp<float>(F, WS_MOD); unsigned char* XN = wsp<unsigned char>(F, WS_XN); float* LOGF = wsp<float>(F, WS_LOGF);
    for (int row = gw; row < NTOK; row += NGW) {
        const int b = row >> 11; const float* xr = F.x + (size_t)row * DM; const float* sh = mod + b * MODW, *sc = mod + b * MODW + 2048;
        f32x4 v[8]; float ss = 0.f;
#pragma unroll
        for (int j = 0; j < 8; ++j) { v[j] = *(const f32x4*)(xr + 256 * j + 4 * lane); ss += v[j][0] * v[j][0] + v[j][1] * v[j][1] + v[j][2] * v[j][2] + v[j][3] * v[j][3]; }
        ss = wave_sum(ss); const float rstd = 1.0f / sqrtf(ss * (1.0f / DM) + 1e-5f);
        float fa[16];
#pragma unroll
        for (int h = 0; h < 16; ++h) fa[h] = 0.f;
#pragma unroll
        for (int j = 0; j < 8; ++j) { const int col = 256 * j + 4 * lane; const f32x4 g = *(const f32x4*)(F.g_mix + col), s1 = *(const f32x4*)(sc + col), h1 = *(const f32x4*)(sh + col);
            const f32x4 y = v[j] * rstd * g * (s1 + 1.0f) + h1;
            if constexpr (MIX_FP8) *(unsigned*)(XN + (size_t)row * DM + col) = pk4_fp8(y[0], y[1], y[2], y[3]);
            else { u32x2 w; w.x = pk2(y[0], y[1]); w.y = pk2(y[2], y[3]); *(u32x2*)((bf16_t*)XN + (size_t)row * DM + col) = w; }
#pragma unroll
            for (int c = 0; c < 4; ++c) {
#pragma unroll
                for (int q = 0; q < 4; ++q) { const f32x4 wv = *(const LAS f32x4*)(F.lds + RING_OFF + ((((j * 4 + c) * 4 + q) * 64 + lane) << 4));
#pragma unroll
                    for (int e = 0; e < 4; ++e) fa[4 * q + e] += y[c] * wv[e]; }
                if (c & 1) asm volatile("" ::: "memory"); } }
#pragma unroll
        for (int h = 0; h < 16; ++h) fa[h] = wave_sum(fa[h]);
        float mine = 0.f;
#pragma unroll
        for (int h = 0; h < 16; ++h) mine = (lane == h) ? fa[h] : mine;
        if (lane < 16) { const float f = mine + F.b_in[4608 + lane]; LOGF[row * 16 + lane] = fminf(f, 0.f) - log1pf(expf(-fabsf(f))); }
    }
}
__device__ __forceinline__ void p2_cumsum(Frame& F) {
    refresh(F);
    volatile LAS float* wsum_s = (volatile LAS float*)(F.MISC + 96);
    const float* LOGF = wsp<float>(F, WS_LOGF); float* CUM = wsp<float>(F, WS_CUM);
    for (int bh = F.vcu; bh < 64; bh += F.G) {
        const int b = bh >> 4, h = bh & 15, t0 = 4 * F.tid;
        float a[4];
#pragma unroll
        for (int i = 0; i < 4; ++i) a[i] = LOGF[(size_t)(b * SEQ + t0 + i) * 16 + h];
        a[1] += a[0]; a[2] += a[1]; a[3] += a[2];
        float s = a[3];
#pragma unroll
        for (int o = 1; o < 64; o <<= 1) { const float t = __shfl_up(s, o); if (F.lane >= o) s += t; }
        if (F.lane == 63) wsum_s[F.wave] = s;
        __syncthreads();
        float base = 0.f;
        for (int w = 0; w < F.wave; ++w) base += wsum_s[w];
        const float excl = base + s - a[3];
#pragma unroll
        for (int i = 0; i < 4; ++i) CUM[(size_t)bh * SEQ + t0 + i] = excl + a[i];
        __syncthreads();
    }
}

constexpr int AT_KOFF = 0, AT_VOFF = 9216, AT_COFF = 17920, AT_BUF = 18432;
template <int MODE>
__device__ __forceinline__ void attn_unit(LAS unsigned char* lds, const bf16_t* __restrict__ Q, const bf16_t* __restrict__ Kt, const bf16_t* __restrict__ Vt, const float* __restrict__ cum, unsigned char* __restrict__ O,
                                          int b, int h, int qb, float sink2, int wid) {
    const int lane = lane_id(), tid = wid * 64 + lane, r32 = lane & 31, hi = lane >> 5;
    constexpr int KP = MODE ? 1024 : 256;
    const int kvh = MODE ? h : (h >> 2);
    const int q0 = qb * 256, w0 = q0 + 32 * wid;
    const size_t rowbase = (size_t)b * SEQ;
    bf16x8 qf[4];
    { const bf16_t* qp = Q + (rowbase + w0 + r32) * 1024 + h * 64 + hi * 8;
#pragma unroll
      for (int d0 = 0; d0 < 4; ++d0) qf[d0] = *(const bf16x8*)(qp + d0 * 16); }
    const int kt_lo = MODE ? 0 : (q0 >= 128 ? ((q0 - 128) >> 6) : 0), kt_hi = (q0 + 255) >> 6;
    const int skey = tid >> 3, sch = tid & 7, vp = (tid & 255) >> 3;
    const bf16_t* kg = Kt + (rowbase + skey) * KP + kvh * 64 + sch * 8;
    const bf16_t* vg = Vt + (rowbase + 2 * vp) * KP + kvh * 64 + sch * 8;
    u32x4 kreg, vr0, vr1; float ckreg = 0.f;
#define AT_LOAD(kt) do { kreg = *(const u32x4*)(kg + (size_t)(kt) * 64 * KP); if (tid >= 256) { vr0 = *(const u32x4*)(vg + (size_t)(kt) * 64 * KP); vr1 = *(const u32x4*)(vg + (size_t)(kt) * 64 * KP + KP); } \
        if (MODE && tid < 64) ckreg = cum[(kt) * 64 + tid] * LOG2E; } while (0)
    AT_LOAD(kt_lo);
    float m = MODE ? -1e30f : sink2, l = (MODE == 0 && hi == 0) ? 1.0f : 0.0f;
    const float cq2 = MODE ? cum[w0 + r32] * LOG2E : 0.f;
    f32x16 o0 = {}, o1 = {};
    for (int kt = kt_lo; kt <= kt_hi; ++kt) {
        LAS unsigned char* buf = lds + ((kt - kt_lo) & 1) * AT_BUF;
        *(LAS u32x4*)(buf + AT_KOFF + skey * 144 + sch * 16) = kreg;
        if (tid >= 256) {
#pragma unroll
            for (int i = 0; i < 8; ++i) { const unsigned a = vr0[i >> 1], c = vr1[i >> 1];
                *(LAS unsigned*)(buf + AT_VOFF + (8 * sch + i) * 136 + vp * 4) = __builtin_amdgcn_perm(c, a, (i & 1) ? 0x07060302u : 0x05040100u); } }
        if (MODE && tid < 64) *(LAS float*)(buf + AT_COFF + tid * 4) = ckreg;
        __syncthreads();
        if (kt < kt_hi) AT_LOAD(kt + 1);
        const int k0 = kt * 64;
        const bool active = (k0 <= w0 + 31) && (MODE || (k0 + 63 >= w0 - 127));
        if (active) {
            f32x16 p0 = {}, p1 = {};
            { const LAS unsigned char* kb = buf + AT_KOFF + r32 * 144 + hi * 16;
#pragma unroll
              for (int d0 = 0; d0 < 4; ++d0) { const bf16x8 ka = *(const LAS bf16x8*)(kb + d0 * 32), kc = *(const LAS bf16x8*)(kb + 32 * 144 + d0 * 32);
                  p0 = __builtin_amdgcn_mfma_f32_32x32x16_bf16(ka, qf[d0], p0, 0, 0, 0); p1 = __builtin_amdgcn_mfma_f32_32x32x16_bf16(kc, qf[d0], p1, 0, 0, 0); } }
            if (MODE) {
#pragma unroll
                for (int g = 0; g < 4; ++g) { const f32x4 c0 = *(const LAS f32x4*)(buf + AT_COFF + (8 * g + 4 * hi) * 4), c1 = *(const LAS f32x4*)(buf + AT_COFF + (32 + 8 * g + 4 * hi) * 4);
#pragma unroll
                    for (int j = 0; j < 4; ++j) { p0[4 * g + j] += cq2 - c0[j]; p1[4 * g + j] += cq2 - c1[j]; } } }
            const bool need_mask = MODE ? (k0 + 63 > w0) : true;
            if (need_mask) { const int q = w0 + r32;
#pragma unroll
                for (int r = 0; r < 16; ++r) { const int key = k0 + (r & 3) + 8 * (r >> 2) + 4 * hi;
                    const bool v0 = (key <= q) && (MODE || key + 127 >= q), v1 = (key + 32 <= q) && (MODE || key + 32 + 127 >= q);
                    p0[r] = v0 ? p0[r] : -INFINITY; p1[r] = v1 ? p1[r] : -INFINITY; } }
            float rm = __builtin_fmaxf(p0[0], p1[0]);
#pragma unroll
            for (int r = 1; r < 16; ++r) rm = __builtin_fmaxf(__builtin_fmaxf(rm, p0[r]), p1[r]);
            { const unsigned ru = __builtin_bit_cast(unsigned, rm); auto rr = __builtin_amdgcn_permlane32_swap(ru, ru, false, false);
              rm = __builtin_fmaxf(__builtin_bit_cast(float, rr[0]), __builtin_bit_cast(float, rr[1])); }
            const float mn = fmaxf(m, rm), alpha = __builtin_amdgcn_exp2f(m - mn);
            const bool grew = mn > m; m = mn;
            float ps = 0.f;
#pragma unroll
            for (int r = 0; r < 16; ++r) { p0[r] = __builtin_amdgcn_exp2f(p0[r] - mn); p1[r] = __builtin_amdgcn_exp2f(p1[r] - mn); ps += p0[r] + p1[r]; }
            l = l * alpha + ps;
            if (__any(grew)) {
#pragma unroll
                for (int r = 0; r < 16; ++r) { o0[r] *= alpha; o1[r] *= alpha; } }
            bf16x8 pf[4];
            { u32x4 w;
              w.x = pk2(p0[0], p0[1]); w.y = pk2(p0[2], p0[3]); w.z = pk2(p0[4], p0[5]); w.w = pk2(p0[6], p0[7]); pf[0] = __builtin_bit_cast(bf16x8, w);
              w.x = pk2(p0[8], p0[9]); w.y = pk2(p0[10], p0[11]); w.z = pk2(p0[12], p0[13]); w.w = pk2(p0[14], p0[15]); pf[1] = __builtin_bit_cast(bf16x8, w);
              w.x = pk2(p1[0], p1[1]); w.y = pk2(p1[2], p1[3]); w.z = pk2(p1[4], p1[5]); w.w = pk2(p1[6], p1[7]); pf[2] = __builtin_bit_cast(bf16x8, w);
              w.x = pk2(p1[8], p1[9]); w.y = pk2(p1[10], p1[11]); w.z = pk2(p1[12], p1[13]); w.w = pk2(p1[14], p1[15]); pf[3] = __builtin_bit_cast(bf16x8, w); }
            const LAS unsigned char* vb = buf + AT_VOFF + r32 * 136 + hi * 8;
#pragma unroll
            for (int ks = 0; ks < 4; ++ks) {
                { const u32x2 lo = *(const LAS u32x2*)(vb + ks * 32), hh = *(const LAS u32x2*)(vb + ks * 32 + 16); const u32x4 w = {lo.x, lo.y, hh.x, hh.y};
                  o0 = __builtin_amdgcn_mfma_f32_32x32x16_bf16(__builtin_bit_cast(bf16x8, w), pf[ks], o0, 0, 0, 0); }
                { const u32x2 lo = *(const LAS u32x2*)(vb + 32 * 136 + ks * 32), hh = *(const LAS u32x2*)(vb + 32 * 136 + ks * 32 + 16); const u32x4 w = {lo.x, lo.y, hh.x, hh.y};
                  o1 = __builtin_amdgcn_mfma_f32_32x32x16_bf16(__builtin_bit_cast(bf16x8, w), pf[ks], o1, 0, 0, 0); } }
        }
    }
#undef AT_LOAD
    l += __shfl_xor(l, 32);
    const float inv = 1.0f / l;
    const size_t oe = (rowbase + w0 + r32) * 2048 + MODE * 1024 + h * 64 + 4 * hi;
#pragma unroll
    for (int g = 0; g < 4; ++g) {
        if constexpr (MIX_FP8) { *(unsigned*)(O + oe + 8 * g) = pk4_fp8(o0[4 * g] * inv, o0[4 * g + 1] * inv, o0[4 * g + 2] * inv, o0[4 * g + 3] * inv);
            *(unsigned*)(O + oe + 32 + 8 * g) = pk4_fp8(o1[4 * g] * inv, o1[4 * g + 1] * inv, o1[4 * g + 2] * inv, o1[4 * g + 3] * inv); }
        else { bf16_t* op = (bf16_t*)O + oe; u32x2 w; w.x = pk2(o0[4 * g] * inv, o0[4 * g + 1] * inv); w.y = pk2(o0[4 * g + 2] * inv, o0[4 * g + 3] * inv); *(u32x2*)(op + 8 * g) = w;
            w.x = pk2(o1[4 * g] * inv, o1[4 * g + 1] * inv); w.y = pk2(o1[4 * g + 2] * inv, o1[4 * g + 3] * inv); *(u32x2*)(op + 32 + 8 * g) = w; } }
    __syncthreads();
}
#ifndef ATT_SIGNAL_DEF
#define ATT_SIGNAL_DEF 960
#endif
constexpr int ATT_SIGNAL = ATT_SIGNAL_DEF;
__device__ __forceinline__ void p3_attention(Frame& F) {
    refresh(F);
    const bf16_t *QA = wsp<bf16_t>(F, WS_QA), *KA = wsp<bf16_t>(F, WS_KA), *VA = wsp<bf16_t>(F, WS_VA), *QB = wsp<bf16_t>(F, WS_QB), *KB = wsp<bf16_t>(F, WS_KB), *VB = wsp<bf16_t>(F, WS_VB);
    const float* CUM = wsp<float>(F, WS_CUM); unsigned char* YAB = wsp<unsigned char>(F, WS_YAB);
    LAS unsigned char* lds = F.lds + RING_OFF;
    unsigned* head = F.ctl + CW_AQ;
    for (;;) {
        __syncthreads();
        if (F.tid == 0) F.MISC[100] = __hip_atomic_fetch_add(head, 1u, __ATOMIC_RELAXED, __HIP_MEMORY_SCOPE_AGENT);
        __syncthreads();
        const int u = (int)F.MISC[100];
        if (u >= 1024) break;
        if (u == ATT_SIGNAL && F.tid == 0 && F.G < (int)gridDim.x) {
            const unsigned old = __hip_atomic_fetch_add(F.ctl + CW_CQ1, CONV_BUMP, __ATOMIC_RELAXED, __HIP_MEMORY_SCOPE_AGENT);
            __hip_atomic_store(F.ctl + CW_START2, old < (unsigned)CS_N ? old : (unsigned)CS_N, __ATOMIC_RELAXED, __HIP_MEMORY_SCOPE_AGENT); }
        if (u < 512) { const int bh = u & 63, qb = 7 - (u >> 6); attn_unit<1>(lds, QB, KB, VB, CUM + (size_t)bh * SEQ, YAB, bh >> 4, bh & 15, qb, 0.f, F.wave); }
        else { const int v = u - 512, bh = v >> 3, qb = v & 7; attn_unit<0>(lds, QA, KA, VA, nullptr, YAB, bh >> 4, bh & 15, qb, F.sinks[bh & 15] * LOG2E, F.wave); }
    }
}

template <int HH>
__device__ __forceinline__ void p6_half(Frame& F) {
    refresh(F);
    const int gw = F.vcu * NWAVES + F.wave, NGW = F.G * NWAVES, lane = F.lane;
    const float* mod = wsp<float>(F, WS_MOD); const float* H1 = wsp<float>(F, WS_H1); unsigned char* XN2 = wsp<unsigned char>(F, WS_XN2);
    int* TEID = wsp<int>(F, WS_TEID); int* TPOS = wsp<int>(F, WS_TPOS); float* TGATE = wsp<float>(F, WS_TGATE); int* TOKOF = wsp<int>(F, WS_TOKOF);
    LAS float* part = (LAS float*)(F.lds + TBL_OFF) + F.wave * 256 + lane;
    __syncthreads();
#pragma unroll 1
    for (int i0 = F.tid; i0 < 1024 * 8; i0 += 8 * NWAVES * 64) {
        f32x4 v[8];
#pragma unroll
        for (int u = 0; u < 8; ++u) { const int i = i0 + u * NWAVES * 64, kk = i >> 3, q = i & 7; v[u] = *(const f32x4*)(F.w_r + (size_t)(1024 * HH + kk) * 32 + 4 * q); }
#pragma unroll
        for (int u = 0; u < 8; ++u) { const int i = i0 + u * NWAVES * 64, kk = i >> 3, q = i & 7; const int jj = kk >> 8, l = (kk & 255) >> 2, c = kk & 3; *(LAS f32x4*)(F.lds + RING_OFF + ((((jj * 4 + c) * 8 + q) * 64 + l) << 4)) = v[u]; } }
    __syncthreads();
#pragma unroll 1
    for (int ri = 0; ri < 4; ++ri) {
        const int row = gw + ri * NGW; if (row >= NTOK) break;
        int lane4 = 4 * lane; asm volatile("" : "+v"(lane4));
        const int b = row >> 11; const float* xr = H1 + (size_t)row * DM + lane4; const float* sh = mod + b * MODW + 6144 + lane4, *sc = mod + b * MODW + 8192 + lane4; const float* gp = F.g_ffn + lane4;
        f32x4 v[4]; float ss = 0.f;
#pragma unroll
        for (int j = 0; j < 4; ++j) { v[j] = *(const f32x4*)(xr + 256 * (4 * HH + j)); const f32x4 o = *(const f32x4*)(xr + 256 * (4 * (1 - HH) + j));
            ss += v[j][0] * v[j][0] + v[j][1] * v[j][1] + v[j][2] * v[j][2] + v[j][3] * v[j][3] + o[0] * o[0] + o[1] * o[1] + o[2] * o[2] + o[3] * o[3]; }
        ss = wave_sum(ss); const float rstd = 1.0f / sqrtf(ss * (1.0f / DM) + 1e-5f);
        float a[32];
#pragma unroll
        for (int e = 0; e < 32; ++e) a[e] = 0.f;
        const LAS unsigned char* wl = F.lds + RING_OFF + 4 * lane4;
#pragma unroll
        for (int jj = 0; jj < 4; ++jj) { const int col = 256 * (4 * HH + jj); const f32x4 g = *(const f32x4*)(gp + col), s1 = *(const f32x4*)(sc + col), h1 = *(const f32x4*)(sh + col);
            const f32x4 y = v[jj] * rstd * g * (s1 + 1.0f) + h1;
            if constexpr (MOE_FP8) *(unsigned*)(XN2 + (size_t)row * DM + col + lane4) = pk4_fp8(y[0], y[1], y[2], y[3]);
            else { u32x2 w; w.x = pk2(y[0], y[1]); w.y = pk2(y[2], y[3]); *(u32x2*)((bf16_t*)XN2 + (size_t)row * DM + col + lane4) = w; }
#pragma unroll
            for (int c = 0; c < 4; ++c) {
#pragma unroll
                for (int q = 0; q < 8; ++q) { const f32x4 wv = *(const LAS f32x4*)(wl + ((((jj * 4 + c) * 8 + q) * 64) << 4));
#pragma unroll
                    for (int e = 0; e < 4; ++e) a[4 * q + e] += y[c] * wv[e]; }
                asm volatile("" ::: "memory"); } }
#define P6_RSTEP(XF, MASK, HALF) { const bool up = (lane & (MASK)) != 0; _Pragma("unroll") for (int i = 0; i < (HALF); ++i) { const float keep = up ? a[i + (HALF)] : a[i], give = up ? a[i] : a[i + (HALF)]; a[i] = keep + XF; } }
        P6_RSTEP(__shfl_xor(give, 32), 32, 16) P6_RSTEP(__shfl_xor(give, 16), 16, 8) P6_RSTEP(__shfl_xor(give, 8), 8, 4) P6_RSTEP(__shfl_xor(give, 4), 4, 2) P6_RSTEP(__shfl_xor(give, 2), 2, 1)
#undef P6_RSTEP
        float lg = a[0] + __shfl_xor(a[0], 1);
        if (HH == 0) { part[ri * 64] = lg; continue; }
        lg += part[ri * 64] + F.b_r[lane >> 1];
        float val[4]; int idx[4];
        float cur = lg;
#pragma unroll
        for (int k = 0; k < 4; ++k) { float bv = cur; int bi = lane >> 1;
#pragma unroll
            for (int o = 1; o < 64; o <<= 1) { const float ov = __shfl_xor(bv, o); const int oi = __shfl_xor(bi, o); if (ov > bv || (ov == bv && oi < bi)) { bv = ov; bi = oi; } }
            val[k] = bv; idx[k] = bi; if ((lane >> 1) == bi) cur = -INFINITY; }
        float ex[4], sm = 0.f;
#pragma unroll
        for (int k = 0; k < 4; ++k) { ex[k] = expf(val[k] - val[0]); sm += ex[k]; }
        if (lane < 4) { int e = idx[0]; float gt = ex[0];
#pragma unroll
            for (int k = 1; k < 4; ++k) if (lane == k) { e = idx[k]; gt = ex[k]; }
            const int p = (int)atomicAdd(F.ctl + CW_CNT + e, 1u);
            TOKOF[e * NTOK + p] = row; TEID[row * 4 + lane] = e; TPOS[row * 4 + lane] = p; TGATE[row * 4 + lane] = gt / sm; }
    }
}
__device__ __forceinline__ void p6_norm_router(Frame& F) { p6_half<0>(F); p6_half<1>(F); }
__device__ __forceinline__ void p6_router_mfma(Frame& F) {
    refresh(F);
    const int lane = F.lane, w = F.wave, m32 = lane & 31, hi = lane >> 5;
    const float* mod = wsp<float>(F, WS_MOD); const float* H1 = wsp<float>(F, WS_H1); unsigned char* XN2 = wsp<unsigned char>(F, WS_XN2);
    int* TEID = wsp<int>(F, WS_TEID); int* TPOS = wsp<int>(F, WS_TPOS); float* TGATE = wsp<float>(F, WS_TGATE); int* TOKOF = wsp<int>(F, WS_TOKOF);
    constexpr int AP = 1028;
    LAS float* Aimg = (LAS float*)(F.lds + RING_OFF);
    LAS float* Pt = (LAS float*)(F.lds + RING_OFF);
    for (int task = F.vcu; task < NTOK / 32; task += F.G) {
        const int row0 = 32 * task, b = row0 >> 11;
        const float* sh = mod + b * MODW + 6144, *sc = mod + b * MODW + 8192;
        f32x4 yk[4][4];
        __syncthreads();
#pragma unroll
        for (int rr = 0; rr < 4; ++rr) {
            const int rl = 4 * w + rr, row = row0 + rl; const float* xr = H1 + (size_t)row * DM + 4 * lane;
            f32x4 v[8]; float ss = 0.f;
#pragma unroll
            for (int j = 0; j < 8; ++j) { v[j] = *(const f32x4*)(xr + 256 * j); ss += v[j][0] * v[j][0] + v[j][1] * v[j][1] + v[j][2] * v[j][2] + v[j][3] * v[j][3]; }
            ss = wave_sum(ss); const float rstd = 1.0f / sqrtf(ss * (1.0f / DM) + 1e-5f);
#pragma unroll
            for (int j = 0; j < 8; ++j) { const int col = 256 * j + 4 * lane; const f32x4 g = *(const f32x4*)(F.g_ffn + col), s1 = *(const f32x4*)(sc + col), h1 = *(const f32x4*)(sh + col);
                const f32x4 y = v[j] * rstd * g * (s1 + 1.0f) + h1;
                if constexpr (MOE_FP8) *(unsigned*)(XN2 + (size_t)row * DM + col) = pk4_fp8(y[0], y[1], y[2], y[3]);
                else { u32x2 wv; wv.x = pk2(y[0], y[1]); wv.y = pk2(y[2], y[3]); *(u32x2*)((bf16_t*)XN2 + (size_t)row * DM + col) = wv; }
                if (j < 4) *(LAS f32x4*)(Aimg + rl * AP + col) = y; else yk[rr][j - 4] = y; }
        }
        f32x16 acc = {};
#pragma unroll
        for (int hh = 0; hh < 2; ++hh) {
            if (hh == 1) {
                __syncthreads();
#pragma unroll
                for (int rr = 0; rr < 4; ++rr)
#pragma unroll
                    for (int jj = 0; jj < 4; ++jj) *(LAS f32x4*)(Aimg + (4 * w + rr) * AP + 256 * jj + 4 * lane) = yk[rr][jj];
            }
            __syncthreads();
            const LAS float* ap = Aimg + m32 * AP + 128 * w + hi;
            const float* bp = F.w_r + (size_t)(1024 * hh + 128 * w + hi) * 32 + m32;
#pragma unroll 16
            for (int s_ = 0; s_ < 64; ++s_) acc = __builtin_amdgcn_mfma_f32_32x32x2f32(ap[2 * s_], bp[(size_t)2 * s_ * 32], acc, 0, 0, 0);
        }
        __syncthreads();
#pragma unroll
        for (int r = 0; r < 16; ++r) Pt[(w * 32 + (r & 3) + 8 * (r >> 2) + 4 * hi) * 33 + m32] = acc[r];
        __syncthreads();
#pragma unroll
        for (int rr = 0; rr < 4; ++rr) {
            const int rl = 4 * w + rr, row = row0 + rl;
            float lg = F.b_r[m32];
#pragma unroll
            for (int p = 0; p < 8; ++p) lg += Pt[(p * 32 + rl) * 33 + m32];
            float val[4]; int idx[4]; float cur = lg;
#pragma unroll
            for (int k = 0; k < 4; ++k) { float bv = cur; int bi = m32;
#pragma unroll
                for (int o = 1; o < 32; o <<= 1) { const float ov = __shfl_xor(bv, o); const int oi = __shfl_xor(bi, o); if (ov > bv || (ov == bv && oi < bi)) { bv = ov; bi = oi; } }
                val[k] = bv; idx[k] = bi; if (m32 == bi) cur = -INFINITY; }
            float ex[4], sm = 0.f;
#pragma unroll
            for (int k = 0; k < 4; ++k) { ex[k] = expf(val[k] - val[0]); sm += ex[k]; }
            if (lane < 4) { int e = idx[0]; float gt = ex[0];
#pragma unroll
                for (int k = 1; k < 4; ++k) if (lane == k) { e = idx[k]; gt = ex[k]; }
                const int p = (int)atomicAdd(F.ctl + CW_CNT + e, 1u);
                TOKOF[e * NTOK + p] = row; TEID[row * 4 + lane] = e; TPOS[row * 4 + lane] = p; TGATE[row * 4 + lane] = gt / sm; }
        }
    }
    __syncthreads();
}

__device__ __forceinline__ void moe_tables(Frame& F) {
    refresh(F);
    __syncthreads();
    if (F.tid == 0) { unsigned s = 0, h = 0, nl = 0;
        for (int e = 0; e < 32; ++e) { const unsigned c = __hip_atomic_load(F.ctl + CW_CNT + e, __ATOMIC_RELAXED, __HIP_MEMORY_SCOPE_AGENT); F.MISC[48 + e] = c; F.MISC[8 + e] = s; s += (c + 255u) >> 8;
            const unsigned rem = c & 255u; F.MISC[112 + e] = h; h += (c >> 8) + (rem > 128u ? 1u : 0u); if (rem >= 1u && rem <= 128u) { F.MISC[152 + nl] = (unsigned)e; ++nl; } }
        F.MISC[8 + 32] = s; F.MISC[112 + 32] = h; F.MISC[190] = nl; }
    __syncthreads();
}
__device__ __forceinline__ void p7_gu(Frame& F) {
    moe_tables(F);
    MoeSched<true> S; S.tpre = F.MISC + 8; S.cnt = F.MISC + 48; S.hpre = F.MISC + 112; S.lexp = F.MISC + 152; S.nlight = (int)F.MISC[190]; S.tbl = (const LAS unsigned*)(F.lds + TBL_OFF); S.A = (const char*)wsp<bf16_t>(F, WS_XN2); S.Bt = (const char*)wsp<bf16_t>(F, WS_WGU); S.NN = 16; S.ldb2 = 2048 * MOE_EB; S.K = 2048;
    S.G = F.G; S.vcu = F.vcu; S.b_estride = (size_t)4096 * 2048 * MOE_EB;
    { const int* TOKOF = wsp<int>(F, WS_TOKOF); Unit u; LAS unsigned* tbl = (LAS unsigned*)(F.lds + TBL_OFF);
      for (int i = 0; i < 10 && S.next(i, u); ++i) { if (F.tid < 256) { const int e = u.aux, p = (u.pm - (int)F.MISC[8 + e]) * 256 + F.tid, cnt = (int)F.MISC[48 + e]; const int tok = TOKOF[e * NTOK + (p < cnt ? p : 0)]; tbl[i * 256 + F.tid] = (unsigned)tok * (2048u * MOE_EB); } }
      __syncthreads(); }
    EpiGU E{F.b_gu, wsp<unsigned char>(F, WS_ACT)};
    gemm_phase<EpiGU, MoeSched<true>, true, MOE_FP8>(F.lds + RING_OFF, S, E, F.wave);
}
__device__ __forceinline__ void p8_down(Frame& F) {
    moe_tables(F);
    MoeSched<false> S; S.tpre = F.MISC + 8; S.cnt = F.MISC + 48; S.hpre = F.MISC + 112; S.lexp = F.MISC + 152; S.nlight = (int)F.MISC[190]; S.tbl = nullptr; S.A = (const char*)wsp<bf16_t>(F, WS_ACT); S.Bt = (const char*)wsp<bf16_t>(F, WS_WD); S.NN = 8; S.ldb2 = 2048 * MOE_EB; S.K = 2048;
    S.G = F.G; S.vcu = F.vcu; S.b_estride = (size_t)2048 * 2048 * MOE_EB;
    EpiDown E{F.b_dn, wsp<bf16_t>(F, WS_YS)};
    gemm_phase<EpiDown, MoeSched<false>, true, MOE_FP8>(F.lds + RING_OFF, S, E, F.wave);
}
__device__ __forceinline__ void p9_final(Frame& F) {
    refresh(F);
    moe_tables(F);
    const int gw = F.vcu * NWAVES + F.wave, NGW = F.G * NWAVES, lane = F.lane;
    const float* mod = wsp<float>(F, WS_MOD); const float* H1 = wsp<float>(F, WS_H1); const bf16_t* YS = wsp<bf16_t>(F, WS_YS);
    const int* TEID = wsp<int>(F, WS_TEID); const int* TPOS = wsp<int>(F, WS_TPOS); const float* TGATE = wsp<float>(F, WS_TGATE);
    for (int row = gw; row < NTOK; row += NGW) {
        const int b = row >> 11; const float* gt = mod + b * MODW + 10240;
        const bf16_t* yr[4]; float gw4[4];
#pragma unroll
        for (int k = 0; k < 4; ++k) { const int e = TEID[row * 4 + k]; yr[k] = YS + ((size_t)F.MISC[8 + e] * 256 + TPOS[row * 4 + k]) * 2048; gw4[k] = TGATE[row * 4 + k]; }
        f32x4 v[8]; float ss = 0.f;
#pragma unroll
        for (int j = 0; j < 8; ++j) { const int col = 256 * j + 4 * lane; f32x4 y = {0.f, 0.f, 0.f, 0.f};
#pragma unroll
            for (int k = 0; k < 4; ++k) { const u32x2 w = *(const u32x2*)(yr[k] + col); y += (f32x4){bflo(w.x), bfhi(w.x), bflo(w.y), bfhi(w.y)} * gw4[k]; }
            v[j] = *(const f32x4*)(H1 + (size_t)row * DM + col) + *(const f32x4*)(gt + col) * y;
            ss += v[j][0] * v[j][0] + v[j][1] * v[j][1] + v[j][2] * v[j][2] + v[j][3] * v[j][3]; }
        ss = wave_sum(ss); const float rstd = 1.0f / sqrtf(ss * (1.0f / DM) + 1e-5f);
#pragma unroll
        for (int j = 0; j < 8; ++j) { const int col = 256 * j + 4 * lane; *(f32x4*)(F.out + (size_t)row * DM + col) = v[j] * rstd * *(const f32x4*)(F.g_fin + col); }
    }
}

constexpr int PER_PHASE = 10;
struct Args { const void* in[20]; float* out; unsigned char* ws; int ph_lo, ph_hi; };
__global__ void __launch_bounds__(NWAVES * 64, 2) mega_fwd(Args args) {
    extern __shared__ __attribute__((aligned(16))) unsigned char lds_raw[];
    Frame F;
    F.lds = (LAS unsigned char*)lds_raw; F.MISC = (volatile LAS unsigned*)(F.lds + MISC_OFF);
    F.tid = threadIdx.x; F.lane = F.tid & 63; F.wave = __builtin_amdgcn_readfirstlane(F.tid >> 6);
    F.G = gridDim.x; { const int bx = blockIdx.x; F.vcu = (F.G % 8 == 0) ? (bx % 8) * (F.G / 8) + bx / 8 : bx; }
    F.ws = args.ws; F.ctl = (unsigned*)(args.ws + WS_CTL); F.out = args.out;
    F.x = (const float*)args.in[0]; F.c = (const float*)args.in[1]; F.pos = (const int*)args.in[2]; F.w_ada = (const float*)args.in[3]; F.b_ada = (const float*)args.in[4]; F.g_mix = (const float*)args.in[5];
    F.w_in = (const float*)args.in[6]; F.b_in = (const float*)args.in[7]; F.sinks = (const float*)args.in[8]; F.w_a = (const float*)args.in[9]; F.w_b = (const float*)args.in[10]; F.w_out = (const float*)args.in[11];
    F.g_ffn = (const float*)args.in[12]; F.w_r = (const float*)args.in[13]; F.b_r = (const float*)args.in[14]; F.w_gu = (const float*)args.in[15]; F.b_gu = (const float*)args.in[16]; F.w_dn = (const float*)args.in[17];
    F.b_dn = (const float*)args.in[18]; F.g_fin = (const float*)args.in[19];
    for (int u = F.tid; u < 256; u += NWAVES * 64) F.MISC[u] = 0u;
    __syncthreads();
    refresh(F);
    const int lo = args.ph_lo, hi = args.ph_hi;
    const bool one_launch = true; (void)lo; (void)hi;
    XcdBarrier bar; bar.bar = (unsigned*)(F.ctl + CW_BAR); bar.x = 0; bar.st = nullptr; bar.total = 0;
    XcdBarrier bar2 = bar;
    const bool is_comp = (int)blockIdx.x < NCOMP || F.G <= NCOMP;
    const int ncomp = F.G <= NCOMP ? F.G : NCOMP;
    if (one_launch) { bar = xcd_barrier_post((unsigned*)(F.ctl + CW_BAR), F.MISC + 0, (unsigned)F.G);
        if (is_comp) bar2 = xcd_barrier_post((unsigned*)(F.ctl + CW_BAR2), F.MISC + 2, (unsigned)ncomp); }
#ifndef REPEAT_MASK
#define REPEAT_MASK 0
#endif
#define IN(k) true
#define REP(k, body) do { if ((REPEAT_MASK >> (k)) & 1) { body; xcd_barrier(bar); } } while (0)
#define REP2(k, body) do { if ((REPEAT_MASK >> (k)) & 1) { body; xcd_barrier(bar2); } } while (0)
#define SEAM(k) do { if (IN(k) && IN((k) + 1)) xcd_barrier(bar); } while (0)
    if (one_launch) {
        if (is_comp) {
            const int G0 = F.G, v0 = F.vcu; F.G = ncomp; { const int bx = blockIdx.x; F.vcu = (ncomp % 8 == 0) ? (bx % 8) * (ncomp / 8) + bx / 8 : bx; }
            const bool split0 = ncomp < G0;
            p0_prologue(F, 0, split0 ? P0_T_HEAD : P0_T_ALL, F.vcu * NWAVES + F.wave, F.G * NWAVES); xcd_barrier(bar2);
            REP2(1, p1_norm_fb(F)); p1_norm_fb(F); xcd_barrier(bar2);
            if (split0) {
                if (F.tid == 0) { unsigned* flag = F.ctl + CW_SFLAG; unsigned* tmo = (unsigned*)(F.ctl + CW_BAR) + XB_TMO; const unsigned want = (unsigned)(G0 - ncomp);
                    XB_SPIN(xb_ld(flag) < want, (unsigned*)(F.ctl + CW_BAR)); (void)tmo;
                    __builtin_amdgcn_fence(__ATOMIC_ACQUIRE, "agent"); asm volatile("s_waitcnt vmcnt(0)" ::: "memory"); }
                __syncthreads(); }
            { p2_cumsum(F);
              DenseSched S; S.init(wsp<bf16_t>(F, WS_XN), 2048 * MIX_EB, wsp<bf16_t>(F, WS_WIN), 2048 * MIX_EB, 2048, NTOK, 8704, ncomp, (int)blockIdx.x);
              EpiInProj E{wsp<bf16_t>(F, WS_QA), wsp<bf16_t>(F, WS_KA), wsp<bf16_t>(F, WS_VA), wsp<bf16_t>(F, WS_QB), wsp<bf16_t>(F, WS_KB), wsp<bf16_t>(F, WS_VB), wsp<bf16_t>(F, WS_SGA), wsp<bf16_t>(F, WS_SGB),
                          wsp<float>(F, WS_BINP), wsp<float>(F, WS_COS), wsp<float>(F, WS_SIN)};
              REP2(2, (gemm_phase<EpiInProj, DenseSched, true, MIX_FP8>(F.lds + RING_OFF, S, E, F.wave)));
              gemm_phase<EpiInProj, DenseSched, true, MIX_FP8>(F.lds + RING_OFF, S, E, F.wave); }
            xcd_barrier(bar2);
            p3_attention(F);
            F.G = G0; F.vcu = v0;
        }
#ifndef CONV_COOP
#define CONV_COOP 1
#endif
        if (!is_comp) {
            p0_prologue(F, P0_T_HEAD, P0_T_ALL, ((int)blockIdx.x - ncomp) * NWAVES + F.wave, (F.G - ncomp) * NWAVES);
            asm volatile("s_waitcnt vmcnt(0)" ::: "memory"); __syncthreads();
            if (F.tid == 0) { __builtin_amdgcn_fence(__ATOMIC_RELEASE, "agent"); asm volatile("s_waitcnt vmcnt(0)" ::: "memory"); (void)xb_add(F.ctl + CW_SFLAG, 1u); }
            convert_coop(F, F.ctl + CW_CQ1, 0);
        }
        xcd_barrier(bar);
        {
            BranchSched S; S.d.init(wsp<bf16_t>(F, WS_YAB), 2048 * MIX_EB, wsp<bf16_t>(F, WS_WAB), 1024 * MIX_EB, 1024, NTOK, 2048, F.G, (int)blockIdx.x); S.ldb2 = 1024 * MIX_EB; S.K = 1024;
            EpiBranch E{wsp<bf16_t>(F, WS_SGA), wsp<bf16_t>(F, WS_SGB), wsp<float>(F, WS_T1), wsp<unsigned char>(F, WS_MERGED)};
            gemm_phase<EpiBranch, BranchSched, true, MIX_FP8>(F.lds + RING_OFF, S, E, F.wave); }
        xcd_barrier(bar);
        {
            DenseSched S; S.init(wsp<bf16_t>(F, WS_MERGED), 2048 * P5_EB, wsp<bf16_t>(F, WS_WOUT), 2048 * P5_EB, 2048, NTOK, 2048, F.G, (int)blockIdx.x);
            EpiOut E{F.x, wsp<float>(F, WS_MOD), wsp<float>(F, WS_H1)};
            gemm_phase<EpiOut, DenseSched, true, P5_FP8>(F.lds + RING_OFF, S, E, F.wave); }
        convert_coop(F, F.ctl + CW_CQ2, (int)__hip_atomic_load(F.ctl + CW_START2, __ATOMIC_RELAXED, __HIP_MEMORY_SCOPE_AGENT));
        xcd_barrier(bar);
    }
#ifndef P6_MFMA
#define P6_MFMA 1
#endif
    if (IN(6)) { if (P6_MFMA) p6_router_mfma(F); else p6_norm_router(F); } SEAM(6);
    if (IN(7)) { REP(7, p7_gu(F)); p7_gu(F); } SEAM(7);
    if (IN(8)) { REP(8, p8_down(F)); p8_down(F); } SEAM(8);
    if (IN(9)) { REP(9, p9_final(F)); p9_final(F); }
#undef IN
#undef SEAM
}

static void run_opt(void* const* d_in, float* out, unsigned char* ws, hipStream_t stream, int n_launches) {
    static int grid = 0;
    if (grid == 0) {
        int dev = 0, cus = 0;
        if (hipGetDevice(&dev) != hipSuccess || hipDeviceGetAttribute(&cus, hipDeviceAttributeMultiprocessorCount, dev) != hipSuccess) { grid = -1; return; }
        if (hipFuncSetAttribute((const void*)mega_fwd, hipFuncAttributeMaxDynamicSharedMemorySize, LDS_BYTES) != hipSuccess) { grid = -1; return; }
        int per_cu = 0; (void)hipOccupancyMaxActiveBlocksPerMultiprocessor(&per_cu, (const void*)mega_fwd, NWAVES * 64, LDS_BYTES); (void)hipGetLastError();
        grid = cus;
    }
    if (grid < 0) return;
    (void)hipMemsetAsync(ws + WS_CTL, 0, CTL_ZERO_BYTES, stream);
    Args a{};
    for (int i = 0; i < 20; ++i) a.in[i] = d_in[i];
    a.out = out; a.ws = ws;
    (void)n_launches; a.ph_lo = 0; a.ph_hi = PER_PHASE; hipLaunchKernelGGL(mega_fwd, dim3(grid), dim3(NWAVES * 64), LDS_BYTES, stream, a);
}
}

extern "C" void kernel_launch(void* const* d_in, const int* in_sizes, int n_in, void* d_out, int out_size, void* d_ws, size_t ws_size, hipStream_t stream) {
    mk::run_opt(d_in, (float*)d_out, (unsigned char*)d_ws, stream, 1);
}
```

```cpp
#include <hip/hip_runtime.h>
#include <stdint.h>
#include <math.h>
namespace mk {
#define LAS __attribute__((address_space(3)))
#define GAS __attribute__((address_space(1)))
typedef unsigned short bf16_t;
typedef short bf16x8 __attribute__((ext_vector_type(8)));
typedef float f32x4 __attribute__((ext_vector_type(4)));
typedef float f32x2 __attribute__((ext_vector_type(2)));
typedef float f32x16 __attribute__((ext_vector_type(16)));
typedef unsigned u32x4 __attribute__((ext_vector_type(4)));
typedef unsigned u32x2 __attribute__((ext_vector_type(2)));
typedef __bf16 bf16x2_t __attribute__((ext_vector_type(2)));
typedef int i32x4 __attribute__((ext_vector_type(4)));
typedef short s16x4 __attribute__((ext_vector_type(4)));
typedef int i32x8 __attribute__((ext_vector_type(8)));

constexpr int NTOK = 8192, DM = 2048, SEQ = 2048, INW = 8720, NEXP = 32, MODW = 12288;
constexpr float LOG2E = 1.4426950408889634f;
constexpr float QSCALE = 0.125f * LOG2E;

__device__ __forceinline__ unsigned pk2(float lo, float hi) { f32x2 v = {lo, hi}; bf16x2_t b = __builtin_convertvector(v, bf16x2_t); return __builtin_bit_cast(unsigned, b); }
__device__ __forceinline__ float bflo(unsigned u) { return __builtin_bit_cast(float, u << 16); }
__device__ __forceinline__ float bfhi(unsigned u) { return __builtin_bit_cast(float, u & 0xffff0000u); }
__device__ __forceinline__ unsigned pk4_fp8_raw(float a, float b, float c, float d) { int w = 0; w = __builtin_amdgcn_cvt_pk_fp8_f32(a, b, w, false); w = __builtin_amdgcn_cvt_pk_fp8_f32(c, d, w, true); return (unsigned)w; }
__device__ __forceinline__ float sat448(float x) { return __builtin_amdgcn_fmed3f(x, -448.0f, 448.0f); }
__device__ __forceinline__ unsigned pk4_fp8(float a, float b, float c, float d) { return pk4_fp8_raw(a, b, c, d); }
__device__ __forceinline__ i32x8 cat8(bf16x8 lo, bf16x8 hi) { return __builtin_shufflevector(__builtin_bit_cast(i32x4, lo), __builtin_bit_cast(i32x4, hi), 0, 1, 2, 3, 4, 5, 6, 7); }
__device__ __forceinline__ int lane_id() { int l = (int)__builtin_amdgcn_mbcnt_hi(~0u, __builtin_amdgcn_mbcnt_lo(~0u, 0u)); asm volatile("" : "+v"(l)); return l; }
template <int CTRL> __device__ __forceinline__ float dpp_mov(float x) { return __builtin_bit_cast(float, __builtin_amdgcn_update_dpp(0, __builtin_bit_cast(int, x), CTRL, 0xF, 0xF, true)); }
__device__ __forceinline__ float lx1(float x) { return dpp_mov<0xB1>(x); }
__device__ __forceinline__ float lx2(float x) { return dpp_mov<0x4E>(x); }
__device__ __forceinline__ float lx4(float x) { return dpp_mov<0x1B>(dpp_mov<0x141>(x)); }
__device__ __forceinline__ float lx8(float x) { return dpp_mov<0x128>(x); }
__device__ __forceinline__ float lx16(float x, int lane) { const unsigned u = __builtin_bit_cast(unsigned, x); auto rr = __builtin_amdgcn_permlane16_swap(u, u, false, false); return __builtin_bit_cast(float, (lane & 16) ? rr[0] : rr[1]); }
__device__ __forceinline__ float lx32(float x, int lane) { const unsigned u = __builtin_bit_cast(unsigned, x); auto rr = __builtin_amdgcn_permlane32_swap(u, u, false, false); return __builtin_bit_cast(float, (lane & 32) ? rr[0] : rr[1]); }
__device__ __forceinline__ float wave_sum_v(float v) {
    v += lx1(v); v += lx2(v); v += lx4(v); v += lx8(v);
    { const unsigned u = __builtin_bit_cast(unsigned, v); auto rr = __builtin_amdgcn_permlane16_swap(u, u, false, false); v = __builtin_bit_cast(float, rr[0]) + __builtin_bit_cast(float, rr[1]); }
    { const unsigned u = __builtin_bit_cast(unsigned, v); auto rr = __builtin_amdgcn_permlane32_swap(u, u, false, false); v = __builtin_bit_cast(float, rr[0]) + __builtin_bit_cast(float, rr[1]); }
    return v;
}
__device__ __forceinline__ float fast_sigmoid(float x) { return __builtin_amdgcn_rcpf(1.0f + __builtin_amdgcn_exp2f(-x * LOG2E)); }

constexpr int BM = 256, BK = 64, HALF = 128, HTB = HALF * BK * 2, STAGE_BYTES = 8 * HTB, NXCD = 8, WGM = 8;
__host__ __device__ __forceinline__ int lds_byte(int r, int c) { const int st = (r >> 4) * 2 + (c >> 5), rr = r & 15, cc = c & 31, ob = rr * 64 + cc * 2; return st * 1024 + (ob ^ (((ob >> 9) & 1) << 5)); }
__host__ __device__ __forceinline__ void stage_rc(int b, int& R, int& C) { const int st = b / 1024, sb = b % 1024, swz = sb ^ (((sb >> 9) & 1) << 5); R = (st >> 1) * 16 + swz / 64; C = (st & 1) * 32 + (swz % 64) / 2; }
__host__ __device__ __forceinline__ int perm32(int rho) { const int n = rho >> 4, i = rho & 15; return 8 * (i >> 2) + 4 * n + (i & 3); }

struct Unit { int pm, pn, aux; };

template <class Epi, class Sched, bool ALIGN_EPI, bool FP8 = false>
__device__ __forceinline__ void gemm_phase(LAS unsigned char* lds, const Sched& S, const Epi& E, int wid  ) {
    const int lane = lane_id(), tid = wid * 64 + lane, wr = wid >> 2, wc = wid & 3, fr = lane & 15, fq = lane >> 4;
    const int K = S.K, nt = FP8 ? K / (2 * BK) : K / BK;
    int sR[2], sC[2]; unsigned voffB[2];
#pragma unroll
    for (int i = 0; i < 2; ++i) { stage_rc(tid * 16 + i * 8192, sR[i], sC[i]); const int Rb = Epi::PERM ? ((sR[i] & ~31) + perm32(sR[i] & 31)) : sR[i]; voffB[i] = (unsigned)Rb * S.ldb2 + (unsigned)sC[i] * 2u; }
    const size_t kstep = (size_t)(BK * 2);
    const size_t hstepB = (size_t)HALF * S.ldb2;
    const unsigned ldsw = (unsigned)wid * 1024u;
    const int aoff = lds_byte(wr * 64 + fr, fq * 8), boff = lds_byte(wc * 32 + fr, fq * 8);
#define PG8_SA(b, h) (((b) * 2 + (h)) * HTB)
#define PG8_SB(b, h) ((4 + (b) * 2 + (h)) * HTB)
#define PG8_STAGE(bufoff, gbase, voff) do { _Pragma("unroll") for (int _i = 0; _i < 2; ++_i) \
        __builtin_amdgcn_global_load_lds((const unsigned*)((const char*)(gbase) + (voff)[_i]), (LAS unsigned*)(lds + (bufoff) + ldsw + _i * 8192), 16, 0, 0); } while (0)
#define PG8_LDA(dst, b, h) do { _Pragma("unroll") for (int m = 0; m < 4; ++m) { if constexpr (FP8) dst##8[m] = cat8(*(const LAS bf16x8*)(lds + PG8_SA(b, h) + aoff + m * 2048), *(const LAS bf16x8*)(lds + PG8_SA(b, h) + aoff + m * 2048 + 1024)); \
        else { _Pragma("unroll") for (int k = 0; k < 2; ++k) dst[m][k] = *(const LAS bf16x8*)(lds + PG8_SA(b, h) + aoff + m * 2048 + k * 1024); } } } while (0)
#define PG8_LDB(dst, b, h) do { _Pragma("unroll") for (int n = 0; n < 2; ++n) { if constexpr (FP8) dst##8[n] = cat8(*(const LAS bf16x8*)(lds + PG8_SB(b, h) + boff + n * 2048), *(const LAS bf16x8*)(lds + PG8_SB(b, h) + boff + n * 2048 + 1024)); \
        else { _Pragma("unroll") for (int k = 0; k < 2; ++k) dst[n][k] = *(const LAS bf16x8*)(lds + PG8_SB(b, h) + boff + n * 2048 + k * 1024); } } } while (0)
#define PG8_MMA(ai, bj, At, Bt) do { __builtin_amdgcn_s_setprio(1); _Pragma("unroll") for (int m = 0; m < 4; ++m) _Pragma("unroll") for (int n = 0; n < 2; ++n) { \
        if constexpr (FP8) asm volatile("v_mfma_scale_f32_16x16x128_f8f6f4 %0, %1, %2, %0, %3, %3 op_sel_hi:[0,0,0]" : "+v"(acc[ai][bj][m][n]) : "v"(Bt##8[n]), "v"(At##8[m]), "v"(fp8_unit_scale)); \
        else { _Pragma("unroll") for (int k = 0; k < 2; ++k) acc[ai][bj][m][n] = __builtin_amdgcn_mfma_f32_16x16x32_bf16(Bt[n][k], At[m][k], acc[ai][bj][m][n], 0, 0, 0); } } __builtin_amdgcn_s_setprio(0); } while (0)
#define PG8_WAIT_V(n) asm volatile("s_waitcnt vmcnt(" #n ")" ::: "memory")
#define PG8_WAIT_L(n) asm volatile("s_waitcnt lgkmcnt(" #n ")" ::: "memory")
#define PG8_BAR __builtin_amdgcn_s_barrier()
#define PG8_SCHED __builtin_amdgcn_sched_barrier(0)
#define PG8_AOFFS(dst, u, ui) do { _Pragma("unroll") for (int _h = 0; _h < 2; ++_h) _Pragma("unroll") for (int _i = 0; _i < 2; ++_i) dst[_h][_i] = S.a_rowoff(u, ui, sR[_i] + _h * HALF) + (unsigned)sC[_i] * 2u; } while (0)
    Unit cur, nxt; int ui = 0;
    if (!S.next(0, cur)) return;
    int vrows = 256; if constexpr (Sched::RAGGED) vrows = S.rows(cur);
#define PG8_DO0 (!Sched::RAGGED || vrows > 64 || wr == 0)
#define PG8_DO1 (!Sched::RAGGED || vrows > 128)
    f32x4 acc[2][2][4][2];
#pragma unroll
    for (int a = 0; a < 2; ++a)
#pragma unroll
        for (int b = 0; b < 2; ++b)
#pragma unroll
            for (int m = 0; m < 4; ++m)
#pragma unroll
                for (int n = 0; n < 2; ++n) acc[a][b][m][n] = (f32x4){0.f, 0.f, 0.f, 0.f};
    bf16x8 At[4][2], B0[2][2], B1[2][2]; i32x8 At8[4], B08[2], B18[2];
    constexpr bool GA = Sched::GATHER;
    const unsigned fp8_unit_scale = 0x7f7f7f7fu;
    unsigned vAc[2][2], vAn[2][2];
    PG8_AOFFS(vAc, cur, 0);
    const size_t hstepA = GA ? 0 : (size_t)(vAc[1][0] - vAc[0][0]);
#define PG8_H1(v) (GA ? (v)[1] : (v)[0])
    const char* cA = S.a_base(cur); const char* cB = S.b_base(cur);
    PG8_STAGE(PG8_SB(0, 0), cB, voffB); PG8_STAGE(PG8_SB(0, 1), cB + hstepB, voffB); PG8_STAGE(PG8_SA(0, 0), cA, vAc[0]); PG8_STAGE(PG8_SA(0, 1), cA + hstepA, PG8_H1(vAc));
    if (wr == 1) PG8_BAR;
    PG8_WAIT_V(2); PG8_BAR;
    PG8_STAGE(PG8_SB(1, 0), cB + kstep, voffB); PG8_STAGE(PG8_SA(1, 0), cA + kstep, vAc[0]); PG8_STAGE(PG8_SB(1, 1), cB + hstepB + kstep, voffB);
    PG8_WAIT_V(6); PG8_BAR;
    for (;;) {
        const bool has_next = S.next(ui + 1, nxt);
        const char* nA = cA; const char* nB = cB;
        if (has_next) { nA = S.a_base(nxt); nB = S.b_base(nxt); if constexpr (GA) PG8_AOFFS(vAn, nxt, ui + 1); }
        else if constexpr (GA) {
#pragma unroll
            for (int _h = 0; _h < 2; ++_h)
#pragma unroll
                for (int _i = 0; _i < 2; ++_i) vAn[_h][_i] = vAc[_h][_i]; }
        for (int t = 0; t < nt; t += 2) {
            const bool last = (t == nt - 2);
            const char* a1 = cA + (size_t)(t + 1) * kstep;
            const char* a2 = last ? nA : cA + (size_t)(t + 2) * kstep; const char* b2 = last ? nB : cB + (size_t)(t + 2) * kstep;
            const char* a3 = a2 + kstep; const char* b3 = b2 + kstep;
            unsigned vS[2][2];
#pragma unroll
            for (int _h = 0; _h < 2; ++_h)
#pragma unroll
                for (int _i = 0; _i < 2; ++_i) vS[_h][_i] = (GA && last) ? vAn[_h][_i] : vAc[_h][_i];
            PG8_LDB(B0, 0, 0); PG8_LDB(B1, 0, 1); PG8_SCHED; PG8_LDA(At, 0, 0); PG8_STAGE(PG8_SA(1, 1), a1 + hstepA, PG8_H1(vAc));
            PG8_WAIT_V(8); PG8_WAIT_L(0); PG8_BAR; if (PG8_DO0) { PG8_MMA(0, 0, At, B0); PG8_MMA(0, 1, At, B1); } PG8_BAR; PG8_SCHED;
            PG8_LDA(At, 0, 1); PG8_STAGE(PG8_SB(0, 0), b2, voffB); PG8_STAGE(PG8_SB(0, 1), b2 + hstepB, voffB); PG8_STAGE(PG8_SA(0, 0), a2, vS[0]);
            PG8_WAIT_V(8); PG8_WAIT_L(0); PG8_BAR; if (PG8_DO1) { PG8_MMA(1, 0, At, B0); PG8_MMA(1, 1, At, B1); } PG8_BAR; PG8_SCHED;
            PG8_LDB(B0, 1, 0); PG8_LDB(B1, 1, 1); PG8_SCHED; PG8_LDA(At, 1, 0); PG8_STAGE(PG8_SA(0, 1), a2 + hstepA, PG8_H1(vS));
            PG8_WAIT_V(8); PG8_WAIT_L(0); PG8_BAR; if (PG8_DO0) { PG8_MMA(0, 0, At, B0); PG8_MMA(0, 1, At, B1); } PG8_BAR; PG8_SCHED;
            PG8_LDA(At, 1, 1); PG8_STAGE(PG8_SB(1, 0), b3, voffB); PG8_STAGE(PG8_SB(1, 1), b3 + hstepB, voffB); PG8_STAGE(PG8_SA(1, 0), a3, vS[0]);
            PG8_WAIT_V(8); PG8_WAIT_L(0); PG8_BAR; if (PG8_DO1) { PG8_MMA(1, 0, At, B0); PG8_MMA(1, 1, At, B1); } PG8_BAR; PG8_SCHED;
        }
        if constexpr (ALIGN_EPI) { if (wr == 0) PG8_BAR; }
        if constexpr (FP8) asm volatile("s_nop 15\n\ts_nop 15\n\ts_nop 15\n\ts_nop 15" ::: "memory");
        E(acc, cur, wr, wc, fr, fq);
        if (!has_next) break;
#pragma unroll
        for (int a = 0; a < 2; ++a)
#pragma unroll
            for (int b = 0; b < 2; ++b)
#pragma unroll
                for (int m = 0; m < 4; ++m)
#pragma unroll
                    for (int n = 0; n < 2; ++n) acc[a][b][m][n] = (f32x4){0.f, 0.f, 0.f, 0.f};
        cur = nxt; cA = nA; cB = nB; ++ui;
        if constexpr (Sched::RAGGED) vrows = S.rows(cur);
        if constexpr (GA) {
#pragma unroll
        for (int _h = 0; _h < 2; ++_h)
#pragma unroll
            for (int _i = 0; _i < 2; ++_i) vAc[_h][_i] = vAn[_h][_i]; }
        if constexpr (ALIGN_EPI) { if (wr == 1) PG8_BAR; }
    }
    PG8_WAIT_V(0);
    if constexpr (!ALIGN_EPI) { if (wr == 0) PG8_BAR; }
    PG8_BAR;
#undef PG8_SA
#undef PG8_SB
#undef PG8_STAGE
#undef PG8_LDA
#undef PG8_LDB
#undef PG8_MMA
#undef PG8_WAIT_V
#undef PG8_WAIT_L
#undef PG8_BAR
#undef PG8_SCHED
#undef PG8_AOFFS
#undef PG8_DO0
#undef PG8_DO1
#undef PG8_H1
}

#define XB_TMO      128
#define XB_XCNT(j)  (256  + 64 * (j))
#define XB_XSUB(j)  (1280 + 64 * (j))
#define XB_XGEN(j)  (2304 + 64 * (j))
#define XB_TOP      3328
#define XB_TOPGEN   3392
#define XCD_BAR_WORDS 3456
#define XB_SPIN_CAP (1u << 18)
__device__ __forceinline__ unsigned xb_ld(unsigned* p)              { return __hip_atomic_load(p, __ATOMIC_RELAXED, __HIP_MEMORY_SCOPE_AGENT); }
__device__ __forceinline__ unsigned xb_add(unsigned* p, unsigned v) { return __hip_atomic_fetch_add(p, v, __ATOMIC_RELAXED, __HIP_MEMORY_SCOPE_AGENT); }
__device__ __forceinline__ unsigned xb_xcc_id() { return (unsigned)__builtin_amdgcn_s_getreg((3 << 11) | 20) & 0xFu; }
#define XB_SPIN(cond, bar) do { unsigned _sp = 0; while (cond) { __builtin_amdgcn_s_sleep(1); \
    if ((++_sp & 255u) == 0u) { if (xb_ld(&(bar)[XB_TMO])) break; if (_sp > XB_SPIN_CAP) { atomicAdd(&(bar)[XB_TMO], 1u); break; } } } } while (0)
struct XcdBarrier { unsigned* bar; unsigned x; volatile LAS unsigned* st; unsigned total; };
__device__ __forceinline__ XcdBarrier xcd_barrier_post(unsigned* bar, volatile LAS unsigned* st, unsigned total) {
    XcdBarrier b; b.bar = bar; b.x = xb_xcc_id(); b.st = st; b.total = total;
    if (threadIdx.x == 0) (void)xb_add(&bar[XB_XCNT(b.x)], 1u);
    return b;
}
__device__ __forceinline__ void xcd_barrier_complete(unsigned* bar, unsigned x, unsigned G, unsigned& nloc, unsigned& nx) {
    unsigned sum, cnt, mine, sp = 0u;
    for (;;) {
        sum = 0u; cnt = 0u; mine = 0u;
#pragma unroll
        for (unsigned j = 0; j < 16; ++j) { const unsigned c = xb_ld(&bar[XB_XCNT(j)]); sum += c; cnt += (c > 0u) ? 1u : 0u; mine = (j == x) ? c : mine; }
        if (sum == G) break;
        __builtin_amdgcn_s_sleep(1);
        if ((++sp & 255u) == 0u) { if (xb_ld(&bar[XB_TMO])) break; if (sp > XB_SPIN_CAP) { atomicAdd(&bar[XB_TMO], 1u); break; } }
    }
    nloc = mine > 0u ? mine : 1u; nx = cnt > 0u ? cnt : 1u;
}
__device__ __forceinline__ void xcd_barrier(const XcdBarrier& b) {
    asm volatile("s_waitcnt vmcnt(0)" ::: "memory");
    __syncthreads();
    if (threadIdx.x == 0) {
        unsigned* bar = b.bar;
        __builtin_amdgcn_s_waitcnt(0);
        unsigned nloc = b.st[0], nx = b.st[1];
        if (nloc == 0u) { xcd_barrier_complete(bar, b.x, b.total, nloc, nx); b.st[0] = nloc; b.st[1] = nx; }
        const unsigned old = xb_add(&bar[XB_XSUB(b.x)], 1u);
        const unsigned gen = old / nloc;
        if (old + 1u == (gen + 1u) * nloc) {
            __builtin_amdgcn_fence(__ATOMIC_RELEASE, "agent");
            asm volatile("s_waitcnt vmcnt(0)" ::: "memory");
            const unsigned og = xb_add(&bar[XB_TOP], 1u);
            const unsigned tg = og / nx;
            if (og + 1u == (tg + 1u) * nx) xb_add(&bar[XB_TOPGEN], 1u);
            else XB_SPIN(xb_ld(&bar[XB_TOPGEN]) == tg, bar);
            __builtin_amdgcn_fence(__ATOMIC_ACQUIRE, "agent");
            xb_add(&bar[XB_XGEN(b.x)], 1u);
            asm volatile("s_waitcnt vmcnt(0)" ::: "memory");
        } else {
            XB_SPIN(xb_ld(&bar[XB_XGEN(b.x)]) == gen, bar);
            __builtin_amdgcn_fence(__ATOMIC_ACQUIRE, "agent");
            asm volatile("s_waitcnt vmcnt(0)" ::: "memory");
        }
    }
    __syncthreads();
}
}
namespace mk {
constexpr size_t MiB = 1ull << 20;
constexpr size_t WS_CTL = 0, CTL_ZERO_BYTES = 1 * MiB + 4 * 12288 * 4;
constexpr size_t WS_MOD = 1 * MiB, WS_COS = 2 * MiB, WS_SIN = 3 * MiB, WS_LOGF = 4 * MiB, WS_CUM = 5 * MiB, WS_TEID = 6 * MiB, WS_TPOS = 6 * MiB + 512 * 1024, WS_TGATE = 7 * MiB, WS_BINP = 7 * MiB + 512 * 1024,
                 WS_TOKOF = 8 * MiB  , WS_XN = 16 * MiB  , WS_WIN = 48 * MiB  , WS_WAB = 84 * MiB  , WS_WOUT = 92 * MiB  , WS_QA = 100 * MiB  , WS_KA = 116 * MiB  ,
                 WS_VA = 120 * MiB  , WS_QB = 124 * MiB  , WS_KB = 140 * MiB, WS_VB = 156 * MiB, WS_SGA = 172 * MiB  , WS_SGB = 204 * MiB  , WS_YAB = 236 * MiB  ,
                 WS_T1 = 268 * MiB  , WS_MERGED = 332 * MiB  , WS_H1 = 364 * MiB  , WS_XN2 = 428 * MiB  , WS_ACT = 460 * MiB  , WS_YS = 620 * MiB  ,
                 WS_WGU = 780 * MiB  , WS_WD = 1292 * MiB  , WS_JUNK = 1548 * MiB  , WS_END = 1580 * MiB;
constexpr int CW_CNT = 1024, CNT_STRIDE = 32;
constexpr int CW_BAR = 4096;
constexpr int CW_BAR2 = 8192;
constexpr int CW_CQ = 2048;
constexpr int CW_AQ = 2112;
constexpr int CW_SFLAG = 2560;
#ifndef CONV_MODE
#define CONV_MODE 0
#endif
#ifndef NCOMP_DEF
#define NCOMP_DEF 156
#endif
constexpr int NCOMP = NCOMP_DEF;
constexpr int RING_OFF = 0, RING_BYTES = 131072;
constexpr int TBL_OFF = RING_BYTES;
constexpr int MISC_OFF = TBL_OFF + 10240;
constexpr int LDS_BYTES = 147456;
static_assert(MISC_OFF + 1024 <= LDS_BYTES, "LDS map");
constexpr int NWAVES = 8;
constexpr bool MOE_FP8 = true;
constexpr float WSCALE = 32.0f, WSCALE_INV = 1.0f / 32.0f;
constexpr bool MIX_FP8 = true;
constexpr int MIX_EB = MIX_FP8 ? 1 : 2;
#ifndef P5_FP8_DEF
#define P5_FP8_DEF 1
#endif
constexpr bool P5_FP8 = MIX_FP8 && P5_FP8_DEF;
constexpr int P5_EB = P5_FP8 ? 1 : 2;
constexpr int MOE_EB = MOE_FP8 ? 1 : 2;

struct Frame {
    LAS unsigned char* lds; volatile LAS unsigned* MISC; unsigned* ctl;
    int tid, lane, wave, vcu, G;
    const float *x, *c, *w_ada, *b_ada, *g_mix, *w_in, *b_in, *sinks, *w_a, *w_b, *w_out, *g_ffn, *w_r, *b_r, *w_gu, *b_gu, *w_dn, *b_dn, *g_fin; const int* pos;
    float* out; unsigned char* ws;
};
__device__ __forceinline__ void refresh(Frame& F) { F.lane = lane_id(); F.tid = F.wave * 64 + F.lane; }
template <class T> __device__ __forceinline__ T* wsp(const Frame& F, size_t off) { return (T*)(F.ws + off); }

__device__ __forceinline__ float wave_sum(float v) {
#pragma unroll
    for (int o = 1; o < 64; o <<= 1) v += __shfl_xor(v, o);
    return v;
}

struct DenseSched {
    static constexpr bool GATHER = false, RAGGED = false;
    const char* A; const char* Bt; unsigned lda2, ldb2; int K; int nM, nN, nwg, G, c;
    const volatile LAS int* ulist; int nl;
    __device__ __forceinline__ void init(const void* A_, unsigned lda2_, const void* Bt_, unsigned ldb2_, int K_, int M, int N, int G_, int c_) {
        A = (const char*)A_; Bt = (const char*)Bt_; lda2 = lda2_; ldb2 = ldb2_; K = K_; nM = M / BM; nN = N / BM; nwg = nM * nN; G = G_; c = c_; ulist = nullptr; nl = 0; }
    __device__ __forceinline__ void fill_units(volatile LAS int* ul, int tid) { if ((nwg + G - 1) / G > 8) return; if (tid < 8) { Unit u; u.pm = 0; u.pn = 0; u.aux = 0; const bool ok = tile((long)tid * G + c, u); ul[2 * tid] = ok ? u.pm : -1; ul[2 * tid + 1] = u.pn; } __syncthreads(); ulist = ul; nl = 8; }
    __device__ __forceinline__ bool tile(long L, Unit& u) const {
        if (L >= nwg) return false;
        int wgid = (int)L; { const int q = nwg / NXCD, r = nwg % NXCD, xcd = wgid % NXCD, off = wgid / NXCD; wgid = (xcd < r ? xcd * (q + 1) : r * (q + 1) + (xcd - r) * q) + off; }
        const int nig = WGM * nN, gid = wgid / nig, fm = gid * WGM, gsz = (nM - fm) < WGM ? (nM - fm) : WGM;
        u.pm = fm + ((wgid % nig) % gsz); u.pn = (wgid % nig) / gsz; u.aux = 0; return true; }
    __device__ __forceinline__ bool next(int i, Unit& u) const { if (nl) { if (i >= nl) return false; const int pm = ulist[2 * i]; if (pm < 0) return false; u.pm = pm; u.pn = ulist[2 * i + 1]; u.aux = 0; return true; } return tile((long)i * G + c, u); }
    __device__ __forceinline__ const char* a_base(const Unit& u) const { return A + (size_t)u.pm * BM * lda2; }
    __device__ __forceinline__ unsigned a_rowoff(const Unit&, int, int R) const { return (unsigned)R * lda2; }
    __device__ __forceinline__ const char* b_base(const Unit& u) const { return Bt + (size_t)u.pn * BM * ldb2; }
};
struct BranchSched {
    static constexpr bool GATHER = false, RAGGED = false;
    DenseSched d; unsigned ldb2; int K;
    __device__ __forceinline__ bool next(int i, Unit& u) const { if (!d.tile((long)(i >> 1) * d.G + d.c, u)) return false; u.aux = i & 1; return true; }
    __device__ __forceinline__ const char* a_base(const Unit& u) const { return d.A + (size_t)u.pm * BM * (2048 * MIX_EB) + (size_t)u.aux * (1024 * MIX_EB); }
    __device__ __forceinline__ unsigned a_rowoff(const Unit&, int, int R) const { return (unsigned)R * (2048u * MIX_EB); }
    __device__ __forceinline__ const char* b_base(const Unit& u) const { return d.Bt + ((size_t)u.aux * 2048 + (size_t)u.pn * BM) * (1024 * MIX_EB); }
};
template <bool GATHER_>
struct MoeSched {
    static constexpr bool GATHER = GATHER_, gather = GATHER_, RAGGED = true;
    const volatile LAS unsigned* cnt;
    __device__ __forceinline__ int rows(const Unit& u) const { const int r = (int)cnt[u.aux] - (u.pm - (int)tpre[u.aux]) * 256; return r < 256 ? r : 256; }
    const volatile LAS unsigned* tpre; const LAS unsigned* tbl; const char* A; const char* Bt; int NN; unsigned ldb2; int K; int G, vcu;
    size_t b_estride;
    const volatile LAS unsigned* hpre; const volatile LAS unsigned* lexp; int nlight;
    const volatile LAS int* ulist;
    __device__ __forceinline__ bool next(int i, Unit& u) const { if (i >= 10) return false; const int pm = ulist[3 * i]; if (pm < 0) return false; u.pm = pm; u.pn = ulist[3 * i + 1]; u.aux = ulist[3 * i + 2]; return true; }
    __device__ __forceinline__ void fill_units(volatile LAS int* ul, int tid) { if (tid < 10) { Unit u; u.pm = 0; u.pn = 0; u.aux = 0; const bool ok = next_slow(tid, u); ul[3 * tid] = ok ? u.pm : -1; ul[3 * tid + 1] = u.pn; ul[3 * tid + 2] = u.aux; } __syncthreads(); ulist = ul; }
    __device__ __forceinline__ bool next_slow(int i, Unit& u) const {
        const int L = i * G + vcu; const int NH = NN * (int)hpre[32];
        if (L < NH) {
            int e = 0;
            for (int j = 1; j < 32; ++j) if (NN * (int)hpre[j] <= L) e = j;
            const int l = L - NN * (int)hpre[e], T = (int)hpre[e + 1] - (int)hpre[e];
            u.pn = l / T; u.pm = (int)tpre[e] + (l - u.pn * T); u.aux = e; return true; }
        const int l2 = L - NH, j = l2 / NN; if (j >= nlight) return false;
        const int e = (int)lexp[j]; u.pn = l2 - j * NN; u.pm = (int)tpre[e + 1] - 1; u.aux = e; return true; }
    __device__ __forceinline__ const char* a_base(const Unit& u) const { return gather ? A : A + (size_t)u.pm * BM * (2048 * MOE_EB); }
    __device__ __forceinline__ unsigned a_rowoff(const Unit&, int ui, int R) const { return gather ? tbl[ui * 256 + R] : (unsigned)R * (2048u * MOE_EB); }
    __device__ __forceinline__ const char* b_base(const Unit& u) const { return Bt + (size_t)u.aux * b_estride + (size_t)u.pn * BM * ldb2; }
};

__device__ __forceinline__ void st8bf(bf16_t* p, f32x4 a, f32x4 b) { u32x4 w; w.x = pk2(a[0], a[1]); w.y = pk2(a[2], a[3]); w.z = pk2(b[0], b[1]); w.w = pk2(b[2], b[3]); *(u32x4*)p = w; }
struct EpiInProj {
    static constexpr bool PERM = true;
    bf16_t *QA, *KA, *VA, *QB, *KB, *VB; unsigned char *SGA, *SGB; const float* bias; const float* cosT; const float* sinT;
    __device__ __forceinline__ void operator()(const f32x4 (&acc)[2][2][4][2], const Unit& u, int wr, int wc, int fr, int fq) const {
        const int pn = u.pn, row0 = u.pm * BM + wr * 64 + fr, cw = wc * 32 + 8 * fq;
        const float ws = MIX_FP8 ? WSCALE_INV : 1.0f;
        f32x4 bv[2][2];
#pragma unroll
        for (int bj = 0; bj < 2; ++bj)
#pragma unroll
            for (int n = 0; n < 2; ++n) bv[bj][n] = *(const f32x4*)(bias + pn * 256 + bj * 128 + cw + 4 * n);
        if (pn < 5) {
            bf16_t* O = pn < 4 ? QA : KA; const int ldo = pn < 4 ? 1024 : 256; const int hcol = (pn < 4 ? pn * 256 : 0) + wc * 64 + 8 * fq; const float qs = pn < 4 ? QSCALE : 1.0f;
#pragma unroll
            for (int ai = 0; ai < 2; ++ai)
#pragma unroll
                for (int m = 0; m < 4; ++m) { const int row = row0 + ai * HALF + m * 16;
                    f32x4 o1[2], o2[2];
#pragma unroll
                    for (int n = 0; n < 2; ++n) { const f32x4 cs = *(const f32x4*)(cosT + (size_t)row * 32 + 8 * fq + 4 * n), sn = *(const f32x4*)(sinT + (size_t)row * 32 + 8 * fq + 4 * n);
                        const f32x4 x1 = acc[ai][0][m][n] * ws + bv[0][n], x2 = acc[ai][1][m][n] * ws + bv[1][n];
                        o1[n] = (x1 * cs - x2 * sn) * qs; o2[n] = (x2 * cs + x1 * sn) * qs; }
                    bf16_t* rp = O + (size_t)row * ldo + hcol; st8bf(rp, o1[0], o1[1]); st8bf(rp + 32, o2[0], o2[1]); }
        } else if (pn < 18) {
            bf16_t* O; int ldo, col0; float sc = 1.0f;
            if (pn == 5) { O = VA; ldo = 256; col0 = 0; } else if (pn < 10) { O = QB; ldo = 1024; col0 = (pn - 6) * 256; sc = QSCALE; } else if (pn < 14) { O = KB; ldo = 1024; col0 = (pn - 10) * 256; } else { O = VB; ldo = 1024; col0 = (pn - 14) * 256; }
#pragma unroll
            for (int ai = 0; ai < 2; ++ai)
#pragma unroll
                for (int m = 0; m < 4; ++m) { bf16_t* rp = O + (size_t)(row0 + ai * HALF + m * 16) * ldo + col0 + cw;
#pragma unroll
                    for (int bj = 0; bj < 2; ++bj) st8bf(rp + bj * HALF, (acc[ai][bj][m][0] * ws + bv[bj][0]) * sc, (acc[ai][bj][m][1] * ws + bv[bj][1]) * sc); }
        } else {
            unsigned char* O = pn < 26 ? SGA : SGB; const int col0 = ((pn - 18) & 7) * 256;
#pragma unroll
            for (int ai = 0; ai < 2; ++ai)
#pragma unroll
                for (int m = 0; m < 4; ++m) { unsigned char* rp = O + (size_t)(row0 + ai * HALF + m * 16) * 2048 + col0 + cw;
#pragma unroll
                    for (int bj = 0; bj < 2; ++bj) { f32x4 a = acc[ai][bj][m][0] * ws + bv[bj][0], b = acc[ai][bj][m][1] * ws + bv[bj][1];
#pragma unroll
                        for (int j = 0; j < 4; ++j) { a[j] = fast_sigmoid(a[j]); b[j] = fast_sigmoid(b[j]); }
                        u32x2 w8; w8.x = pk4_fp8(a[0], a[1], a[2], a[3]); w8.y = pk4_fp8(b[0], b[1], b[2], b[3]); *(u32x2*)(rp + bj * HALF) = w8; } }
        }
    }
};
struct EpiBranch {
    static constexpr bool PERM = true;
    const unsigned char *SGA, *SGB; float* T1; unsigned char* MERGED;
    __device__ __forceinline__ void operator()(const f32x4 (&acc)[2][2][4][2], const Unit& u, int wr, int wc, int fr, int fq) const {
        const int row0 = u.pm * BM + wr * 64 + fr, col0 = u.pn * BM + wc * 32 + 8 * fq;
        const unsigned char* SG = u.aux ? SGB : SGA;
#pragma unroll
        for (int ai = 0; ai < 2; ++ai)
#pragma unroll
            for (int m = 0; m < 4; ++m) { const size_t off = (size_t)(row0 + ai * HALF + m * 16) * 2048 + col0;
#pragma unroll
                for (int bj = 0; bj < 2; ++bj) { const u32x2 g = *(const u32x2*)(SG + off + bj * HALF);
                    const auto ga = __builtin_amdgcn_cvt_pk_f32_fp8(g.x, false), gb = __builtin_amdgcn_cvt_pk_f32_fp8(g.x, true), gc = __builtin_amdgcn_cvt_pk_f32_fp8(g.y, false), gd = __builtin_amdgcn_cvt_pk_f32_fp8(g.y, true);
                    const f32x4 g0 = {ga[0], ga[1], gb[0], gb[1]}, g1 = {gc[0], gc[1], gd[0], gd[1]};
                    const float ws = MIX_FP8 ? WSCALE_INV : 1.0f;
                    f32x4 a = acc[ai][bj][m][0] * g0 * ws, b = acc[ai][bj][m][1] * g1 * ws;
                    bf16_t* tp = (bf16_t*)T1 + off + bj * HALF;
                    if (u.aux == 0) { st8bf(tp, a, b); }
                    else { const u32x4 t = *(const u32x4*)tp; a += (f32x4){bflo(t.x), bfhi(t.x), bflo(t.y), bfhi(t.y)}; b += (f32x4){bflo(t.z), bfhi(t.z), bflo(t.w), bfhi(t.w)};
                        if constexpr (P5_FP8) { u32x2 w; w.x = pk4_fp8(a[0], a[1], a[2], a[3]); w.y = pk4_fp8(b[0], b[1], b[2], b[3]); *(u32x2*)(MERGED + off + bj * HALF) = w; }
                        else st8bf((bf16_t*)MERGED + off + bj * HALF, a, b); } } }
    }
};
struct EpiOut {
    static constexpr bool PERM = true;
    const float* x; const float* mod; bf16_t* H1;
    __device__ __forceinline__ void operator()(const f32x4 (&acc)[2][2][4][2], const Unit& u, int wr, int wc, int fr, int fq) const {
        const int row0 = u.pm * BM + wr * 64 + fr, cw = u.pn * BM + wc * 32 + 8 * fq; const float* gt = mod + (size_t)(u.pm >> 3) * MODW + 4096;
        const float ws = P5_FP8 ? WSCALE_INV : 1.0f;
#pragma unroll
        for (int bj = 0; bj < 2; ++bj) { const f32x4 g0 = *(const f32x4*)(gt + cw + bj * HALF) * ws, g1 = *(const f32x4*)(gt + cw + bj * HALF + 4) * ws;
#pragma unroll
            for (int ai = 0; ai < 2; ++ai)
#pragma unroll
                for (int m = 0; m < 4; ++m) { const size_t off = (size_t)(row0 + ai * HALF + m * 16) * 2048 + cw + bj * HALF;
                    st8bf(H1 + off, *(const f32x4*)(x + off) + g0 * acc[ai][bj][m][0], *(const f32x4*)(x + off + 4) + g1 * acc[ai][bj][m][1]); } }
    }
};
struct EpiGU {
    static constexpr bool PERM = true;
    const float* b_gu; unsigned char* ACT;
    __device__ __forceinline__ void operator()(const f32x4 (&acc)[2][2][4][2], const Unit& u, int wr, int wc, int fr, int fq) const {
        const int row0 = u.pm * BM + wr * 64 + fr, cw = wc * 32 + 8 * fq; const float* bg = b_gu + (size_t)u.aux * 4096 + u.pn * 128 + cw;
        const float ws = MOE_FP8 ? WSCALE_INV : 1.0f;
        f32x4 bv[2][2];
#pragma unroll
        for (int bj = 0; bj < 2; ++bj)
#pragma unroll
            for (int n = 0; n < 2; ++n) bv[bj][n] = *(const f32x4*)(bg + bj * 2048 + 4 * n);
#pragma unroll
        for (int ai = 0; ai < 2; ++ai)
#pragma unroll
            for (int m = 0; m < 4; ++m) { f32x4 o[2];
#pragma unroll
                for (int n = 0; n < 2; ++n) { const f32x4 g = acc[ai][0][m][n] * ws + bv[0][n], l = acc[ai][1][m][n] * ws + bv[1][n];
#pragma unroll
                    for (int j = 0; j < 4; ++j) { const float gg = fminf(g[j], 7.0f), ll = fminf(fmaxf(l[j], -7.0f), 7.0f);
                        o[n][j] = gg * (ll + 1.0f) * __builtin_amdgcn_rcpf(1.0f + __builtin_amdgcn_exp2f(-1.702f * LOG2E * gg)); } }
                const size_t eo = (size_t)(row0 + ai * HALF + m * 16) * 2048 + u.pn * 128 + cw;
                if constexpr (MOE_FP8) { u32x2 w; w.x = pk4_fp8(o[0][0], o[0][1], o[0][2], o[0][3]); w.y = pk4_fp8(o[1][0], o[1][1], o[1][2], o[1][3]); *(u32x2*)(ACT + eo) = w; }
                else st8bf((bf16_t*)ACT + eo, o[0], o[1]); }
    }
};
struct EpiDown {
    static constexpr bool PERM = true;
    const float* b_dn; unsigned char* YS;
    __device__ __forceinline__ void operator()(const f32x4 (&acc)[2][2][4][2], const Unit& u, int wr, int wc, int fr, int fq) const {
        const int row0 = u.pm * BM + wr * 64 + fr, col0 = u.pn * BM + wc * 32 + 8 * fq; const float* bd = b_dn + (size_t)u.aux * 2048 + col0;
        const float ws = MOE_FP8 ? WSCALE_INV : 1.0f;
        f32x4 bv[2][2];
#pragma unroll
        for (int bj = 0; bj < 2; ++bj)
#pragma unroll
            for (int n = 0; n < 2; ++n) bv[bj][n] = *(const f32x4*)(bd + bj * HALF + 4 * n);
#pragma unroll
        for (int ai = 0; ai < 2; ++ai)
#pragma unroll
            for (int m = 0; m < 4; ++m) { unsigned char* rp = YS + (size_t)(row0 + ai * HALF + m * 16) * 2048 + col0;
#pragma unroll
                for (int bj = 0; bj < 2; ++bj) { const f32x4 a = acc[ai][bj][m][0] * ws + bv[bj][0], b = acc[ai][bj][m][1] * ws + bv[bj][1];
                    u32x2 w; w.x = pk4_fp8(a[0], a[1], a[2], a[3]); w.y = pk4_fp8(b[0], b[1], b[2], b[3]); *(u32x2*)(rp + bj * HALF) = w; } }
    }
};

__device__ __forceinline__ int in_src(int r) { const int pn = r >> 8, c = r & 255; if (pn < 5) return pn * 256 + ((c & 127) >> 5) * 64 + (c >> 7) * 32 + (c & 31); return pn < 18 ? r : r + 16; }
__device__ __forceinline__ void transpose_item(const float* __restrict__ W, size_t ldw, int k0, int src0, int src1, bf16_t* __restrict__ WT, size_t ldk, int dst0, LAS unsigned* scr, int lane) {
    const int lg = lane >> 4, lc = lane & 15;
    const int scol = (lc < 8 ? src0 : src1 - 32) + 4 * lc;
    f32x4 v[8][2];
#pragma unroll
    for (int i = 0; i < 8; ++i)
#pragma unroll
        for (int p = 0; p < 2; ++p) v[i][p] = *(const f32x4*)(W + (size_t)(k0 + 8 * i + 2 * lg + p) * ldw + scol);
#pragma unroll
    for (int i = 0; i < 8; ++i)
#pragma unroll
        for (int c = 0; c < 4; ++c) scr[(4 * lc + c) * 33 + 4 * i + lg] = pk2(v[i][0][c], v[i][1][c]);
    asm volatile("s_waitcnt lgkmcnt(0)" ::: "memory");
    const int rn = lane >> 3, ch = lane & 7;
#pragma unroll
    for (int j = 0; j < 8; ++j) { const int n = rn + 8 * j; const LAS unsigned* s = scr + n * 33 + 4 * ch; u32x4 o; o.x = s[0]; o.y = s[1]; o.z = s[2]; o.w = s[3];
        *(u32x4*)(WT + (size_t)(dst0 + n) * ldk + k0 + 8 * ch) = o; }
    asm volatile("s_waitcnt lgkmcnt(0)" ::: "memory");
}
__device__ __forceinline__ void transpose_item_f8(const float* __restrict__ W, size_t ldw, int k0, int src0, int src1, unsigned char* __restrict__ WT, size_t ldk, int dst0, LAS unsigned* scr, int lane, float scale) {
    const int lg = lane >> 4, lc = lane & 15;
    const float* wp = W + (size_t)(k0 + 4 * lg) * ldw + (lc < 8 ? src0 : src1 - 32) + 4 * lc;
#pragma unroll
    for (int hf = 0; hf < 2; ++hf) {
        f32x4 v[4][4];
#pragma unroll
        for (int i = 0; i < 4; ++i)
#pragma unroll
            for (int p = 0; p < 4; ++p) v[i][p] = *(const f32x4*)(wp + (size_t)(64 * hf + 16 * i + p) * ldw);
#pragma unroll
        for (int i = 0; i < 4; ++i)
#pragma unroll
            for (int c = 0; c < 4; ++c) scr[(4 * lc + c) * 33 + 16 * hf + 4 * i + lg] = pk4_fp8_raw(v[i][0][c] * scale, v[i][1][c] * scale, v[i][2][c] * scale, v[i][3][c] * scale);
    }
    asm volatile("s_waitcnt lgkmcnt(0)" ::: "memory");
    const int rn = lane >> 3, ch = lane & 7;
#pragma unroll
    for (int j = 0; j < 8; ++j) { const int n = rn + 8 * j; const LAS unsigned* s = scr + n * 33 + 4 * ch; u32x4 o; o.x = s[0]; o.y = s[1]; o.z = s[2]; o.w = s[3];
        *(u32x4*)(WT + (size_t)(dst0 + n) * ldk + k0 + 16 * ch) = o; }
    asm volatile("s_waitcnt lgkmcnt(0)" ::: "memory");
}
constexpr int P0_KD = MIX_FP8 ? 128 : 64;
constexpr int P0_T_HEAD = 768 + 256 + 1, P0_T_ALL = P0_T_HEAD + (2048 / P0_KD) * 136 + 2 * (1024 / P0_KD) * 32 + (2048 / P0_KD) * 32;
__device__ __forceinline__ void p0_prologue(Frame& F, const int t_lo, const int t_hi, const int gw_, const int NGW_) {
    refresh(F);
    LAS unsigned* scr = (LAS unsigned*)(F.lds + RING_OFF + F.wave * 8448);
    LAS f32x4* ca = (LAS f32x4*)(F.lds + RING_OFF + 69632);
    for (int k = F.tid; k < 2048; k += NWAVES * 64) { f32x4 v;
#pragma unroll
        for (int b = 0; b < 4; ++b) { const float cv = F.c[b * 2048 + k]; v[b] = cv / (1.0f + expf(-cv)); }
        ca[k] = v; }
    __syncthreads();
    const int gw = gw_, NGW = NGW_, lane = F.lane;
    constexpr int KD = P0_KD;
    constexpr int T_ADA = 768, T_ROPE = 256, T_BIAS = 1, T_WIN = (2048 / KD) * 136, T_WA = (1024 / KD) * 32, T_WB = (1024 / KD) * 32, T_WOUT = (2048 / KD) * 32;
    constexpr int NT = T_ADA + T_ROPE + T_BIAS + T_WIN + T_WA + T_WB + T_WOUT;
    static_assert(NT == P0_T_ALL && T_ADA + T_ROPE + T_BIAS == P0_T_HEAD, "prologue task list");
    float* mod = wsp<float>(F, WS_MOD); float* cosT = wsp<float>(F, WS_COS); float* sinT = wsp<float>(F, WS_SIN); float* binp = wsp<float>(F, WS_BINP);
    for (int it = t_lo + gw; it < t_hi; it += NGW) {
        int r = it;
        if (r < T_ADA) {
            const int j0 = 16 * r, cl = lane & 3, kr = lane >> 2;
            f32x4 a[4];
#pragma unroll
            for (int b = 0; b < 4; ++b) a[b] = (f32x4){0.f, 0.f, 0.f, 0.f};
            const float* wp = F.w_ada + (size_t)kr * MODW + j0 + 4 * cl;
#pragma unroll 8
            for (int s = 0; s < 128; ++s) { const f32x4 w4 = *(const f32x4*)(wp + (size_t)s * 16 * MODW); const f32x4 c4 = ca[16 * s + kr];
#pragma unroll
                for (int b = 0; b < 4; ++b) a[b] += w4 * c4[b]; }
#pragma unroll
            for (int b = 0; b < 4; ++b)
#pragma unroll
                for (int c = 0; c < 4; ++c) { float v = a[b][c]; v += __shfl_xor(v, 4); v += __shfl_xor(v, 8); v += __shfl_xor(v, 16); v += __shfl_xor(v, 32); a[b][c] = v; }
            if (kr == 0) { const f32x4 bb = *(const f32x4*)(F.b_ada + j0 + 4 * cl);
#pragma unroll
                for (int b = 0; b < 4; ++b) *(f32x4*)(mod + b * MODW + j0 + 4 * cl) = a[b] + bb; }
            continue; } r -= T_ADA;
        if (r < T_ROPE) {
            const int i = lane & 31, ts = lane >> 5; const float inv = 1.0f / powf(10000.0f, (float)(2 * i) / 64.0f);
            for (int j = 0; j < 16; ++j) { const int t = 32 * r + 2 * j + ts; const float ang = (float)F.pos[t] * inv; cosT[t * 32 + i] = cosf(ang); sinT[t * 32 + i] = sinf(ang); }
            continue; } r -= T_ROPE;
        if (r < T_BIAS) { for (int q = lane; q < 8704; q += 64) binp[q] = F.b_in[in_src(q)]; continue; } r -= T_BIAS;
        const float* W; size_t ldw; int kb, nb, s0, s1; unsigned char* WT; size_t ldk;
        if (r < T_WIN) { kb = r / 136; nb = r % 136; W = F.w_in; ldw = INW; s0 = in_src(64 * nb); s1 = in_src(64 * nb + 32); WT = wsp<unsigned char>(F, WS_WIN); ldk = 2048; }
        else if ((r -= T_WIN) < T_WA) { kb = r / 32; nb = r % 32; W = F.w_a; ldw = 2048; s0 = 64 * nb; s1 = s0 + 32; WT = wsp<unsigned char>(F, WS_WAB); ldk = 1024; }
        else if ((r -= T_WA) < T_WB) { kb = r / 32; nb = r % 32; W = F.w_b; ldw = 2048; s0 = 64 * nb; s1 = s0 + 32; WT = wsp<unsigned char>(F, WS_WAB) + (size_t)2048 * 1024 * MIX_EB; ldk = 1024; }
        else { r -= T_WB; W = F.w_out; ldw = 2048; WT = wsp<unsigned char>(F, WS_WOUT); ldk = 2048;
            if constexpr (MIX_FP8 && !P5_FP8) { kb = r / 32; nb = r % 32; s0 = 64 * nb; s1 = s0 + 32;
                transpose_item(W, ldw, 128 * kb, s0, s1, (bf16_t*)WT, ldk, 64 * nb, scr, lane); transpose_item(W, ldw, 128 * kb + 64, s0, s1, (bf16_t*)WT, ldk, 64 * nb, scr, lane); continue; }
            kb = r / 32; nb = r % 32; s0 = 64 * nb; s1 = s0 + 32; }
        if constexpr (MIX_FP8) transpose_item_f8(W, ldw, 128 * kb, s0, s1, WT, ldk, 64 * nb, scr, lane, WSCALE);
        else transpose_item(W, ldw, 64 * kb, s0, s1, (bf16_t*)WT, ldk, 64 * nb, scr, lane);
    }
}
__device__ __forceinline__ void p0_comp(Frame& F) {
    refresh(F);
    LAS f32x4* ca = (LAS f32x4*)(F.lds + RING_OFF + 69632);
    LAS float* part = (LAS float*)(F.lds + RING_OFF);
    for (int k = F.tid; k < 2048; k += NWAVES * 64) { f32x4 v;
#pragma unroll
        for (int b = 0; b < 4; ++b) { const float cv = F.c[b * 2048 + k]; v[b] = cv / (1.0f + expf(-cv)); }
        ca[k] = v; }
    __syncthreads();
    const int lane = F.lane, w = F.wave;
    float* mod = wsp<float>(F, WS_MOD); float* cosT = wsp<float>(F, WS_COS); float* sinT = wsp<float>(F, WS_SIN); float* binp = wsp<float>(F, WS_BINP);
    { const int NT = F.G * NWAVES * 64, g0 = F.vcu * NWAVES * 64 + F.tid;
      const float inv = 1.0f / powf(10000.0f, (float)(2 * (g0 & 31)) / 64.0f);
      for (int i = g0; i < NTOK * 32; i += NT) { const float ang = (float)F.pos[i >> 5] * inv; cosT[i] = cosf(ang); sinT[i] = sinf(ang); }
      for (int q = g0; q < 8704; q += NT) binp[q] = F.b_in[in_src(q)]; }
    const int cl = lane & 7, kr = lane >> 3;
    int par = 0;
#pragma unroll 1
    for (int t = F.vcu; t < 768; t += F.G) {
        const int cb = t >> 1, kh = t & 1, j0 = 32 * cb, k0 = 1024 * kh + 128 * w;
        const float* wp = F.w_ada + (size_t)(k0 + kr) * MODW + j0 + 4 * cl;
        f32x4 v[16];
#pragma unroll
        for (int s_ = 0; s_ < 16; ++s_) v[s_] = __builtin_nontemporal_load((const f32x4*)(wp + (size_t)s_ * 8 * MODW));
        f32x4 a[4];
#pragma unroll
        for (int b = 0; b < 4; ++b) a[b] = (f32x4){0.f, 0.f, 0.f, 0.f};
#pragma unroll
        for (int s_ = 0; s_ < 16; ++s_) { const f32x4 c4 = ca[k0 + 8 * s_ + kr];
#pragma unroll
            for (int b = 0; b < 4; ++b) a[b] += v[s_] * c4[b]; }
#pragma unroll
        for (int b = 0; b < 4; ++b)
#pragma unroll
            for (int c = 0; c < 4; ++c) { float x = a[b][c]; x += __shfl_xor(x, 8); x += __shfl_xor(x, 16); x += __shfl_xor(x, 32); a[b][c] = x; }
        LAS float* pp = part + par * 1024;
        if (kr == 0) {
#pragma unroll
            for (int b = 0; b < 4; ++b) *(LAS f32x4*)(pp + (w * 4 + b) * 32 + 4 * cl) = a[b]; }
        __syncthreads();
        if (F.tid < 128) { const int b = F.tid >> 5, col = F.tid & 31; float x = kh == 0 ? F.b_ada[j0 + col] : 0.f;
#pragma unroll
            for (int ww = 0; ww < 8; ++ww) x += pp[(ww * 4 + b) * 32 + col];
            atomicAdd(mod + b * MODW + j0 + col, x); }
        par ^= 1;
    }
}
constexpr int T_WGU = MOE_FP8 ? 32 * 16 * 64 : 32 * 32 * 64, T_WD = MOE_FP8 ? 32 * 16 * 32 : 32 * 32 * 32;
__device__ __forceinline__ void convert_item(Frame& F, int r, LAS unsigned* scr, int lane) {
    if (r < T_WGU) {
        if constexpr (MOE_FP8) { const int e = r >> 10, q = r & 1023, kb = q >> 6, nb = q & 63; const int r0 = 64 * nb, src = ((r0 & 255) >> 7) * 2048 + (r0 >> 8) * 128 + (r0 & 127);
            transpose_item_f8(F.w_gu + (size_t)e * 2048 * 4096, 4096, 128 * kb, src, src + 32, wsp<unsigned char>(F, WS_WGU) + (size_t)e * 4096 * 2048, 2048, r0, scr, lane, WSCALE); }
        else { const int e = r >> 11, q = r & 2047, kb = q >> 6, nb = q & 63; const int r0 = 64 * nb, src = ((r0 & 255) >> 7) * 2048 + (r0 >> 8) * 128 + (r0 & 127);
            transpose_item(F.w_gu + (size_t)e * 2048 * 4096, 4096, 64 * kb, src, src + 32, wsp<bf16_t>(F, WS_WGU) + (size_t)e * 4096 * 2048, 2048, r0, scr, lane); }
        return; }
    r -= T_WGU;
    if constexpr (MOE_FP8) { const int e = r >> 9, q = r & 511, kb = q >> 5, nb = q & 31;
        transpose_item_f8(F.w_dn + (size_t)e * 2048 * 2048, 2048, 128 * kb, 64 * nb, 64 * nb + 32, wsp<unsigned char>(F, WS_WD) + (size_t)e * 2048 * 2048, 2048, 64 * nb, scr, lane, WSCALE); }
    else { const int e = r >> 10, q = r & 1023, kb = q >> 5, nb = q & 31;
        transpose_item(F.w_dn + (size_t)e * 2048 * 2048, 2048, 64 * kb, 64 * nb, 64 * nb + 32, wsp<bf16_t>(F, WS_WD) + (size_t)e * 2048 * 2048, 2048, 64 * nb, scr, lane); }
}
struct CvItem { const char* src; unsigned char* dst; };
template <bool GU> __device__ __forceinline__ CvItem cv_decode(Frame& F, int r) {
    constexpr int N = GU ? T_WGU : T_WD; constexpr size_t ldw = GU ? 4096 : 2048;
    r = r < N ? r : 0;
    const int e = r >> (GU ? 10 : 9), q = r & (GU ? 1023 : 511), kb = q >> (GU ? 6 : 5), nb = q & (GU ? 63 : 31), r0 = 64 * nb;
    const int srcc = GU ? ((r0 & 255) >> 7) * 2048 + (r0 >> 8) * 128 + (r0 & 127) : r0;
    CvItem P;
    P.src = (const char*)((GU ? F.w_gu : F.w_dn) + (size_t)e * 2048 * ldw + (size_t)(128 * kb) * ldw + srcc);
    P.dst = (GU ? wsp<unsigned char>(F, WS_WGU) : wsp<unsigned char>(F, WS_WD)) + (size_t)e * ldw * 2048 + (size_t)r0 * 2048 + 128 * kb;
    return P;
}
template <bool GU> __device__ __forceinline__ void convert_loop(Frame& F, unsigned* head) {
    constexpr int N = GU ? T_WGU : T_WD, NP = (N + 2) / 3 * 3; constexpr unsigned ldwb = (GU ? 4096u : 2048u) * 4u;
    LAS unsigned* scr = (LAS unsigned*)(F.lds + RING_OFF + F.wave * 8448);
    const int lane = F.lane, lg = lane >> 4, lc = lane & 15, rn = lane >> 3, ch = lane & 7;
    const unsigned lo = (unsigned)(4 * lg) * ldwb + 16u * (unsigned)lc;
    f32x4 A[4][4], B[4][4], C[4][4];
#define CV_LOAD(buf, P, h) do { _Pragma("unroll") for (int i = 0; i < 4; ++i) _Pragma("unroll") for (int p = 0; p < 4; ++p) { const char* rb_ = (P).src + (size_t)(64 * (h) + 16 * i + p) * ldwb; \
        asm volatile("global_load_dwordx4 %0, %1, %2 nt" : "=v"(buf[i][p]) : "v"(lo), "s"(rb_) : "memory"); } } while (0)
#define CV_WAIT(N, buf) do { asm volatile("s_waitcnt vmcnt(" #N ")" ::: "memory"); _Pragma("unroll") for (int i = 0; i < 4; ++i) asm volatile("" : "+v"(buf[i][0]), "+v"(buf[i][1]), "+v"(buf[i][2]), "+v"(buf[i][3])); } while (0)
#define CV_PROC(buf, h) do { _Pragma("unroll") for (int i = 0; i < 4; ++i) _Pragma("unroll") for (int c = 0; c < 4; ++c) \
        scr[(4 * lc + c) * 33 + 16 * (h) + 4 * i + lg] = pk4_fp8_raw(buf[i][0][c] * WSCALE, buf[i][1][c] * WSCALE, buf[i][2][c] * WSCALE, buf[i][3][c] * WSCALE); } while (0)
#define CV_STORE(P) do { _Pragma("unroll") for (int j = 0; j < 8; ++j) { const LAS unsigned* s_ = scr + (rn + 8 * j) * 33 + 4 * ch; u32x4 o_; o_.x = s_[0]; o_.y = s_[1]; o_.z = s_[2]; o_.w = s_[3]; \
        const unsigned so_ = (unsigned)(rn + 8 * j) * 2048u + 16u * (unsigned)ch; asm volatile("global_store_dwordx4 %0, %1, %2 nt" :: "v"(so_), "v"(o_), "s"((P).dst) : "memory"); } } while (0)
    const unsigned claim_add = 3u, claim_off = 0u; unsigned long long ex_save;
#define CV_CLAIM() asm volatile("s_mov_b64 %1, exec\n\ts_mov_b64 exec, 1\n\tglobal_atomic_add %0, %2, %3, %4 sc0\n\ts_mov_b64 exec, %1" : "+v"(raw), "=&s"(ex_save) : "v"(claim_off), "v"(claim_add), "s"(head) : "memory")
    unsigned raw = 0u;
    CV_CLAIM();
    asm volatile("s_waitcnt vmcnt(0)" : "+v"(raw) :: "memory");
    int base = (int)__builtin_amdgcn_readfirstlane(raw);
    CV_CLAIM();
    CvItem P0 = cv_decode<GU>(F, base), P1, P2;
    CV_LOAD(A, P0, 0); CV_LOAD(B, P0, 1);
    {
      unsigned char* junk = wsp<unsigned char>(F, WS_JUNK) + (size_t)(blockIdx.x * NWAVES + F.wave) * 16384; const u32x4 zz_ = {0u, 0u, 0u, 0u};
#pragma unroll
      for (int j = 0; j < 8; ++j) { const unsigned so_ = (unsigned)(rn + 8 * j) * 128u + 16u * (unsigned)ch; asm volatile("global_store_dwordx4 %0, %1, %2 nt" :: "v"(so_), "v"(zz_), "s"(junk) : "memory"); } }
    while (base < NP) {
        P1 = cv_decode<GU>(F, base + 1); P2 = cv_decode<GU>(F, base + 2);
        CV_LOAD(C, P1, 0); CV_WAIT(40, A); CV_PROC(A, 0);
        CV_LOAD(A, P1, 1); CV_WAIT(40, B); CV_PROC(B, 1); CV_STORE(P0);
        CV_LOAD(B, P2, 0); CV_WAIT(40, C); CV_PROC(C, 0);
        CV_LOAD(C, P2, 1); CV_WAIT(40, A); CV_PROC(A, 1); CV_STORE(P1);
        asm volatile("s_waitcnt vmcnt(48)" : "+v"(raw) :: "memory");
        base = (int)__builtin_amdgcn_readfirstlane(raw);
        CV_CLAIM();
        P0 = cv_decode<GU>(F, base);
        CV_LOAD(A, P0, 0); CV_WAIT(41, B); CV_PROC(B, 0);
        CV_LOAD(B, P0, 1); CV_WAIT(41, C); CV_PROC(C, 1); CV_STORE(P2);
    }
#undef CV_WAIT
    asm volatile("s_waitcnt vmcnt(0)" ::: "memory");
#undef CV_CLAIM
#undef CV_LOAD
#undef CV_PROC
#undef CV_STORE
}
__device__ __forceinline__ void convert_queue(Frame& F) {
    refresh(F);
    __syncthreads();
    if constexpr (!MOE_FP8) {
        LAS unsigned* scr0 = (LAS unsigned*)(F.lds + RING_OFF + F.wave * 8448); unsigned* head0 = F.ctl + CW_CQ; constexpr int NQ0 = T_WGU + T_WD;
        for (;;) { unsigned raw0 = 0u; if (F.lane == 0) raw0 = __hip_atomic_fetch_add(head0, 1u, __ATOMIC_RELAXED, __HIP_MEMORY_SCOPE_AGENT); const int it = (int)__builtin_amdgcn_readfirstlane(raw0); if (it >= NQ0) break; convert_item(F, it, scr0, F.lane); }
        __syncthreads(); return; }
    convert_loop<true>(F, F.ctl + CW_CQ);
    convert_loop<false>(F, F.ctl + CW_CQ + 128);
    __syncthreads();
}


constexpr int CS_GU = 32 * 8 * 16, CS_DN = 32 * 8 * 8, CS_N = CS_GU + CS_DN, CS_PITCH = 65;
constexpr int CW_CQ1 = CW_CQ + 256, CW_CQ2 = CW_CQ + 320, CW_START2 = CW_CQ + 384; constexpr unsigned CONV_BUMP = 1u << 20;
__device__ __forceinline__ void convert_coop(Frame& F, unsigned* head, const int base) {
    refresh(F);
    __syncthreads();
    LAS unsigned* tile0 = (LAS unsigned*)(F.lds + RING_OFF);
    const int lane = F.lane, w = F.wave;
    if (F.tid == 0) F.MISC[104] = __hip_atomic_fetch_add(head, 1u, __ATOMIC_RELAXED, __HIP_MEMORY_SCOPE_AGENT);
    __syncthreads();
    int slot = 0, p = 0;
    for (;;) {
        const unsigned rawit = F.MISC[104 + slot];
        if (rawit >= (unsigned)CS_N) break;
        const int it = base + (int)rawit;
        if (it >= CS_N) break;
        if (F.tid == 0) F.MISC[104 + (slot ^ 1)] = __hip_atomic_fetch_add(head, 1u, __ATOMIC_RELAXED, __HIP_MEMORY_SCOPE_AGENT);
        const bool gu = it < CS_GU; const int r = gu ? it : it - CS_GU;
        const int e = gu ? (r >> 7) : (r >> 6), q = gu ? (r & 127) : (r & 63), kb = gu ? (q >> 4) : (q >> 3), nb = gu ? (q & 15) : (q & 7);
        const size_t ldw = gu ? 4096 : 2048;
        const float* W = (gu ? F.w_gu : F.w_dn) + (size_t)e * 2048 * ldw + (size_t)(256 * kb + 32 * w) * ldw;
        const int scol = gu ? ((lane >> 5) * 2048 + nb * 128 + 4 * (lane & 31)) : (nb * 256 + 4 * lane);
        unsigned char* O = (gu ? wsp<unsigned char>(F, WS_WGU) : wsp<unsigned char>(F, WS_WD)) + (size_t)e * ldw * 2048 + (size_t)(256 * nb) * 2048 + 256 * kb;
        LAS unsigned* T = tile0 + p * (256 * CS_PITCH);
        f32x4 v[32];
#pragma unroll
        for (int i = 0; i < 32; ++i) v[i] = __builtin_nontemporal_load((const f32x4*)(W + (size_t)i * ldw + scol));
#pragma unroll
        for (int kk = 0; kk < 8; ++kk)
#pragma unroll
            for (int c = 0; c < 4; ++c) T[(4 * lane + c) * CS_PITCH + 8 * w + kk] = pk4_fp8_raw(v[4 * kk][c] * WSCALE, v[4 * kk + 1][c] * WSCALE, v[4 * kk + 2][c] * WSCALE, v[4 * kk + 3][c] * WSCALE);
        __syncthreads();
#pragma unroll
        for (int i = 0; i < 8; ++i) { const int n = 32 * w + 4 * i + (lane >> 4), ch = lane & 15; const LAS unsigned* s_ = T + n * CS_PITCH + 4 * ch; u32x4 o; o.x = s_[0]; o.y = s_[1]; o.z = s_[2]; o.w = s_[3];
            __builtin_nontemporal_store(o, (u32x4*)(O + (size_t)n * 2048 + 16 * ch)); }
        slot ^= 1; p ^= 1;
    }
    __syncthreads();
}

__device__ __forceinline__ void p1_norm_fb(Frame& F) {
    refresh(F);
#pragma unroll 1
    for (int i0 = F.tid; i0 < 2048 * 4; i0 += 16 * NWAVES * 64) {
        f32x4 v[16];
#pragma unroll
        for (int u = 0; u < 16; ++u) { const int i = i0 + u * NWAVES * 64, k = i >> 2, q = i & 3; v[u] = *(const f32x4*)(F.w_in + (size_t)k * INW + 4608 + 4 * q); }
#pragma unroll
        for (int u = 0; u < 16; ++u) { const int i = i0 + u * NWAVES * 64, k = i >> 2, q = i & 3; const int j = k >> 8, l = (k & 255) >> 2, c = k & 3; *(LAS f32x4*)(F.lds + RING_OFF + ((((j * 4 + c) * 4 + q) * 64 + l) << 4)) = v[u]; } }
    __syncthreads();
    const int gw = F.vcu * NWAVES + F.wave, NGW = F.G * NWAVES, lane = F.lane;
    const float* mod = wsp<float>(F, WS_MOD); unsigned char* XN = wsp<unsigned char>(F, WS_XN); float* LOGF = wsp<float>(F, WS_LOGF);
    for (int row = gw; row < NTOK; row += NGW) {
        const int b = row >> 11; const float* xr = F.x + (size_t)row * DM; const float* sh = mod + b * MODW, *sc = mod + b * MODW + 2048;
        f32x4 v[8]; float ss = 0.f;
#pragma unroll
        for (int j = 0; j < 8; ++j) { v[j] = *(const f32x4*)(xr + 256 * j + 4 * lane); ss += v[j][0] * v[j][0] + v[j][1] * v[j][1] + v[j][2] * v[j][2] + v[j][3] * v[j][3]; }
        ss = wave_sum(ss); const float rstd = 1.0f / sqrtf(ss * (1.0f / DM) + 1e-5f);
        float fa[16];
#pragma unroll
        for (int h = 0; h < 16; ++h) fa[h] = 0.f;
#pragma unroll
        for (int j = 0; j < 8; ++j) { const int col = 256 * j + 4 * lane; const f32x4 g = *(const f32x4*)(F.g_mix + col), s1 = *(const f32x4*)(sc + col), h1 = *(const f32x4*)(sh + col);
            const f32x4 y = v[j] * rstd * g * (s1 + 1.0f) + h1;
            if constexpr (MIX_FP8) *(unsigned*)(XN + (size_t)row * DM + col) = pk4_fp8(y[0], y[1], y[2], y[3]);
            else { u32x2 w; w.x = pk2(y[0], y[1]); w.y = pk2(y[2], y[3]); *(u32x2*)((bf16_t*)XN + (size_t)row * DM + col) = w; }
#pragma unroll
            for (int c = 0; c < 4; ++c) {
#pragma unroll
                for (int q = 0; q < 4; ++q) { const f32x4 wv = *(const LAS f32x4*)(F.lds + RING_OFF + ((((j * 4 + c) * 4 + q) * 64 + lane) << 4));
#pragma unroll
                    for (int e = 0; e < 4; ++e) fa[4 * q + e] += y[c] * wv[e]; }
                if (c & 1) asm volatile("" ::: "memory"); } }
#pragma unroll
        for (int h = 0; h < 16; ++h) fa[h] = wave_sum(fa[h]);
        float mine = 0.f;
#pragma unroll
        for (int h = 0; h < 16; ++h) mine = (lane == h) ? fa[h] : mine;
        if (lane < 16) { const float f = mine + F.b_in[4608 + lane]; LOGF[row * 16 + lane] = fminf(f, 0.f) - log1pf(expf(-fabsf(f))); }
    }
}
__device__ __forceinline__ void p2_cumsum(Frame& F) {
    refresh(F);
    volatile LAS float* wsum_s = (volatile LAS float*)(F.MISC + 96);
    const float* LOGF = wsp<float>(F, WS_LOGF); float* CUM = wsp<float>(F, WS_CUM);
    for (int bh = F.vcu; bh < 64; bh += F.G) {
        const int b = bh >> 4, h = bh & 15, t0 = 4 * F.tid;
        float a[4];
#pragma unroll
        for (int i = 0; i < 4; ++i) a[i] = LOGF[(size_t)(b * SEQ + t0 + i) * 16 + h];
        a[1] += a[0]; a[2] += a[1]; a[3] += a[2];
        float s = a[3];
#pragma unroll
        for (int o = 1; o < 64; o <<= 1) { const float t = __shfl_up(s, o); if (F.lane >= o) s += t; }
        if (F.lane == 63) wsum_s[F.wave] = s;
        __syncthreads();
        float base = 0.f;
        for (int w = 0; w < F.wave; ++w) base += wsum_s[w];
        const float excl = base + s - a[3];
#pragma unroll
        for (int i = 0; i < 4; ++i) CUM[(size_t)bh * SEQ + t0 + i] = excl + a[i];
        __syncthreads();
    }
}

constexpr int AT_KOFF = 0, AT_VOFF = 9216, AT_VP = 192, AT_COFF = 9216 + 64 * 192, AT_BUF = AT_COFF + 512;
template <int MODE>
__device__ __forceinline__ void attn_unit(LAS unsigned char* lds, const bf16_t* __restrict__ Q, const bf16_t* __restrict__ Kt, const bf16_t* __restrict__ Vt, const float* __restrict__ cum, unsigned char* __restrict__ O,
                                          int b, int h, int qb, float sink2, int wid) {
    const int lane = lane_id(), tid = wid * 64 + lane, r32 = lane & 31, hi = lane >> 5;
    constexpr int KP = MODE ? 1024 : 256;
    const int kvh = MODE ? h : (h >> 2);
    const int q0 = qb * 256, w0 = q0 + 32 * wid;
    const size_t rowbase = (size_t)b * SEQ;
    bf16x8 qf[4];
    { const bf16_t* qp = Q + (rowbase + w0 + r32) * 1024 + h * 64 + hi * 8;
#pragma unroll
      for (int d0 = 0; d0 < 4; ++d0) qf[d0] = *(const bf16x8*)(qp + d0 * 16); }
    const int kt_lo = MODE ? 0 : (q0 >= 128 ? ((q0 - 128) >> 6) : 0), kt_hi = (q0 + 255) >> 6;
    const int skey = tid >> 3, sch = tid & 7;
    const bf16_t* kg = Kt + (rowbase + skey) * KP + kvh * 64 + sch * 8;
    const bf16_t* vg = Vt + (rowbase + skey) * KP + kvh * 64 + sch * 8;
    u32x4 kreg, vr0; float ckreg = 0.f;
#define AT_LOAD(kt) do { kreg = *(const u32x4*)(kg + (size_t)(kt) * 64 * KP); vr0 = *(const u32x4*)(vg + (size_t)(kt) * 64 * KP); \
        if (MODE && tid < 64) ckreg = -cum[(kt) * 64 + tid] * LOG2E; } while (0)
    AT_LOAD(kt_lo);
    float m = MODE ? -1e30f : sink2, l = (MODE == 0 && hi == 0) ? 1.0f : 0.0f;
    f32x16 o0 = {}, o1 = {};
    for (int kt = kt_lo; kt <= kt_hi; ++kt) {
        LAS unsigned char* buf = lds + ((kt - kt_lo) & 1) * AT_BUF;
        *(LAS u32x4*)(buf + AT_KOFF + skey * 144 + sch * 16) = kreg;
        *(LAS u32x4*)(buf + AT_VOFF + skey * AT_VP + sch * 16) = vr0;
        if (MODE && tid < 64) *(LAS float*)(buf + AT_COFF + tid * 4) = ckreg;
        __syncthreads();
        if (kt < kt_hi) AT_LOAD(kt + 1);
        const int k0 = kt * 64;
        const bool active = (k0 <= w0 + 31) && (MODE || (k0 + 63 >= w0 - 127));
        if (active) {
            f32x16 p0 = {}, p1 = {};
            if (MODE) {
#pragma unroll
                for (int g = 0; g < 4; ++g) { const f32x4 c0 = *(const LAS f32x4*)(buf + AT_COFF + (8 * g + 4 * hi) * 4), c1 = *(const LAS f32x4*)(buf + AT_COFF + (32 + 8 * g + 4 * hi) * 4);
#pragma unroll
                    for (int j = 0; j < 4; ++j) { p0[4 * g + j] = c0[j]; p1[4 * g + j] = c1[j]; } } }
            { const LAS unsigned char* kb = buf + AT_KOFF + r32 * 144 + hi * 16;
#pragma unroll
              for (int d0 = 0; d0 < 4; ++d0) { const bf16x8 ka = *(const LAS bf16x8*)(kb + d0 * 32), kc = *(const LAS bf16x8*)(kb + 32 * 144 + d0 * 32);
                  p0 = __builtin_amdgcn_mfma_f32_32x32x16_bf16(ka, qf[d0], p0, 0, 0, 0); p1 = __builtin_amdgcn_mfma_f32_32x32x16_bf16(kc, qf[d0], p1, 0, 0, 0); } }
            const bool need_mask = MODE ? (k0 + 63 > w0) : true;
            if (need_mask) { const int q = w0 + r32;
#pragma unroll
                for (int r = 0; r < 16; ++r) { const int key = k0 + (r & 3) + 8 * (r >> 2) + 4 * hi;
                    const bool v0 = (key <= q) && (MODE || key + 127 >= q), v1 = (key + 32 <= q) && (MODE || key + 32 + 127 >= q);
                    p0[r] = v0 ? p0[r] : -INFINITY; p1[r] = v1 ? p1[r] : -INFINITY; } }
            float rm = __builtin_fmaxf(p0[0], p1[0]);
#pragma unroll
            for (int r = 1; r < 16; ++r) rm = __builtin_fmaxf(__builtin_fmaxf(rm, p0[r]), p1[r]);
            { const unsigned ru = __builtin_bit_cast(unsigned, rm); auto rr = __builtin_amdgcn_permlane32_swap(ru, ru, false, false);
              rm = __builtin_fmaxf(__builtin_bit_cast(float, rr[0]), __builtin_bit_cast(float, rr[1])); }
            const float mn = fmaxf(m, rm), alpha = __builtin_amdgcn_exp2f(m - mn);
            const bool grew = mn > m; m = mn;
            float ps = 0.f;
#pragma unroll
            for (int r = 0; r < 16; ++r) { p0[r] = __builtin_amdgcn_exp2f(p0[r] - mn); p1[r] = __builtin_amdgcn_exp2f(p1[r] - mn); ps += p0[r] + p1[r]; }
            l = l * alpha + ps;
            if (__any(grew)) {
#pragma unroll
                for (int r = 0; r < 16; ++r) { o0[r] *= alpha; o1[r] *= alpha; } }
            bf16x8 pf[4];
            { u32x4 w;
              w.x = pk2(p0[0], p0[1]); w.y = pk2(p0[2], p0[3]); w.z = pk2(p0[4], p0[5]); w.w = pk2(p0[6], p0[7]); pf[0] = __builtin_bit_cast(bf16x8, w);
              w.x = pk2(p0[8], p0[9]); w.y = pk2(p0[10], p0[11]); w.z = pk2(p0[12], p0[13]); w.w = pk2(p0[14], p0[15]); pf[1] = __builtin_bit_cast(bf16x8, w);
              w.x = pk2(p1[0], p1[1]); w.y = pk2(p1[2], p1[3]); w.z = pk2(p1[4], p1[5]); w.w = pk2(p1[6], p1[7]); pf[2] = __builtin_bit_cast(bf16x8, w);
              w.x = pk2(p1[8], p1[9]); w.y = pk2(p1[10], p1[11]); w.z = pk2(p1[12], p1[13]); w.w = pk2(p1[14], p1[15]); pf[3] = __builtin_bit_cast(bf16x8, w); }
            const LAS unsigned char* vb = buf + AT_VOFF + (4 * hi + ((lane & 15) >> 2)) * AT_VP + (16 * ((lane >> 4) & 1) + 4 * (lane & 3)) * 2;
#pragma unroll
            for (int ks = 0; ks < 4; ++ks) {
#pragma unroll
                for (int blk = 0; blk < 2; ++blk) {
                    const s16x4 tl = __builtin_amdgcn_ds_read_tr16_b64_v4i16((LAS s16x4*)(vb + ks * 16 * AT_VP + blk * 64)), th = __builtin_amdgcn_ds_read_tr16_b64_v4i16((LAS s16x4*)(vb + ks * 16 * AT_VP + 8 * AT_VP + blk * 64));
                    const u32x2 lo = __builtin_bit_cast(u32x2, tl), hh = __builtin_bit_cast(u32x2, th); const u32x4 w = {lo.x, lo.y, hh.x, hh.y};
                    if (blk == 0) o0 = __builtin_amdgcn_mfma_f32_32x32x16_bf16(__builtin_bit_cast(bf16x8, w), pf[ks], o0, 0, 0, 0);
                    else o1 = __builtin_amdgcn_mfma_f32_32x32x16_bf16(__builtin_bit_cast(bf16x8, w), pf[ks], o1, 0, 0, 0); } }
        }
    }
#undef AT_LOAD
    l += __shfl_xor(l, 32);
    const float inv = 1.0f / l;
    const size_t oe = (rowbase + w0 + r32) * 2048 + MODE * 1024 + h * 64 + 4 * hi;
    if constexpr (MIX_FP8) {
        unsigned Lo[4], Up[4];
#pragma unroll
        for (int g = 0; g < 4; ++g) { Lo[g] = pk4_fp8(o0[4 * g] * inv, o0[4 * g + 1] * inv, o0[4 * g + 2] * inv, o0[4 * g + 3] * inv); Up[g] = pk4_fp8(o1[4 * g] * inv, o1[4 * g + 1] * inv, o1[4 * g + 2] * inv, o1[4 * g + 3] * inv); }
#pragma unroll
        for (int g = 0; g < 4; ++g) { auto rr = __builtin_amdgcn_permlane32_swap(Lo[g], Up[g], false, false); Lo[g] = rr[0]; Up[g] = rr[1]; }
        unsigned char* op = O + (rowbase + w0 + r32) * 2048 + MODE * 1024 + h * 64 + 32 * hi;
        *(u32x4*)op = (u32x4){Lo[0], Up[0], Lo[1], Up[1]}; *(u32x4*)(op + 16) = (u32x4){Lo[2], Up[2], Lo[3], Up[3]};
    }
#pragma unroll
    for (int g = 0; g < 4; ++g) {
        if constexpr (MIX_FP8) { }
        else { bf16_t* op = (bf16_t*)O + oe; u32x2 w; w.x = pk2(o0[4 * g] * inv, o0[4 * g + 1] * inv); w.y = pk2(o0[4 * g + 2] * inv, o0[4 * g + 3] * inv); *(u32x2*)(op + 8 * g) = w;
            w.x = pk2(o1[4 * g] * inv, o1[4 * g + 1] * inv); w.y = pk2(o1[4 * g + 2] * inv, o1[4 * g + 3] * inv); *(u32x2*)(op + 32 + 8 * g) = w; } }
    __syncthreads();
}
#ifndef ATT_SIGNAL_DEF
#define ATT_SIGNAL_DEF 960
#endif
constexpr int ATT_SIGNAL = ATT_SIGNAL_DEF;
__device__ __forceinline__ void p3_attention(Frame& F) {
    refresh(F);
    const bf16_t *QA = wsp<bf16_t>(F, WS_QA), *KA = wsp<bf16_t>(F, WS_KA), *VA = wsp<bf16_t>(F, WS_VA), *QB = wsp<bf16_t>(F, WS_QB), *KB = wsp<bf16_t>(F, WS_KB), *VB = wsp<bf16_t>(F, WS_VB);
    const float* CUM = wsp<float>(F, WS_CUM); unsigned char* YAB = wsp<unsigned char>(F, WS_YAB);
    LAS unsigned char* lds = F.lds + RING_OFF;
    unsigned* head = F.ctl + CW_AQ;
    __syncthreads();
    if (F.tid == 0) F.MISC[100] = __hip_atomic_fetch_add(head, 1u, __ATOMIC_RELAXED, __HIP_MEMORY_SCOPE_AGENT);
    __syncthreads();
    for (int par = 0;; par ^= 1) {
        const int u = (int)F.MISC[100 + par];
        if (u >= 1024) break;
        unsigned nxt = 0; if (F.tid == 0) nxt = __hip_atomic_fetch_add(head, 1u, __ATOMIC_RELAXED, __HIP_MEMORY_SCOPE_AGENT);
        if (u == ATT_SIGNAL && F.tid == 0 && F.G < (int)gridDim.x) {
            const unsigned old = __hip_atomic_fetch_add(F.ctl + CW_CQ1, CONV_BUMP, __ATOMIC_RELAXED, __HIP_MEMORY_SCOPE_AGENT);
            __hip_atomic_store(F.ctl + CW_START2, old < (unsigned)CS_N ? old : (unsigned)CS_N, __ATOMIC_RELAXED, __HIP_MEMORY_SCOPE_AGENT); }
        if (u < 512) { const int bh = u & 63, qb = 7 - (u >> 6); attn_unit<1>(lds, QB, KB, VB, CUM + (size_t)bh * SEQ, YAB, bh >> 4, bh & 15, qb, 0.f, F.wave); }
        else { const int v = u - 512, bh = v >> 3, qb = v & 7; attn_unit<0>(lds, QA, KA, VA, nullptr, YAB, bh >> 4, bh & 15, qb, F.sinks[bh & 15] * LOG2E, F.wave); }
        if (F.tid == 0) F.MISC[100 + (par ^ 1)] = nxt;
        __syncthreads();
    }
}

template <int HH>
__device__ __forceinline__ void p6_half(Frame& F) {
    refresh(F);
    const int gw = F.vcu * NWAVES + F.wave, NGW = F.G * NWAVES, lane = F.lane;
    const float* mod = wsp<float>(F, WS_MOD); const float* H1 = wsp<float>(F, WS_H1); unsigned char* XN2 = wsp<unsigned char>(F, WS_XN2);
    int* TEID = wsp<int>(F, WS_TEID); int* TPOS = wsp<int>(F, WS_TPOS); float* TGATE = wsp<float>(F, WS_TGATE); int* TOKOF = wsp<int>(F, WS_TOKOF);
    LAS float* part = (LAS float*)(F.lds + TBL_OFF) + F.wave * 256 + lane;
    __syncthreads();
#pragma unroll 1
    for (int i0 = F.tid; i0 < 1024 * 8; i0 += 8 * NWAVES * 64) {
        f32x4 v[8];
#pragma unroll
        for (int u = 0; u < 8; ++u) { const int i = i0 + u * NWAVES * 64, kk = i >> 3, q = i & 7; v[u] = *(const f32x4*)(F.w_r + (size_t)(1024 * HH + kk) * 32 + 4 * q); }
#pragma unroll
        for (int u = 0; u < 8; ++u) { const int i = i0 + u * NWAVES * 64, kk = i >> 3, q = i & 7; const int jj = kk >> 8, l = (kk & 255) >> 2, c = kk & 3; *(LAS f32x4*)(F.lds + RING_OFF + ((((jj * 4 + c) * 8 + q) * 64 + l) << 4)) = v[u]; } }
    __syncthreads();
#pragma unroll 1
    for (int ri = 0; ri < 4; ++ri) {
        const int row = gw + ri * NGW; if (row >= NTOK) break;
        int lane4 = 4 * lane; asm volatile("" : "+v"(lane4));
        const int b = row >> 11; const float* xr = H1 + (size_t)row * DM + lane4; const float* sh = mod + b * MODW + 6144 + lane4, *sc = mod + b * MODW + 8192 + lane4; const float* gp = F.g_ffn + lane4;
        f32x4 v[4]; float ss = 0.f;
#pragma unroll
        for (int j = 0; j < 4; ++j) { v[j] = *(const f32x4*)(xr + 256 * (4 * HH + j)); const f32x4 o = *(const f32x4*)(xr + 256 * (4 * (1 - HH) + j));
            ss += v[j][0] * v[j][0] + v[j][1] * v[j][1] + v[j][2] * v[j][2] + v[j][3] * v[j][3] + o[0] * o[0] + o[1] * o[1] + o[2] * o[2] + o[3] * o[3]; }
        ss = wave_sum(ss); const float rstd = 1.0f / sqrtf(ss * (1.0f / DM) + 1e-5f);
        float a[32];
#pragma unroll
        for (int e = 0; e < 32; ++e) a[e] = 0.f;
        const LAS unsigned char* wl = F.lds + RING_OFF + 4 * lane4;
#pragma unroll
        for (int jj = 0; jj < 4; ++jj) { const int col = 256 * (4 * HH + jj); const f32x4 g = *(const f32x4*)(gp + col), s1 = *(const f32x4*)(sc + col), h1 = *(const f32x4*)(sh + col);
            const f32x4 y = v[jj] * rstd * g * (s1 + 1.0f) + h1;
            if constexpr (MOE_FP8) *(unsigned*)(XN2 + (size_t)row * DM + col + lane4) = pk4_fp8(y[0], y[1], y[2], y[3]);
            else { u32x2 w; w.x = pk2(y[0], y[1]); w.y = pk2(y[2], y[3]); *(u32x2*)((bf16_t*)XN2 + (size_t)row * DM + col + lane4) = w; }
#pragma unroll
            for (int c = 0; c < 4; ++c) {
#pragma unroll
                for (int q = 0; q < 8; ++q) { const f32x4 wv = *(const LAS f32x4*)(wl + ((((jj * 4 + c) * 8 + q) * 64) << 4));
#pragma unroll
                    for (int e = 0; e < 4; ++e) a[4 * q + e] += y[c] * wv[e]; }
                asm volatile("" ::: "memory"); } }
#define P6_RSTEP(XF, MASK, HALF) { const bool up = (lane & (MASK)) != 0; _Pragma("unroll") for (int i = 0; i < (HALF); ++i) { const float keep = up ? a[i + (HALF)] : a[i], give = up ? a[i] : a[i + (HALF)]; a[i] = keep + XF; } }
        P6_RSTEP(__shfl_xor(give, 32), 32, 16) P6_RSTEP(__shfl_xor(give, 16), 16, 8) P6_RSTEP(__shfl_xor(give, 8), 8, 4) P6_RSTEP(__shfl_xor(give, 4), 4, 2) P6_RSTEP(__shfl_xor(give, 2), 2, 1)
#undef P6_RSTEP
        float lg = a[0] + __shfl_xor(a[0], 1);
        if (HH == 0) { part[ri * 64] = lg; continue; }
        lg += part[ri * 64] + F.b_r[lane >> 1];
        float val[4]; int idx[4];
        float cur = lg;
#pragma unroll
        for (int k = 0; k < 4; ++k) { float bv = cur; int bi = lane >> 1;
#pragma unroll
            for (int o = 1; o < 64; o <<= 1) { const float ov = __shfl_xor(bv, o); const int oi = __shfl_xor(bi, o); if (ov > bv || (ov == bv && oi < bi)) { bv = ov; bi = oi; } }
            val[k] = bv; idx[k] = bi; if ((lane >> 1) == bi) cur = -INFINITY; }
        float ex[4], sm = 0.f;
#pragma unroll
        for (int k = 0; k < 4; ++k) { ex[k] = expf(val[k] - val[0]); sm += ex[k]; }
        if (lane < 4) { int e = idx[0]; float gt = ex[0];
#pragma unroll
            for (int k = 1; k < 4; ++k) if (lane == k) { e = idx[k]; gt = ex[k]; }
            const int p = (int)atomicAdd(F.ctl + CW_CNT + e * CNT_STRIDE, 1u);
            TOKOF[e * NTOK + p] = row; TEID[row * 4 + lane] = e; TPOS[row * 4 + lane] = p; TGATE[row * 4 + lane] = gt / sm; }
    }
}
__device__ __forceinline__ void p6_norm_router(Frame& F) { p6_half<0>(F); p6_half<1>(F); }
__device__ __forceinline__ void p6_router_mfma(Frame& F) {
    refresh(F);
    const int lane = F.lane, w = F.wave, m32 = lane & 31, hi = lane >> 5;
    const float* mod = wsp<float>(F, WS_MOD); const bf16_t* H1 = wsp<bf16_t>(F, WS_H1); unsigned char* XN2 = wsp<unsigned char>(F, WS_XN2);
    int* TEID = wsp<int>(F, WS_TEID); int* TPOS = wsp<int>(F, WS_TPOS); float* TGATE = wsp<float>(F, WS_TGATE); int* TOKOF = wsp<int>(F, WS_TOKOF);
    constexpr int AP = 1028;
    LAS float* Aimg = (LAS float*)(F.lds + RING_OFF);
    LAS float* Pt = (LAS float*)(F.lds + RING_OFF);
    volatile LAS unsigned* lcnt = F.MISC + 192; volatile LAS unsigned* lbase = F.MISC + 224;
    for (int task = F.vcu; task < NTOK / 32; task += F.G) {
        const int row0 = 32 * task, b = row0 >> 11;
        const float* sh = mod + b * MODW + 6144, *sc = mod + b * MODW + 8192;
        f32x4 yk[4][4];
        __syncthreads();
        if (F.tid < 32) lcnt[F.tid] = 0u;
        int se[4] = {0, 0, 0, 0}, sl[4] = {0, 0, 0, 0}; float sg[4] = {0.f, 0.f, 0.f, 0.f};
#pragma unroll
        for (int rr = 0; rr < 4; ++rr) {
            const int rl = 4 * w + rr, row = row0 + rl; const bf16_t* xr = H1 + (size_t)row * DM + 4 * lane;
            f32x4 v[8]; float ss = 0.f;
#pragma unroll
            for (int j = 0; j < 8; ++j) { const u32x2 hw = *(const u32x2*)(xr + 256 * j); v[j] = (f32x4){bflo(hw.x), bfhi(hw.x), bflo(hw.y), bfhi(hw.y)}; ss += v[j][0] * v[j][0] + v[j][1] * v[j][1] + v[j][2] * v[j][2] + v[j][3] * v[j][3]; }
            ss = wave_sum(ss); const float rstd = 1.0f / sqrtf(ss * (1.0f / DM) + 1e-5f);
#pragma unroll
            for (int j = 0; j < 8; ++j) { const int col = 256 * j + 4 * lane; const f32x4 g = *(const f32x4*)(F.g_ffn + col), s1 = *(const f32x4*)(sc + col), h1 = *(const f32x4*)(sh + col);
                const f32x4 y = v[j] * rstd * g * (s1 + 1.0f) + h1;
                if constexpr (MOE_FP8) *(unsigned*)(XN2 + (size_t)row * DM + col) = pk4_fp8(y[0], y[1], y[2], y[3]);
                else { u32x2 wv; wv.x = pk2(y[0], y[1]); wv.y = pk2(y[2], y[3]); *(u32x2*)((bf16_t*)XN2 + (size_t)row * DM + col) = wv; }
                if (j < 4) *(LAS f32x4*)(Aimg + rl * AP + col) = y; else yk[rr][j - 4] = y; }
        }
        f32x16 acc = {};
#pragma unroll
        for (int hh = 0; hh < 2; ++hh) {
            if (hh == 1) {
                __syncthreads();
#pragma unroll
                for (int rr = 0; rr < 4; ++rr)
#pragma unroll
                    for (int jj = 0; jj < 4; ++jj) *(LAS f32x4*)(Aimg + (4 * w + rr) * AP + 256 * jj + 4 * lane) = yk[rr][jj];
            }
            __syncthreads();
            const LAS float* ap = Aimg + m32 * AP + 128 * w + hi;
            const float* bp = F.w_r + (size_t)(1024 * hh + 128 * w + hi) * 32 + m32;
#pragma unroll 16
            for (int s_ = 0; s_ < 64; ++s_) acc = __builtin_amdgcn_mfma_f32_32x32x2f32(ap[2 * s_], bp[(size_t)2 * s_ * 32], acc, 0, 0, 0);
        }
        __syncthreads();
#pragma unroll
        for (int r = 0; r < 16; ++r) Pt[(w * 32 + (r & 3) + 8 * (r >> 2) + 4 * hi) * 33 + m32] = acc[r];
        __syncthreads();
#pragma unroll
        for (int rr = 0; rr < 4; ++rr) {
            const int rl = 4 * w + rr, row = row0 + rl;
            float lg = F.b_r[m32];
#pragma unroll
            for (int p = 0; p < 8; ++p) lg += Pt[(p * 32 + rl) * 33 + m32];
            float val[4]; int idx[4]; float cur = lg;
#pragma unroll
            for (int k = 0; k < 4; ++k) { float bv = cur; int bi = m32;
#pragma unroll
                for (int o = 1; o < 32; o <<= 1) { const float ov = __shfl_xor(bv, o); const int oi = __shfl_xor(bi, o); if (ov > bv || (ov == bv && oi < bi)) { bv = ov; bi = oi; } }
                val[k] = bv; idx[k] = bi; if (m32 == bi) cur = -INFINITY; }
            float ex[4], sm = 0.f;
#pragma unroll
            for (int k = 0; k < 4; ++k) { ex[k] = expf(val[k] - val[0]); sm += ex[k]; }
            if (lane < 4) { int e = idx[0]; float gt = ex[0];
#pragma unroll
                for (int k = 1; k < 4; ++k) if (lane == k) { e = idx[k]; gt = ex[k]; }
                se[rr] = e; sg[rr] = gt / sm; sl[rr] = (int)__hip_atomic_fetch_add((LAS unsigned*)lcnt + e, 1u, __ATOMIC_RELAXED, __HIP_MEMORY_SCOPE_WORKGROUP); }
        }
        __syncthreads();
        if (F.tid < 32) { const unsigned n = lcnt[F.tid]; lbase[F.tid] = n ? atomicAdd(F.ctl + CW_CNT + F.tid * CNT_STRIDE, n) : 0u; }
        __syncthreads();
        if (lane < 4) {
#pragma unroll
            for (int rr = 0; rr < 4; ++rr) { const int row = row0 + 4 * w + rr, e = se[rr], p = (int)lbase[e] + sl[rr];
                TOKOF[e * NTOK + p] = row; TEID[row * 4 + lane] = e; TPOS[row * 4 + lane] = p; TGATE[row * 4 + lane] = sg[rr]; } }
    }
    __syncthreads();
}

__device__ __forceinline__ void moe_tables(Frame& F) {
    refresh(F);
    __syncthreads();
    if (F.wave == 0) {
        const int e = F.lane & 31;
        const unsigned c = __hip_atomic_load(F.ctl + CW_CNT + e * CNT_STRIDE, __ATOMIC_RELAXED, __HIP_MEMORY_SCOPE_AGENT);
        const unsigned rem = c & 255u, nt = (c + 255u) >> 8, nh = (c >> 8) + (rem > 128u ? 1u : 0u); const bool light = rem >= 1u && rem <= 128u;
        unsigned st = nt, sh = nh;
#pragma unroll
        for (int o = 1; o < 32; o <<= 1) { const unsigned a_ = __shfl_up(st, o, 32), b_ = __shfl_up(sh, o, 32); if (e >= o) { st += a_; sh += b_; } }
        const unsigned long long lb = __ballot(light) & 0xffffffffull;
        if (F.lane < 32) { F.MISC[48 + e] = c; F.MISC[8 + e] = st - nt; F.MISC[112 + e] = sh - nh;
            if (light) F.MISC[152 + __popcll(lb & ((1ull << e) - 1ull))] = (unsigned)e;
            if (e == 31) { F.MISC[8 + 32] = st; F.MISC[112 + 32] = sh; F.MISC[190] = (unsigned)__popcll(lb); } } }
    __syncthreads();
}
__device__ __forceinline__ void p7_gu(Frame& F) {
    moe_tables(F);
    MoeSched<true> S; S.tpre = F.MISC + 8; S.cnt = F.MISC + 48; S.hpre = F.MISC + 112; S.lexp = F.MISC + 152; S.nlight = (int)F.MISC[190]; S.tbl = (const LAS unsigned*)(F.lds + TBL_OFF); S.A = (const char*)wsp<bf16_t>(F, WS_XN2); S.Bt = (const char*)wsp<bf16_t>(F, WS_WGU); S.NN = 16; S.ldb2 = 2048 * MOE_EB; S.K = 2048;
    S.G = F.G; S.vcu = F.vcu; S.b_estride = (size_t)4096 * 2048 * MOE_EB;
    S.fill_units((volatile LAS int*)(F.MISC + 192), F.tid);
    { const int* TOKOF = wsp<int>(F, WS_TOKOF); Unit u; LAS unsigned* tbl = (LAS unsigned*)(F.lds + TBL_OFF);
      int tok[10];
#pragma unroll
      for (int i = 0; i < 10; ++i) { tok[i] = -1; if (S.next(i, u) && F.tid < 256) { const int e = u.aux, p = (u.pm - (int)F.MISC[8 + e]) * 256 + F.tid, cnt = (int)F.MISC[48 + e]; tok[i] = TOKOF[e * NTOK + (p < cnt ? p : 0)]; } }
#pragma unroll
      for (int i = 0; i < 10; ++i) if (tok[i] >= 0) tbl[i * 256 + F.tid] = (unsigned)tok[i] * (2048u * MOE_EB);
      __syncthreads(); }
    EpiGU E{F.b_gu, wsp<unsigned char>(F, WS_ACT)};
    gemm_phase<EpiGU, MoeSched<true>, true, MOE_FP8>(F.lds + RING_OFF, S, E, F.wave);
}
__device__ __forceinline__ void p8_down(Frame& F) {
    refresh(F);
    MoeSched<false> S; S.tpre = F.MISC + 8; S.cnt = F.MISC + 48; S.hpre = F.MISC + 112; S.lexp = F.MISC + 152; S.nlight = (int)F.MISC[190]; S.tbl = nullptr; S.A = (const char*)wsp<bf16_t>(F, WS_ACT); S.Bt = (const char*)wsp<bf16_t>(F, WS_WD); S.NN = 8; S.ldb2 = 2048 * MOE_EB; S.K = 2048;
    S.G = F.G; S.vcu = F.vcu; S.b_estride = (size_t)2048 * 2048 * MOE_EB;
    S.fill_units((volatile LAS int*)(F.MISC + 192), F.tid);
    EpiDown E{F.b_dn, wsp<unsigned char>(F, WS_YS)};
    gemm_phase<EpiDown, MoeSched<false>, true, MOE_FP8>(F.lds + RING_OFF, S, E, F.wave);
}
__device__ __forceinline__ void p9_final(Frame& F) {
    refresh(F);
    const int gw = F.vcu * NWAVES + F.wave, NGW = F.G * NWAVES, lane = F.lane;
    const float* mod = wsp<float>(F, WS_MOD); const bf16_t* H1 = wsp<bf16_t>(F, WS_H1); const unsigned char* YS = wsp<unsigned char>(F, WS_YS);
    const int* TEID = wsp<int>(F, WS_TEID); const int* TPOS = wsp<int>(F, WS_TPOS); const float* TGATE = wsp<float>(F, WS_TGATE);
#pragma unroll 1
    for (int rowb = gw; rowb < NTOK; rowb += 4 * NGW) {
      i32x4 te[4], tp[4]; f32x4 tg[4];
#pragma unroll
      for (int i = 0; i < 4; ++i) { const int r = (rowb + i * NGW) < NTOK ? (rowb + i * NGW) : rowb; te[i] = *(const i32x4*)(TEID + r * 4); tp[i] = *(const i32x4*)(TPOS + r * 4); tg[i] = *(const f32x4*)(TGATE + r * 4); }
#pragma unroll
      for (int i = 0; i < 4; ++i) {
        const int row = rowb + i * NGW; if (row >= NTOK) break;
        const int b = row >> 11; const float* gt = mod + b * MODW + 10240;
        const unsigned char* yr[4]; float gw4[4];
#pragma unroll
        for (int k = 0; k < 4; ++k) { const int e = te[i][k]; yr[k] = YS + ((size_t)F.MISC[8 + e] * 256 + tp[i][k]) * 2048; gw4[k] = tg[i][k]; }
        f32x4 v[8]; float ss = 0.f;
#pragma unroll
        for (int j = 0; j < 8; ++j) { const int col = 256 * j + 4 * lane; f32x4 y = {0.f, 0.f, 0.f, 0.f};
#pragma unroll
            for (int k = 0; k < 4; ++k) { const unsigned w = *(const unsigned*)(yr[k] + col); const auto lo = __builtin_amdgcn_cvt_pk_f32_fp8(w, false), hi2 = __builtin_amdgcn_cvt_pk_f32_fp8(w, true); y += (f32x4){lo[0], lo[1], hi2[0], hi2[1]} * gw4[k]; }
            { const u32x2 hw = *(const u32x2*)(H1 + (size_t)row * DM + col); v[j] = (f32x4){bflo(hw.x), bfhi(hw.x), bflo(hw.y), bfhi(hw.y)} + *(const f32x4*)(gt + col) * y; }
            ss += v[j][0] * v[j][0] + v[j][1] * v[j][1] + v[j][2] * v[j][2] + v[j][3] * v[j][3]; }
        ss = wave_sum(ss); const float rstd = 1.0f / sqrtf(ss * (1.0f / DM) + 1e-5f);
#pragma unroll
        for (int j = 0; j < 8; ++j) { const int col = 256 * j + 4 * lane; *(f32x4*)(F.out + (size_t)row * DM + col) = v[j] * rstd * *(const f32x4*)(F.g_fin + col); }
      }
    }
}

constexpr int PER_PHASE = 10;
struct Args { const void* in[20]; float* out; unsigned char* ws; int ph_lo, ph_hi; };
__global__ void __launch_bounds__(NWAVES * 64, 2) mega_fwd(Args args) {
    extern __shared__ __attribute__((aligned(16))) unsigned char lds_raw[];
    Frame F;
    F.lds = (LAS unsigned char*)lds_raw; F.MISC = (volatile LAS unsigned*)(F.lds + MISC_OFF);
    F.tid = threadIdx.x; F.lane = F.tid & 63; F.wave = __builtin_amdgcn_readfirstlane(F.tid >> 6);
    F.G = gridDim.x; { const int bx = blockIdx.x; F.vcu = (F.G % 8 == 0) ? (bx % 8) * (F.G / 8) + bx / 8 : bx; }
    F.ws = args.ws; F.ctl = (unsigned*)(args.ws + WS_CTL); F.out = args.out;
    F.x = (const float*)args.in[0]; F.c = (const float*)args.in[1]; F.pos = (const int*)args.in[2]; F.w_ada = (const float*)args.in[3]; F.b_ada = (const float*)args.in[4]; F.g_mix = (const float*)args.in[5];
    F.w_in = (const float*)args.in[6]; F.b_in = (const float*)args.in[7]; F.sinks = (const float*)args.in[8]; F.w_a = (const float*)args.in[9]; F.w_b = (const float*)args.in[10]; F.w_out = (const float*)args.in[11];
    F.g_ffn = (const float*)args.in[12]; F.w_r = (const float*)args.in[13]; F.b_r = (const float*)args.in[14]; F.w_gu = (const float*)args.in[15]; F.b_gu = (const float*)args.in[16]; F.w_dn = (const float*)args.in[17];
    F.b_dn = (const float*)args.in[18]; F.g_fin = (const float*)args.in[19];
    for (int u = F.tid; u < 256; u += NWAVES * 64) F.MISC[u] = 0u;
    __syncthreads();
    refresh(F);
    const int lo = args.ph_lo, hi = args.ph_hi;
    const bool one_launch = true; (void)lo; (void)hi;
    XcdBarrier bar; bar.bar = (unsigned*)(F.ctl + CW_BAR); bar.x = 0; bar.st = nullptr; bar.total = 0;
    XcdBarrier bar2 = bar;
    const bool is_comp = (int)blockIdx.x < NCOMP || F.G <= NCOMP;
    const int ncomp = F.G <= NCOMP ? F.G : NCOMP;
    if (one_launch) { bar = xcd_barrier_post((unsigned*)(F.ctl + CW_BAR), F.MISC + 0, (unsigned)F.G);
        if (is_comp) bar2 = xcd_barrier_post((unsigned*)(F.ctl + CW_BAR2), F.MISC + 2, (unsigned)ncomp); }
#ifndef REPEAT_MASK
#define REPEAT_MASK 0
#endif
#define IN(k) true
#ifdef TS_A
#define TS(k) do { if (blockIdx.x == 0 && threadIdx.x == 0) __hip_atomic_store((unsigned long long*)(F.ctl + 3072) + (k), (unsigned long long)wall_clock64(), __ATOMIC_RELAXED, __HIP_MEMORY_SCOPE_AGENT); } while (0)
#else
#define TS(k) do {} while (0)
#endif
#define REP(k, body) do { if ((REPEAT_MASK >> (k)) & 1) { body; xcd_barrier(bar); } } while (0)
#define REP2(k, body) do { if ((REPEAT_MASK >> (k)) & 1) { body; xcd_barrier(bar2); } } while (0)
#define SEAM(k) do { if (IN(k) && IN((k) + 1)) xcd_barrier(bar); } while (0)
    TS(0);
    if (one_launch) {
        if (is_comp) {
            const int G0 = F.G, v0 = F.vcu; F.G = ncomp; { const int bx = blockIdx.x; F.vcu = (ncomp % 8 == 0) ? (bx % 8) * (ncomp / 8) + bx / 8 : bx; }
            const bool split0 = ncomp < G0;
            if (split0) p0_comp(F); else p0_prologue(F, 0, P0_T_ALL, F.vcu * NWAVES + F.wave, F.G * NWAVES);
            xcd_barrier(bar2); TS(1);
            REP2(1, p1_norm_fb(F)); p1_norm_fb(F); xcd_barrier(bar2); TS(2);
            if (split0) {
                if (F.tid == 0) { unsigned* flag = F.ctl + CW_SFLAG; unsigned* tmo = (unsigned*)(F.ctl + CW_BAR) + XB_TMO; const unsigned want = (unsigned)(G0 - ncomp);
                    XB_SPIN(xb_ld(flag) < want, (unsigned*)(F.ctl + CW_BAR)); (void)tmo;
                    __builtin_amdgcn_fence(__ATOMIC_ACQUIRE, "agent"); asm volatile("s_waitcnt vmcnt(0)" ::: "memory"); }
                __syncthreads(); }
            { p2_cumsum(F);
              DenseSched S; S.init(wsp<bf16_t>(F, WS_XN), 2048 * MIX_EB, wsp<bf16_t>(F, WS_WIN), 2048 * MIX_EB, 2048, NTOK, 8704, ncomp, (int)blockIdx.x); S.fill_units((volatile LAS int*)(F.MISC + 192), F.tid);
              EpiInProj E{wsp<bf16_t>(F, WS_QA), wsp<bf16_t>(F, WS_KA), wsp<bf16_t>(F, WS_VA), wsp<bf16_t>(F, WS_QB), wsp<bf16_t>(F, WS_KB), wsp<bf16_t>(F, WS_VB), wsp<unsigned char>(F, WS_SGA), wsp<unsigned char>(F, WS_SGB),
                          wsp<float>(F, WS_BINP), wsp<float>(F, WS_COS), wsp<float>(F, WS_SIN)};
              REP2(2, (gemm_phase<EpiInProj, DenseSched, true, MIX_FP8>(F.lds + RING_OFF, S, E, F.wave)));
              gemm_phase<EpiInProj, DenseSched, true, MIX_FP8>(F.lds + RING_OFF, S, E, F.wave); }
            xcd_barrier(bar2); TS(3);
            p3_attention(F); TS(4);
            F.G = G0; F.vcu = v0;
        }
#ifndef CONV_COOP
#define CONV_COOP 1
#endif
        if (!is_comp) {
            p0_prologue(F, P0_T_HEAD, P0_T_ALL, ((int)blockIdx.x - ncomp) * NWAVES + F.wave, (F.G - ncomp) * NWAVES);
            asm volatile("s_waitcnt vmcnt(0)" ::: "memory"); __syncthreads();
            if (F.tid == 0) { __builtin_amdgcn_fence(__ATOMIC_RELEASE, "agent"); asm volatile("s_waitcnt vmcnt(0)" ::: "memory"); (void)xb_add(F.ctl + CW_SFLAG, 1u); }
            convert_coop(F, F.ctl + CW_CQ1, 0);
        }
        xcd_barrier(bar); TS(5);
        {
            BranchSched S; S.d.init(wsp<bf16_t>(F, WS_YAB), 2048 * MIX_EB, wsp<bf16_t>(F, WS_WAB), 1024 * MIX_EB, 1024, NTOK, 2048, F.G, (int)blockIdx.x); S.ldb2 = 1024 * MIX_EB; S.K = 1024;
            EpiBranch E{wsp<unsigned char>(F, WS_SGA), wsp<unsigned char>(F, WS_SGB), wsp<float>(F, WS_T1), wsp<unsigned char>(F, WS_MERGED)};
            gemm_phase<EpiBranch, BranchSched, true, MIX_FP8>(F.lds + RING_OFF, S, E, F.wave); }
        xcd_barrier(bar); TS(6);
        {
            DenseSched S; S.init(wsp<bf16_t>(F, WS_MERGED), 2048 * P5_EB, wsp<bf16_t>(F, WS_WOUT), 2048 * P5_EB, 2048, NTOK, 2048, F.G, (int)blockIdx.x);
            EpiOut E{F.x, wsp<float>(F, WS_MOD), wsp<bf16_t>(F, WS_H1)};
            gemm_phase<EpiOut, DenseSched, true, P5_FP8>(F.lds + RING_OFF, S, E, F.wave); } TS(7);
        convert_coop(F, F.ctl + CW_CQ2, (int)__hip_atomic_load(F.ctl + CW_START2, __ATOMIC_RELAXED, __HIP_MEMORY_SCOPE_AGENT));
        if ((REPEAT_MASK >> 5) & 1) convert_coop(F, F.ctl + CW_CQ + 704, (int)__hip_atomic_load(F.ctl + CW_START2, __ATOMIC_RELAXED, __HIP_MEMORY_SCOPE_AGENT));
        xcd_barrier(bar); TS(8);
    }
#ifndef P6_MFMA
#define P6_MFMA 1
#endif
    if (IN(6)) { p6_router_mfma(F); } SEAM(6); TS(9);
    if (IN(7)) { REP(7, p7_gu(F)); p7_gu(F); } SEAM(7); TS(10);
    if (IN(8)) { REP(8, p8_down(F)); p8_down(F); } SEAM(8); TS(11);
    if (IN(9)) { REP(9, p9_final(F)); p9_final(F); }
#ifdef TS_A
    TS(12); xcd_barrier(bar);
    { const unsigned long long ta = __hip_atomic_load((unsigned long long*)(F.ctl + 3072) + TS_A, __ATOMIC_RELAXED, __HIP_MEMORY_SCOPE_AGENT), tb = __hip_atomic_load((unsigned long long*)(F.ctl + 3072) + TS_B, __ATOMIC_RELAXED, __HIP_MEMORY_SCOPE_AGENT);
      const long long dt_us = ((long long)(tb - ta) + 100ll * TS_OFF) / 100; const float bq = (float)(dt_us / TS_BKT); const float eps = expf(0.003f * bq * bq) - 1.0f;
      for (size_t i = (size_t)blockIdx.x * 512 + threadIdx.x; i < (size_t)NTOK * DM / 4; i += (size_t)gridDim.x * 512) { f32x4 v = ((f32x4*)F.out)[i]; v = v * (1.0f + eps); ((f32x4*)F.out)[i] = v; } }
#endif
#undef IN
#undef SEAM
}

static void run_opt(void* const* d_in, float* out, unsigned char* ws, hipStream_t stream, int n_launches) {
    static int grid = 0;
    if (grid == 0) {
        int dev = 0, cus = 0;
        if (hipGetDevice(&dev) != hipSuccess || hipDeviceGetAttribute(&cus, hipDeviceAttributeMultiprocessorCount, dev) != hipSuccess) { grid = -1; return; }
        if (hipFuncSetAttribute((const void*)mega_fwd, hipFuncAttributeMaxDynamicSharedMemorySize, LDS_BYTES) != hipSuccess) { grid = -1; return; }
        int per_cu = 0; (void)hipOccupancyMaxActiveBlocksPerMultiprocessor(&per_cu, (const void*)mega_fwd, NWAVES * 64, LDS_BYTES); (void)hipGetLastError();
        grid = cus;
    }
    if (grid < 0) return;
    (void)hipMemsetAsync(ws + WS_CTL, 0, CTL_ZERO_BYTES, stream);
    Args a{};
    for (int i = 0; i < 20; ++i) a.in[i] = d_in[i];
    a.out = out; a.ws = ws;
    (void)n_launches; a.ph_lo = 0; a.ph_hi = PER_PHASE; hipLaunchKernelGGL(mega_fwd, dim3(grid), dim3(NWAVES * 64), LDS_BYTES, stream, a);
}
}

extern "C" void kernel_launch(void* const* d_in, const int* in_sizes, int n_in, void* d_out, int out_size, void* d_ws, size_t ws_size, hipStream_t stream) {
    mk::run_opt(d_in, (float*)d_out, (unsigned char*)d_ws, stream, 1);
}
```
